# Optimizing an MI355X kernel written in HIP

```python
import math
import numpy as np
import jax
import jax.numpy as jnp
from jax import lax

D_MODEL = 1024
BATCH = 2
SEQ = 16384
DEPTH = 2

GRID_W = 64
CTX_LEN = 256
N_MIXERS = 4
GROUP_WIDTH = D_MODEL // N_MIXERS
MIX_WIDTH = N_MIXERS * GROUP_WIDTH
HEAD_DIM = 64
D_FF = 4 * D_MODEL
EPS = 1e-6
NEG_INF = -1e30
ROPE_BASE = 10000.0

DA_HEADS = GROUP_WIDTH // HEAD_DIM
DA_QK_DIM = HEAD_DIM // 2
DA_V_DIM = HEAD_DIM
DA_Q_BLOCK = 128
HG_HEADS = 4
HG_DK = GROUP_WIDTH // HG_HEADS
HG_DV = GROUP_WIDTH // HG_HEADS
HG_CHUNK = 64
NA_HEADS = GROUP_WIDTH // HEAD_DIM
NA_KH = 8
NA_KW = 16
NA_Q_BLOCK_W = 16
NA_BAND_W = 2 * NA_KW
SW_HEADS = GROUP_WIDTH // HEAD_DIM
SW_KV_HEADS = 2
SW_GROUPS = SW_HEADS // SW_KV_HEADS
SW_WINDOW = 128
SW_BLOCK = 128

IN_SIZES = (GROUP_WIDTH, GROUP_WIDTH, GROUP_WIDTH,
            GROUP_WIDTH, GROUP_WIDTH, GROUP_WIDTH, GROUP_WIDTH, GROUP_WIDTH,
            GROUP_WIDTH, GROUP_WIDTH, GROUP_WIDTH,
            SW_HEADS * HEAD_DIM, SW_KV_HEADS * HEAD_DIM, SW_KV_HEADS * HEAD_DIM)
IN_COLS = sum(IN_SIZES)

kernel_name = 'hybrid_parallel_head_dit_block'


def rmsnorm(x, g):
    xf = x.astype(jnp.float32)
    y = xf * lax.rsqrt(jnp.mean(xf * xf, axis=-1, keepdims=True) + EPS)
    return (y * g.astype(jnp.float32)).astype(x.dtype)


def split_heads(x, n_heads, head_dim):
    b, s, _ = x.shape
    return x.reshape(b, s, n_heads, head_dim).transpose(0, 2, 1, 3)


def merge_heads(x):
    b, n, s, d = x.shape
    return x.transpose(0, 2, 1, 3).reshape(b, s, n * d)


def split_cols(p):
    idx = np.cumsum(IN_SIZES)[:-1].tolist()
    return jnp.split(p, idx, axis=-1)


def axial_rope_tables(n_tokens, rot_dim, dtype):
    t = jnp.arange(n_tokens, dtype=jnp.int32)
    row = (t // GRID_W).astype(jnp.float32)
    col = (t % GRID_W).astype(jnp.float32)
    axis_dim = rot_dim // 2
    inv_freq = ROPE_BASE ** (-jnp.arange(0, axis_dim, 2, dtype=jnp.float32) / axis_dim)
    ang_r = row[:, None] * inv_freq
    ang_c = col[:, None] * inv_freq
    return tuple(a.astype(dtype) for a in (jnp.cos(ang_r), jnp.sin(ang_r), jnp.cos(ang_c), jnp.sin(ang_c)))


def rotate(x, cos, sin):
    x1, x2 = jnp.split(x, 2, axis=-1)
    return jnp.concatenate([x1 * cos - x2 * sin, x1 * sin + x2 * cos], axis=-1)


def apply_axial_rope(x, tables):
    cos_r, sin_r, cos_c, sin_c = tables
    x_row, x_col = jnp.split(x, 2, axis=-1)
    return jnp.concatenate([rotate(x_row, cos_r, sin_r), rotate(x_col, cos_c, sin_c)], axis=-1)


def adaln_params(cond, w_mod, b_mod):
    return jnp.split(jax.nn.silu(cond) @ w_mod + b_mod, 6, axis=-1)


def modulate(x, g, shift, scale):
    return rmsnorm(x, g) * (1.0 + scale) + shift


def squared_relu_mlp(h, w1, w2):
    return jnp.square(jax.nn.relu(h @ w1)) @ w2


def diff_attention(lat, ctx, q_gain, k_gain, lam_vecs, sub_gain, lam_init, rope_tabs, need_ctx):
    q_l, k_l, v_l = lat
    q_c, k_c, v_c = ctx

    def qk(x, gain, rope):
        b, s, _ = x.shape
        x = rmsnorm(split_heads(x, 2 * DA_HEADS, DA_QK_DIM), gain)
        if rope:
            x = apply_axial_rope(x, rope_tabs)
        return x.reshape(b, DA_HEADS, 2, s, DA_QK_DIM)

    ql, kl = qk(q_l, q_gain, True), qk(k_l, k_gain, True)
    kc = qk(k_c, k_gain, False)
    vl, vc = split_heads(v_l, DA_HEADS, DA_V_DIM), split_heads(v_c, DA_HEADS, DA_V_DIM)
    k_all = jnp.concatenate([kc, kl], axis=3)
    v_all = jnp.concatenate([vc, vl], axis=2)
    lv = lam_vecs.astype(jnp.float32)
    lam = jnp.exp(jnp.sum(lv[0] * lv[1])) - jnp.exp(jnp.sum(lv[2] * lv[3])) + lam_init
    scale = DA_QK_DIM ** -0.5

    def attend(q, k, v):
        s = jnp.einsum('bhmqd,bhmkd->bhmqk', q, k).astype(jnp.float32) * scale
        a = jax.nn.softmax(s, axis=-1)
        a = a[:, :, 0] - lam * a[:, :, 1]
        return jnp.einsum('bhqk,bhkd->bhqd', a.astype(v.dtype), v)

    def finish(o):
        return merge_heads(rmsnorm(o, sub_gain) * (1.0 - lam_init))

    b, _, _, s, _ = ql.shape
    nb = s // DA_Q_BLOCK
    qb = ql.reshape(b, DA_HEADS, 2, nb, DA_Q_BLOCK, DA_QK_DIM).transpose(3, 0, 1, 2, 4, 5)
    o = lax.map(lambda q_blk: attend(q_blk, k_all, v_all), qb)
    o = o.transpose(1, 2, 0, 3, 4).reshape(b, DA_HEADS, s, DA_V_DIM)
    out_c = finish(attend(qk(q_c, q_gain, False), kc, vc)) if need_ctx else None
    return finish(o), out_c


def hgrn2_chunk_scan(q, k, v, log_f, state0, need_out):
    b, h, t, _ = q.shape
    dv = v.shape[-1]
    n = t // HG_CHUNK

    def chunks(a):
        return a.astype(jnp.float32).reshape(b, h, n, HG_CHUNK, a.shape[-1]).transpose(2, 0, 1, 3, 4)

    lower = jnp.tril(jnp.ones((HG_CHUNK, HG_CHUNK), dtype=bool))[:, :, None]

    def step(state, inp):
        qc, kc, vc, gc = inp
        cum = jnp.cumsum(gc, axis=2)
        last = cum[:, :, -1]
        new_state = jnp.exp(last)[..., None] * state + jnp.einsum(
            'bhsk,bhsv->bhkv', kc * jnp.exp(last[:, :, None] - cum), vc)
        if not need_out:
            return new_state, None
        o_inter = jnp.einsum('bhtk,bhkv->bhtv', qc * jnp.exp(cum), state)
        rel = jnp.where(lower, cum[:, :, :, None, :] - cum[:, :, None, :, :], -jnp.inf)
        scores = jnp.einsum('bhtk,bhsk,bhtsk->bhts', qc, kc, jnp.exp(rel))
        o_intra = jnp.einsum('bhts,bhsv->bhtv', scores, vc)
        return new_state, o_inter + o_intra

    state, out = lax.scan(step, state0.astype(jnp.float32),
                          (chunks(q), chunks(k), chunks(v), chunks(log_f)))
    if need_out:
        out = out.transpose(1, 2, 0, 3, 4).reshape(b, h, t, dv).astype(v.dtype)
    return out, state


def hgrn2_mixer(lat, ctx, lower_bound, out_gain, need_ctx):
    def prep(parts):
        q, i, g, f_fw, f_bw = parts
        dirs = []
        for f, lb in ((f_fw, lower_bound[0]), (f_bw, lower_bound[1])):
            f = lb + (1.0 - lb) * jax.nn.sigmoid(f.astype(jnp.float32))
            dirs.append((split_heads(jnp.log(f), HG_HEADS, HG_DK), split_heads(1.0 - f, HG_HEADS, HG_DK)))
        return split_heads(q, HG_HEADS, HG_DK), split_heads(i, HG_HEADS, HG_DV), g, dirs

    ql, vl, gl, dirs_l = prep(lat)
    qc, vc, gc, dirs_c = prep(ctx)
    b = ql.shape[0]
    zero_state = jnp.zeros((b, HG_HEADS, HG_DK, HG_DV), jnp.float32)
    out_l, out_c = 0.0, 0.0
    for d, flip in enumerate((False, True)):
        rev = (lambda a: jnp.flip(a, axis=2)) if flip else (lambda a: a)
        logf_c, k_c = dirs_c[d]
        logf_l, k_l = dirs_l[d]
        o_c, s_c = hgrn2_chunk_scan(rev(qc), rev(k_c), rev(vc), rev(logf_c), zero_state, need_ctx)
        o_l, _ = hgrn2_chunk_scan(rev(ql), rev(k_l), rev(vl), rev(logf_l), s_c, True)
        out_l = out_l + rev(o_l)
        if need_ctx:
            out_c = out_c + rev(o_c)

    def finish(o, g):
        return merge_heads(rmsnorm(o, out_gain)) * jax.nn.silu(g)

    return finish(out_l, gl), (finish(out_c, gc) if need_ctx else None)


def neighbourhood_attention(lat, ctx, q_gain, k_gain, rpb, need_ctx):
    q_l, k_l, v_l = lat
    q_c, k_c, v_c = ctx
    ql = rmsnorm(split_heads(q_l, NA_HEADS, HEAD_DIM), q_gain)
    kl = rmsnorm(split_heads(k_l, NA_HEADS, HEAD_DIM), k_gain)
    vl = split_heads(v_l, NA_HEADS, HEAD_DIM)
    kc = rmsnorm(split_heads(k_c, NA_HEADS, HEAD_DIM), k_gain)
    vc = split_heads(v_c, NA_HEADS, HEAD_DIM)
    b, h, s, d = ql.shape
    rows = s // GRID_W
    kh = min(NA_KH, rows)
    ncb = GRID_W // NA_Q_BLOCK_W
    scale = d ** -0.5
    q_cols = (jnp.arange(ncb) * NA_Q_BLOCK_W)[:, None] + jnp.arange(NA_Q_BLOCK_W)
    win_start = jnp.clip(q_cols - NA_KW // 2, 0, GRID_W - NA_KW)
    band_start = jnp.clip(jnp.arange(ncb) * NA_Q_BLOCK_W - NA_KW // 2, 0, GRID_W - NA_BAND_W)
    key_cols = band_start[:, None] + jnp.arange(NA_BAND_W)
    kcol = key_cols[:, None, :]
    col_valid = (kcol >= win_start[..., None]) & (kcol < win_start[..., None] + NA_KW)
    dj = jnp.clip(kcol - q_cols[..., None], -(NA_KW - 1), NA_KW - 1) + (NA_KW - 1)
    rpb_cols = rpb.astype(jnp.float32)[:, :, dj]
    row_start = jnp.clip(jnp.arange(rows) - NA_KH // 2, 0, rows - kh)
    kl_g = kl.reshape(b, h, rows, GRID_W, d)
    vl_g = vl.reshape(b, h, rows, GRID_W, d)
    q_rows = ql.reshape(b, h, rows, ncb, NA_Q_BLOCK_W, d).transpose(2, 0, 1, 3, 4, 5)
    n_lat = kh * NA_BAND_W

    def one_row(args):
        r, rs, q = args
        k_band = lax.dynamic_slice_in_dim(kl_g, rs, kh, axis=2)[:, :, :, key_cols]
        v_band = lax.dynamic_slice_in_dim(vl_g, rs, kh, axis=2)[:, :, :, key_cols]
        s_lat = jnp.einsum('bhcqd,bhrckd->bhcqrk', q, k_band).astype(jnp.float32) * scale
        di = rs + jnp.arange(kh) - r + (NA_KH - 1)
        bias = rpb_cols[:, di].transpose(0, 2, 3, 1, 4)
        s_lat = jnp.where(col_valid[:, :, None, :], s_lat + bias, NEG_INF)
        s_ctx = jnp.einsum('bhcqd,bhkd->bhcqk', q, kc).astype(jnp.float32) * scale
        a = jax.nn.softmax(jnp.concatenate(
            [s_lat.reshape(b, h, ncb, NA_Q_BLOCK_W, n_lat), s_ctx], axis=-1), axis=-1).astype(q.dtype)
        a_lat = a[..., :n_lat].reshape(b, h, ncb, NA_Q_BLOCK_W, kh, NA_BAND_W)
        return (jnp.einsum('bhcqrk,bhrckd->bhcqd', a_lat, v_band)
                + jnp.einsum('bhcqk,bhkd->bhcqd', a[..., n_lat:], vc))

    o = lax.map(one_row, (jnp.arange(rows), row_start, q_rows))
    o = o.transpose(1, 2, 0, 3, 4, 5).reshape(b, h, s, d)
    out_c = None
    if need_ctx:
        qc = rmsnorm(split_heads(q_c, NA_HEADS, HEAD_DIM), q_gain)
        sc = jnp.einsum('bhqd,bhkd->bhqk', qc, kc).astype(jnp.float32) * scale
        out_c = merge_heads(jnp.einsum('bhqk,bhkd->bhqd', jax.nn.softmax(sc, axis=-1).astype(vc.dtype), vc))
    return merge_heads(o), out_c


def softmax_with_sink(scores, sink_b):
    sink_col = jnp.broadcast_to(sink_b, scores.shape[:-1] + (1,))
    return jax.nn.softmax(jnp.concatenate([sink_col, scores], axis=-1), axis=-1)[..., 1:]


def window_gqa(lat, ctx, q_gain, k_gain, sink, rope_tabs, need_ctx):
    q_l, k_l, v_l = lat
    q_c, k_c, v_c = ctx

    def qheads(x, rope):
        b_, s_, _ = x.shape
        x = rmsnorm(split_heads(x, SW_HEADS, HEAD_DIM), q_gain)
        if rope:
            x = apply_axial_rope(x, rope_tabs)
        return x.reshape(b_, SW_KV_HEADS, SW_GROUPS, s_, HEAD_DIM)

    ql = qheads(q_l, True)
    kl = apply_axial_rope(rmsnorm(split_heads(k_l, SW_KV_HEADS, HEAD_DIM), k_gain), rope_tabs)
    vl = split_heads(v_l, SW_KV_HEADS, HEAD_DIM)
    kc = rmsnorm(split_heads(k_c, SW_KV_HEADS, HEAD_DIM), k_gain)
    vc = split_heads(v_c, SW_KV_HEADS, HEAD_DIM)
    b, _, _, s, d = ql.shape
    n_ctx = kc.shape[2]
    nb = s // SW_BLOCK
    scale = d ** -0.5
    sink_f = sink.astype(jnp.float32).reshape(SW_KV_HEADS, SW_GROUPS)
    qb = ql.reshape(b, SW_KV_HEADS, SW_GROUPS, nb, SW_BLOCK, d)

    def band(a):
        a = jnp.pad(a, ((0, 0), (0, 0), (SW_BLOCK, SW_BLOCK), (0, 0))).reshape(b, SW_KV_HEADS, nb + 2, SW_BLOCK, d)
        return jnp.concatenate([a[:, :, :-2], a[:, :, 1:-1], a[:, :, 2:]], axis=3)

    kw, vw = band(kl), band(vl)
    q_pos = jnp.arange(s).reshape(nb, SW_BLOCK)
    k_pos = (jnp.arange(nb) * SW_BLOCK - SW_BLOCK)[:, None] + jnp.arange(3 * SW_BLOCK)
    valid = ((jnp.abs(k_pos[:, None, :] - q_pos[:, :, None]) <= SW_WINDOW)
             & (k_pos >= 0)[:, None, :] & (k_pos < s)[:, None, :])
    s_win = jnp.where(valid, jnp.einsum('bkgnqd,bknsd->bkgnqs', qb, kw).astype(jnp.float32) * scale, NEG_INF)
    s_ctx = jnp.einsum('bkgnqd,bkcd->bkgnqc', qb, kc).astype(jnp.float32) * scale
    a = softmax_with_sink(jnp.concatenate([s_ctx, s_win], axis=-1),
                          sink_f[None, :, :, None, None, None]).astype(vl.dtype)
    o = (jnp.einsum('bkgnqc,bkcd->bkgnqd', a[..., :n_ctx], vc)
         + jnp.einsum('bkgnqs,bknsd->bkgnqd', a[..., n_ctx:], vw))
    out_l = merge_heads(o.reshape(b, SW_HEADS, s, d))
    out_c = None
    if need_ctx:
        qc = qheads(q_c, False)
        sc = jnp.einsum('bkgqd,bkcd->bkgqc', qc, kc).astype(jnp.float32) * scale
        ac = softmax_with_sink(sc, sink_f[None, :, :, None, None]).astype(vc.dtype)
        out_c = merge_heads(jnp.einsum('bkgqc,bkcd->bkgqd', ac, vc).reshape(b, SW_HEADS, n_ctx, d))
    return out_l, out_c


def setup_inputs(seed: int = 0) -> dict:
    key = jax.random.key(seed)
    ks = jax.random.split(key, 24)

    def nrm(k, shape, s):
        return s * jax.random.normal(k, shape, jnp.float32)

    def gain(k, shape):
        return 1.0 + 0.02 * jax.random.normal(k, shape, jnp.float32)

    L = DEPTH
    return {
        'x': nrm(ks[0], (BATCH, SEQ, D_MODEL), 1.0),
        'c': nrm(ks[1], (BATCH, D_MODEL), 1.0),
        'ctx': nrm(ks[2], (BATCH, CTX_LEN, D_MODEL), 1.0),
        'c_ctx': nrm(ks[3], (D_MODEL,), 1.0),
        'w_mod': nrm(ks[4], (L, D_MODEL, 6 * D_MODEL), 0.5 * D_MODEL ** -0.5),
        'b_mod': nrm(ks[5], (L, 6 * D_MODEL), 0.01),
        'norm1_g': gain(ks[6], (L, D_MODEL)),
        'norm2_g': gain(ks[7], (L, D_MODEL)),
        'w_in': nrm(ks[8], (L, D_MODEL, IN_COLS), D_MODEL ** -0.5),
        'w_out': nrm(ks[9], (L, MIX_WIDTH, D_MODEL), MIX_WIDTH ** -0.5),
        'da_q_gain': gain(ks[10], (L, DA_QK_DIM)),
        'da_k_gain': gain(ks[11], (L, DA_QK_DIM)),
        'da_lambda': nrm(ks[12], (L, 4, DA_QK_DIM), 0.1),
        'da_sub_gain': gain(ks[13], (L, DA_V_DIM)),
        'hg_lb_logits': nrm(ks[14], (L, 2, GROUP_WIDTH), 0.5),
        'hg_out_gain': gain(ks[15], (L, HG_DV)),
        'na_q_gain': gain(ks[16], (L, HEAD_DIM)),
        'na_k_gain': gain(ks[17], (L, HEAD_DIM)),
        'na_rpb': nrm(ks[18], (L, NA_HEADS, 2 * NA_KH - 1, 2 * NA_KW - 1), 0.1),
        'sw_q_gain': gain(ks[19], (L, HEAD_DIM)),
        'sw_k_gain': gain(ks[20], (L, HEAD_DIM)),
        'sw_sink': nrm(ks[21], (L, SW_HEADS), 1.0),
        'w_ff1': nrm(ks[22], (L, D_MODEL, D_FF), D_MODEL ** -0.5),
        'w_ff2': nrm(ks[23], (L, D_FF, D_MODEL), D_FF ** -0.5),
    }


def reference(x, c, ctx, c_ctx, w_mod, b_mod, norm1_g, norm2_g, w_in, w_out,
              da_q_gain, da_k_gain, da_lambda, da_sub_gain, hg_lb_logits, hg_out_gain,
              na_q_gain, na_k_gain, na_rpb, sw_q_gain, sw_k_gain, sw_sink, w_ff1, w_ff2):
    seq = x.shape[1]
    rope_da = axial_rope_tables(seq, DA_QK_DIM, x.dtype)
    rope_sw = axial_rope_tables(seq, HEAD_DIM, x.dtype)
    lb_soft = jax.nn.softmax(hg_lb_logits.astype(jnp.float32), axis=0)
    lower_bounds = jnp.cumsum(lb_soft, axis=0) - lb_soft[0]
    for layer in range(DEPTH):
        need_ctx = layer < DEPTH - 1
        lam_init = 0.8 - 0.6 * math.exp(-0.3 * layer)
        mod_l = [m[:, None, :] for m in adaln_params(c, w_mod[layer], b_mod[layer])]
        mod_c = adaln_params(c_ctx, w_mod[layer], b_mod[layer])
        p_l = split_cols(modulate(x, norm1_g[layer], mod_l[0], mod_l[1]) @ w_in[layer])
        p_c = split_cols(modulate(ctx, norm1_g[layer], mod_c[0], mod_c[1]) @ w_in[layer])
        a_l, a_c = diff_attention(p_l[0:3], p_c[0:3], da_q_gain[layer], da_k_gain[layer], da_lambda[layer],
                                  da_sub_gain[layer], lam_init, rope_da, need_ctx)
        b_l, b_c = hgrn2_mixer(p_l[3:8], p_c[3:8], lower_bounds[layer], hg_out_gain[layer], need_ctx)
        n_l, n_c = neighbourhood_attention(p_l[8:11], p_c[8:11], na_q_gain[layer], na_k_gain[layer],
                                           na_rpb[layer], need_ctx)
        w_l, w_c = window_gqa(p_l[11:14], p_c[11:14], sw_q_gain[layer], sw_k_gain[layer], sw_sink[layer],
                              rope_sw, need_ctx)
        x = x + mod_l[2] * (jnp.concatenate([a_l, b_l, n_l, w_l], axis=-1) @ w_out[layer])
        x = x + mod_l[5] * squared_relu_mlp(modulate(x, norm2_g[layer], mod_l[3], mod_l[4]),
                                            w_ff1[layer], w_ff2[layer])
        if need_ctx:
            ctx = ctx + mod_c[2] * (jnp.concatenate([a_c, b_c, n_c, w_c], axis=-1) @ w_out[layer])
            ctx = ctx + mod_c[5] * squared_relu_mlp(modulate(ctx, norm2_g[layer], mod_c[3], mod_c[4]),
                                                    w_ff1[layer], w_ff2[layer])
    return x
```

```cpp
#include <hip/hip_runtime.h>
#include <hip/hip_cooperative_groups.h>
#include <cstdio>
#include <cstdint>
namespace cg = cooperative_groups;

#ifndef MULTI_LAUNCH
#define MULTI_LAUNCH 0
#endif

#define DI __device__ __forceinline__
typedef unsigned short bf16_t;
typedef short bf16x8 __attribute__((ext_vector_type(8)));
typedef float f32x16 __attribute__((ext_vector_type(16)));
typedef float f32x4 __attribute__((ext_vector_type(4)));
typedef float f32x2 __attribute__((ext_vector_type(2)));
typedef unsigned u32x4 __attribute__((ext_vector_type(4)));
typedef unsigned u32x2 __attribute__((ext_vector_type(2)));
typedef __bf16 bf16x2_t __attribute__((ext_vector_type(2)));

constexpr int SEQ = 16384, CTX = 256, DM = 1024, TL = 32768, TC = 512, TA = 33280, NP = 3328, DFF = 4096, UA = 16640;
constexpr int NCHUNK = 260;
constexpr float EPS = 1e-6f, LOG2E = 1.4426950408889634f;
constexpr int SMEM_BYTES = 73728;
constexpr int LDS_STRIDE = 144;

#define MFMA32(a, b, c) __builtin_amdgcn_mfma_f32_32x32x16_bf16((a), (b), (c), 0, 0, 0)

DI unsigned pk2(float a, float b) { f32x2 v = {a, b}; return __builtin_bit_cast(unsigned, __builtin_convertvector(v, bf16x2_t)); }
DI float bf_lo(unsigned u) { return __uint_as_float(u << 16); }
DI float bf_hi(unsigned u) { return __uint_as_float(u & 0xffff0000u); }
DI bf16_t tobf(float a) { return (bf16_t)(pk2(a, 0.f) & 0xffffu); }
DI float fexp2(float x) { return __builtin_amdgcn_exp2f(x); }
DI float wave_sum(float v) {
#pragma unroll
  for (int o = 32; o > 0; o >>= 1) v += __shfl_xor(v, o);
  return v;
}
DI float wave_max(float v) {
#pragma unroll
  for (int o = 32; o > 0; o >>= 1) v = fmaxf(v, __shfl_xor(v, o));
  return v;
}
DI int rowOfU(int b, int u) { return u < CTX ? TL + b * CTX + u : b * SEQ + (u - CTX); }

struct Params {
  const float *x, *c, *ctx, *c_ctx, *w_mod, *b_mod, *norm1_g, *norm2_g, *w_in, *w_out;
  const float *da_q_gain, *da_k_gain, *da_lambda, *da_sub_gain, *hg_lb_logits, *hg_out_gain;
  const float *na_q_gain, *na_k_gain, *na_rpb, *sw_q_gain, *sw_k_gain, *sw_sink, *w_ff1, *w_ff2;
  float* out;
  float* Xc;
  float* mod;
  float* Hdec;
  bf16_t* WinT;
  bf16_t* WoutT;
  bf16_t* W1T;
  bf16_t* W2T;
  bf16_t* H;
  float* HL;
  bf16_t* P;
  bf16_t* MO;
  bf16_t* VtA;
  bf16_t* VtC;
  bf16_t* VtD;
};

DI void phase0(const Params& p, unsigned char* smem, int bid, int nb) {
  const int tid = threadIdx.x;
  constexpr int n_mod = 2 * 96;
  constexpr int t_in = 16 * 52, t_out = 16 * 16, t_f1 = 16 * 64, t_f2 = 64 * 16;
  constexpr int per_layer = t_in + t_out + t_f1 + t_f2;
  constexpr int total = n_mod + 2 * per_layer;
  float* fs = (float*)smem;
  for (int it = bid; it < total; it += nb) {
    if (it < n_mod) {
      const int l = it / 96, col0 = (it % 96) * 64;
      float* sc = fs;
      float* red = fs + 3072;
      for (int i = tid; i < 3072; i += 256) {
        const int cond = i >> 10, k = i & 1023;
        const float v = cond == 0 ? p.c[k] : (cond == 1 ? p.c[1024 + k] : p.c_ctx[k]);
        sc[i] = v / (1.f + expf(-v));
      }
      __syncthreads();
      const int kg = tid >> 6, j = tid & 63;
      float a0 = 0.f, a1 = 0.f, a2 = 0.f;
      const float* wp = p.w_mod + ((size_t)l * 1024 + kg * 256) * 6144 + col0 + j;
#pragma unroll 8
      for (int k = 0; k < 256; ++k) {
        const float w = wp[(size_t)k * 6144];
        a0 += sc[kg * 256 + k] * w; a1 += sc[1024 + kg * 256 + k] * w; a2 += sc[2048 + kg * 256 + k] * w;
      }
      red[(kg * 3 + 0) * 64 + j] = a0; red[(kg * 3 + 1) * 64 + j] = a1; red[(kg * 3 + 2) * 64 + j] = a2;
      __syncthreads();
      if (tid < 192) {
        const int cond = tid >> 6, jj = tid & 63;
        float s = p.b_mod[l * 6144 + col0 + jj];
#pragma unroll
        for (int g = 0; g < 4; ++g) s += red[(g * 3 + cond) * 64 + jj];
        p.mod[(l * 3 + cond) * 6144 + col0 + jj] = s;
      }
    } else {
      int idx = it - n_mod;
      const int l = idx / per_layer; idx -= l * per_layer;
      const float* src; bf16_t* dst; int K, N;
      if (idx < t_in) { src = p.w_in + (size_t)l * 1024 * NP; dst = p.WinT + (size_t)l * NP * 1024; K = 1024; N = NP; }
      else if (idx < t_in + t_out) { idx -= t_in; src = p.w_out + (size_t)l * 1024 * 1024; dst = p.WoutT + (size_t)l * 1024 * 1024; K = 1024; N = 1024; }
      else if (idx < t_in + t_out + t_f1) { idx -= t_in + t_out; src = p.w_ff1 + (size_t)l * 1024 * DFF; dst = p.W1T + (size_t)l * DFF * 1024; K = 1024; N = DFF; }
      else { idx -= t_in + t_out + t_f1; src = p.w_ff2 + (size_t)l * DFF * 1024; dst = p.W2T + (size_t)l * 1024 * DFF; K = DFF; N = 1024; }
      const int ntn = N >> 6, kt = idx / ntn, nt = idx % ntn, k0 = kt * 64, n0 = nt * 64;
#pragma unroll
      for (int i = 0; i < 4; ++i) {
        const int r = (tid >> 4) + 16 * i, c4 = (tid & 15) * 4;
        const f32x4 v = *(const f32x4*)(src + (size_t)(k0 + r) * N + n0 + c4);
        fs[r * 65 + c4] = v[0]; fs[r * 65 + c4 + 1] = v[1]; fs[r * 65 + c4 + 2] = v[2]; fs[r * 65 + c4 + 3] = v[3];
      }
      __syncthreads();
      const int n = tid >> 2, kq = (tid & 3) * 16;
      u32x4 w0, w1;
#pragma unroll
      for (int i = 0; i < 4; ++i) {
        w0[i] = pk2(fs[(kq + 2 * i) * 65 + n], fs[(kq + 2 * i + 1) * 65 + n]);
        w1[i] = pk2(fs[(kq + 8 + 2 * i) * 65 + n], fs[(kq + 8 + 2 * i + 1) * 65 + n]);
      }
      bf16_t* dp = dst + (size_t)(n0 + n) * K + k0 + kq;
      *(u32x4*)dp = w0; *(u32x4*)(dp + 8) = w1;
    }
    __syncthreads();
  }
}

DI void norm_phase(const float* lat, const float* ctxp, int nrows, const float* g, const float* modl, int shift_off, int scale_off,
                   bf16_t* H, int bid, int nb) {
  const int wave = threadIdx.x >> 6, lane = threadIdx.x & 63;
  for (int r4 = bid; r4 < nrows / 4; r4 += nb) {
    const int row = r4 * 4 + wave;
    const float* src = row < TL ? lat + (size_t)row * DM : ctxp + (size_t)(row - TL) * DM;
    const int mi = row < TL ? (row >> 14) : 2;
    const float* sh = modl + mi * 6144 + shift_off;
    const float* sc = modl + mi * 6144 + scale_off;
    f32x4 v[4]; float ss = 0.f;
#pragma unroll
    for (int i = 0; i < 4; ++i) { v[i] = *(const f32x4*)(src + lane * 4 + 256 * i); ss += v[i][0] * v[i][0] + v[i][1] * v[i][1] + v[i][2] * v[i][2] + v[i][3] * v[i][3]; }
    ss = wave_sum(ss);
    const float rs = rsqrtf(ss * (1.f / 1024.f) + EPS);
#pragma unroll
    for (int i = 0; i < 4; ++i) {
      const int col = lane * 4 + 256 * i;
      const f32x4 gg = *(const f32x4*)(g + col), s4 = *(const f32x4*)(sc + col), h4 = *(const f32x4*)(sh + col);
      float y[4];
#pragma unroll
      for (int j = 0; j < 4; ++j) y[j] = (v[i][j] * rs * gg[j]) * (1.f + s4[j]) + h4[j];
      u32x2 w; w[0] = pk2(y[0], y[1]); w[1] = pk2(y[2], y[3]);
      *(u32x2*)(H + (size_t)row * DM + col) = w;
    }
  }
}

struct EpiBf16 {
  bf16_t* O; int ldc;
  DI void operator()(int m, int n, f32x4 v) const {
    u32x2 w; w[0] = pk2(v[0], v[1]); w[1] = pk2(v[2], v[3]);
    *(u32x2*)(O + (size_t)m * ldc + n) = w;
  }
};
struct EpiRelu2 {
  bf16_t* O; int ldc;
  DI void operator()(int m, int n, f32x4 v) const {
    float y[4];
#pragma unroll
    for (int j = 0; j < 4; ++j) { const float t = fmaxf(v[j], 0.f); y[j] = t * t; }
    u32x2 w; w[0] = pk2(y[0], y[1]); w[1] = pk2(y[2], y[3]);
    *(u32x2*)(O + (size_t)m * ldc + n) = w;
  }
};
struct EpiResid {
  const float* sl; const float* sc; float* dl; float* dc; const float* gate; int row0;
  DI void operator()(int m, int n, f32x4 v) const {
    const int row = m + row0;
    const float* s = row < TL ? sl + (size_t)row * DM : sc + (size_t)(row - TL) * DM;
    float* d = row < TL ? dl + (size_t)row * DM : dc + (size_t)(row - TL) * DM;
    const int mi = row < TL ? (row >> 14) : 2;
    const f32x4 g = *(const f32x4*)(gate + mi * 6144 + n);
    const f32x4 r = *(const f32x4*)(s + n);
    f32x4 o;
#pragma unroll
    for (int j = 0; j < 4; ++j) o[j] = r[j] + g[j] * v[j];
    *(f32x4*)(d + n) = o;
  }
};

template <class Epi>
DI void gemm_phase(const bf16_t* A, const bf16_t* Bt, int mtiles, int ntiles, int K, const Epi& epi, unsigned char* smem, int bid, int nb) {
  const int tid = threadIdx.x, lane = tid & 63, wave = tid >> 6;
  const int wm = wave & 1, wn = wave >> 1, l31 = lane & 31, hh = lane >> 5;
  unsigned char* As0 = smem;
  unsigned char* Bs0 = smem + 2 * 128 * LDS_STRIDE;
  const int nk = K >> 6;
  const int ldrow = tid >> 3, ldcol = (tid & 7) * 8;
  const int total = mtiles * ntiles;
  for (int it = bid; it < total; it += nb) {
    const int pm = it / ntiles, pn = it % ntiles;
    const bf16_t* Ap = A + (size_t)(pm * 128 + ldrow) * K + ldcol;
    const bf16_t* Bp = Bt + (size_t)(pn * 128 + ldrow) * K + ldcol;
    f32x16 acc[2][2];
#pragma unroll
    for (int a = 0; a < 2; ++a)
#pragma unroll
      for (int b = 0; b < 2; ++b)
#pragma unroll
        for (int i = 0; i < 16; ++i) acc[a][b][i] = 0.f;
    u32x4 ra[4], rb[4];
#pragma unroll
    for (int i = 0; i < 4; ++i) { ra[i] = *(const u32x4*)(Ap + (size_t)i * 32 * K); rb[i] = *(const u32x4*)(Bp + (size_t)i * 32 * K); }
#pragma unroll
    for (int i = 0; i < 4; ++i) {
      *(u32x4*)(As0 + (ldrow + 32 * i) * LDS_STRIDE + ldcol * 2) = ra[i];
      *(u32x4*)(Bs0 + (ldrow + 32 * i) * LDS_STRIDE + ldcol * 2) = rb[i];
    }
    __syncthreads();
    for (int kt = 0; kt < nk; ++kt) {
      const int buf = kt & 1;
      if (kt + 1 < nk) {
#pragma unroll
        for (int i = 0; i < 4; ++i) { ra[i] = *(const u32x4*)(Ap + (size_t)i * 32 * K + (kt + 1) * 64); rb[i] = *(const u32x4*)(Bp + (size_t)i * 32 * K + (kt + 1) * 64); }
      }
      const unsigned char* As = As0 + buf * 128 * LDS_STRIDE;
      const unsigned char* Bs = Bs0 + buf * 128 * LDS_STRIDE;
#pragma unroll
      for (int ks = 0; ks < 4; ++ks) {
        bf16x8 wf[2], af[2];
#pragma unroll
        for (int i = 0; i < 2; ++i) {
          wf[i] = *(const bf16x8*)(Bs + (wn * 64 + i * 32 + l31) * LDS_STRIDE + (ks * 16 + 8 * hh) * 2);
          af[i] = *(const bf16x8*)(As + (wm * 64 + i * 32 + l31) * LDS_STRIDE + (ks * 16 + 8 * hh) * 2);
        }
#pragma unroll
        for (int ni = 0; ni < 2; ++ni)
#pragma unroll
          for (int mi = 0; mi < 2; ++mi) acc[ni][mi] = MFMA32(wf[ni], af[mi], acc[ni][mi]);
      }
      if (kt + 1 < nk) {
        unsigned char* Aw = As0 + (buf ^ 1) * 128 * LDS_STRIDE;
        unsigned char* Bw = Bs0 + (buf ^ 1) * 128 * LDS_STRIDE;
#pragma unroll
        for (int i = 0; i < 4; ++i) {
          *(u32x4*)(Aw + (ldrow + 32 * i) * LDS_STRIDE + ldcol * 2) = ra[i];
          *(u32x4*)(Bw + (ldrow + 32 * i) * LDS_STRIDE + ldcol * 2) = rb[i];
        }
      }
      __syncthreads();
    }
#pragma unroll
    for (int ni = 0; ni < 2; ++ni)
#pragma unroll
      for (int mi = 0; mi < 2; ++mi) {
        const int m = pm * 128 + wm * 64 + mi * 32 + l31;
#pragma unroll
        for (int g = 0; g < 4; ++g) {
          const int n = pn * 128 + wn * 64 + ni * 32 + 8 * g + 4 * hh;
          f32x4 v = {acc[ni][mi][4 * g], acc[ni][mi][4 * g + 1], acc[ni][mi][4 * g + 2], acc[ni][mi][4 * g + 3]};
          epi(m, n, v);
        }
      }
  }
}

DI float hg_lb(const Params& p, int layer, int d, int j) {
  if (layer == 0) return 0.f;
  const float l0 = p.hg_lb_logits[d * 256 + j], l1 = p.hg_lb_logits[512 + d * 256 + j];
  return 1.f / (1.f + expf(l0 - l1));
}

DI void prep32_item(const Params& p, int layer, int it) {
  const int idx = it * 256 + threadIdx.x;
  const int row = idx >> 4, j = idx & 15, isk = j >> 3, sub = j & 7;
  bf16_t* ptr = p.P + (size_t)row * NP + isk * 256 + sub * 32;
  const float* gain = (isk ? p.da_k_gain : p.da_q_gain) + layer * 32;
  float v[32];
#pragma unroll
  for (int i = 0; i < 4; ++i) {
    const u32x4 w = *(const u32x4*)(ptr + 8 * i);
#pragma unroll
    for (int q = 0; q < 4; ++q) { v[8 * i + 2 * q] = bf_lo(w[q]); v[8 * i + 2 * q + 1] = bf_hi(w[q]); }
  }
  float ss = 0.f;
#pragma unroll
  for (int i = 0; i < 32; ++i) ss += v[i] * v[i];
  const float r = rsqrtf(ss * (1.f / 32.f) + EPS);
#pragma unroll
  for (int i = 0; i < 32; ++i) v[i] = v[i] * r * gain[i];
  if (row < TL) {
    const int t = row & (SEQ - 1);
    const float gr = (float)(t >> 6), gc = (float)(t & 63);
#pragma unroll
    for (int i = 0; i < 8; ++i) {
      const float fr = exp2f(-(float)i * (13.287712379549449f / 8.f));
      const float ar = gr * fr, ac = gc * fr;
      const float cr = __cosf(ar), sr = __sinf(ar), cc = __cosf(ac), sc = __sinf(ac);
      const float x1 = v[i], x2 = v[8 + i];
      v[i] = x1 * cr - x2 * sr; v[8 + i] = x1 * sr + x2 * cr;
      const float y1 = v[16 + i], y2 = v[24 + i];
      v[16 + i] = y1 * cc - y2 * sc; v[24 + i] = y1 * sc + y2 * cc;
    }
  }
  const float qs = isk ? 1.f : (0.17677669529663687f * LOG2E);
#pragma unroll
  for (int i = 0; i < 4; ++i) {
    u32x4 w;
#pragma unroll
    for (int q = 0; q < 4; ++q) w[q] = pk2(v[8 * i + 2 * q] * qs, v[8 * i + 2 * q + 1] * qs);
    *(u32x4*)(ptr + 8 * i) = w;
  }
}

DI void prep64_item(const Params& p, int layer, int it) {
  const int idx = it * 256 + threadIdx.x;
  const int row = idx / 14, j = idx % 14;
  int col; const float* gain; bool rope, isq;
  if (j < 4) { col = 2048 + 64 * j; gain = p.na_q_gain; rope = false; isq = true; }
  else if (j < 8) { col = 2304 + 64 * (j - 4); gain = p.na_k_gain; rope = false; isq = false; }
  else if (j < 12) { col = 2816 + 64 * (j - 8); gain = p.sw_q_gain; rope = true; isq = true; }
  else { col = 3072 + 64 * (j - 12); gain = p.sw_k_gain; rope = true; isq = false; }
  gain += layer * 64;
  bf16_t* ptr = p.P + (size_t)row * NP + col;
  float v[64];
#pragma unroll
  for (int i = 0; i < 8; ++i) {
    const u32x4 w = *(const u32x4*)(ptr + 8 * i);
#pragma unroll
    for (int q = 0; q < 4; ++q) { v[8 * i + 2 * q] = bf_lo(w[q]); v[8 * i + 2 * q + 1] = bf_hi(w[q]); }
  }
  float ss = 0.f;
#pragma unroll
  for (int i = 0; i < 64; ++i) ss += v[i] * v[i];
  const float r = rsqrtf(ss * (1.f / 64.f) + EPS);
#pragma unroll
  for (int i = 0; i < 64; ++i) v[i] = v[i] * r * gain[i];
  if (rope && row < TL) {
    const int t = row & (SEQ - 1);
    const float gr = (float)(t >> 6), gc = (float)(t & 63);
#pragma unroll
    for (int i = 0; i < 16; ++i) {
      const float fr = exp2f(-(float)i * (13.287712379549449f / 16.f));
      const float ar = gr * fr, ac = gc * fr;
      const float cr = __cosf(ar), sr = __sinf(ar), cc = __cosf(ac), sc = __sinf(ac);
      const float x1 = v[i], x2 = v[16 + i];
      v[i] = x1 * cr - x2 * sr; v[16 + i] = x1 * sr + x2 * cr;
      const float y1 = v[32 + i], y2 = v[48 + i];
      v[32 + i] = y1 * cc - y2 * sc; v[48 + i] = y1 * sc + y2 * cc;
    }
  }
  const float qs = isq ? (0.125f * LOG2E) : 1.f;
#pragma unroll
  for (int i = 0; i < 8; ++i) {
    u32x4 w;
#pragma unroll
    for (int q = 0; q < 4; ++q) w[q] = pk2(v[8 * i + 2 * q] * qs, v[8 * i + 2 * q + 1] * qs);
    *(u32x4*)(ptr + 8 * i) = w;
  }
}

DI void vt_item(const Params& p, int it, unsigned char* smem) {
  const int tid = threadIdx.x;
  const int hv = it % 10, ug = (it / 10) % NCHUNK, b = it / (10 * NCHUNK);
  int vcol; bf16_t* dst;
  if (hv < 4) { vcol = 512 + 64 * hv; dst = p.VtA + (size_t)(b * 4 + hv) * 64 * UA; }
  else if (hv < 8) { vcol = 2560 + 64 * (hv - 4); dst = p.VtC + (size_t)(b * 4 + hv - 4) * 64 * UA; }
  else { vcol = 3200 + 64 * (hv - 8); dst = p.VtD + (size_t)(b * 2 + hv - 8) * 64 * UA; }
  const int u0 = ug * 64;
  bf16_t* tile = (bf16_t*)smem;
  {
    const int tk = tid >> 2, seg = (tid & 3) * 16;
    const int row = rowOfU(b, u0 + tk);
    const bf16_t* src = p.P + (size_t)row * NP + vcol + seg;
    const u32x4 w0 = *(const u32x4*)src, w1 = *(const u32x4*)(src + 8);
    unsigned* tp = (unsigned*)(tile + tk * 66 + seg);
#pragma unroll
    for (int q = 0; q < 4; ++q) { tp[q] = w0[q]; tp[4 + q] = w1[q]; }
  }
  __syncthreads();
  {
    const int dv = tid >> 2, tq = (tid & 3) * 16;
    u32x4 w0, w1;
#pragma unroll
    for (int q = 0; q < 4; ++q) {
      w0[q] = (unsigned)tile[(tq + 2 * q) * 66 + dv] | ((unsigned)tile[(tq + 2 * q + 1) * 66 + dv] << 16);
      w1[q] = (unsigned)tile[(tq + 8 + 2 * q) * 66 + dv] | ((unsigned)tile[(tq + 8 + 2 * q + 1) * 66 + dv] << 16);
    }
    bf16_t* dp = dst + (size_t)dv * UA + u0 + tq;
    *(u32x4*)dp = w0; *(u32x4*)(dp + 8) = w1;
  }
  __syncthreads();
}

DI int hg_row(int b, int d, int n, int pp) {
  if (n < 4) { const int c = d ? 255 - (64 * n + pp) : 64 * n + pp; return TL + b * CTX + c; }
  const int t = d ? SEQ - 1 - (64 * (n - 4) + pp) : 64 * (n - 4) + pp;
  return b * SEQ + t;
}

DI void hgsum_item(const Params& p, int layer, int it, unsigned char* smem) {
  const int tid = threadIdx.x;
  const int n = it % NCHUNK, chain = it / NCHUNK, d = chain & 1, hh = (chain >> 1) & 3, b = chain >> 3;
  float* cumT = (float*)smem;
  float* wk = cumT + 64 * 65;
  float* vv = wk + 64 * 64;
  const int pp = tid >> 2, kq = (tid & 3) * 16;
  {
    const int row = hg_row(b, d, n, pp);
    const bf16_t* pr = p.P + (size_t)row * NP;
    const bf16_t* fp = pr + 1536 + d * 256 + hh * 64 + kq;
    const bf16_t* vp = pr + 1024 + hh * 64 + kq;
    const u32x4 f0 = *(const u32x4*)fp, f1 = *(const u32x4*)(fp + 8), v0 = *(const u32x4*)vp, v1 = *(const u32x4*)(vp + 8);
    float fx[16], vx[16];
#pragma unroll
    for (int q = 0; q < 4; ++q) { fx[2 * q] = bf_lo(f0[q]); fx[2 * q + 1] = bf_hi(f0[q]); fx[8 + 2 * q] = bf_lo(f1[q]); fx[8 + 2 * q + 1] = bf_hi(f1[q]);
                                  vx[2 * q] = bf_lo(v0[q]); vx[2 * q + 1] = bf_hi(v0[q]); vx[8 + 2 * q] = bf_lo(v1[q]); vx[8 + 2 * q + 1] = bf_hi(v1[q]); }
#pragma unroll
    for (int j = 0; j < 16; ++j) {
      const float lb = hg_lb(p, layer, d, hh * 64 + kq + j);
      const float sg = 1.f / (1.f + expf(-fx[j]));
      const float f = lb + (1.f - lb) * sg;
      cumT[(kq + j) * 65 + pp] = logf(f) * LOG2E;
      wk[pp * 64 + kq + j] = 1.f - f;
      vv[pp * 64 + kq + j] = vx[j];
    }
  }
  __syncthreads();
  if (tid < 64) {
    float run = 0.f;
    for (int q = 0; q < 64; ++q) { run += cumT[tid * 65 + q]; cumT[tid * 65 + q] = run; }
  }
  __syncthreads();
#pragma unroll
  for (int j = 0; j < 16; ++j) {
    const int k = kq + j;
    wk[pp * 64 + k] *= fexp2(cumT[k * 65 + 63] - cumT[k * 65 + pp]);
  }
  __syncthreads();
  {
    const int kg = tid >> 6, v = tid & 63;
    float acc[16];
#pragma unroll
    for (int j = 0; j < 16; ++j) acc[j] = 0.f;
    for (int q = 0; q < 64; ++q) {
      const float vq = vv[q * 64 + v];
#pragma unroll
      for (int j4 = 0; j4 < 4; ++j4) {
        const f32x4 w4 = *(const f32x4*)(wk + q * 64 + kg * 16 + 4 * j4);
#pragma unroll
        for (int a = 0; a < 4; ++a) acc[4 * j4 + a] += w4[a] * vq;
      }
    }
    float* L = p.HL + ((size_t)(chain * NCHUNK + n)) * 4096;
#pragma unroll
    for (int j = 0; j < 16; ++j) L[(kg * 16 + j) * 64 + v] = acc[j];
    if (tid < 64) p.Hdec[(chain * NCHUNK + n) * 64 + tid] = fexp2(cumT[tid * 65 + 63]);
  }
  __syncthreads();
}

DI void prep_phase(const Params& p, int layer, unsigned char* smem, int bid, int nb) {
  constexpr int n_hg = 16 * NCHUNK;
  constexpr int n_vt = 2 * NCHUNK * 10;
  constexpr int n_p32 = TA * 16 / 256;
  constexpr int n_p64 = TA * 14 / 256;
  constexpr int total = n_hg + n_vt + n_p32 + n_p64;
  for (int it = bid; it < total; it += nb) {
    if (it < n_hg) hgsum_item(p, layer, it, smem);
    else if (it < n_hg + n_vt) vt_item(p, it - n_hg, smem);
    else if (it < n_hg + n_vt + n_p32) prep32_item(p, layer, it - n_hg - n_vt);
    else prep64_item(p, layer, it - n_hg - n_vt - n_p32);
  }
}

DI void scan_item(const Params& p, int it) {
  const int chain = it >> 4, e = (it & 15) * 256 + threadIdx.x, k = e >> 6;
  float* L = p.HL + (size_t)chain * NCHUNK * 4096 + e;
  const float* dc = p.Hdec + chain * NCHUNK * 64 + k;
  float S = 0.f;
  for (int n0 = 0; n0 < NCHUNK; n0 += 10) {
    float l[10], dd[10];
#pragma unroll
    for (int j = 0; j < 10; ++j) { l[j] = L[(size_t)(n0 + j) * 4096]; dd[j] = dc[(n0 + j) * 64]; }
#pragma unroll
    for (int j = 0; j < 10; ++j) { L[(size_t)(n0 + j) * 4096] = S; S = dd[j] * S + l[j]; }
  }
}

DI void attnA_wave(const Params& p, int layer, int b, int h, int qrow0, int ubeg, int uend) {
  const int lane = threadIdx.x & 63, qi = lane & 31, hh = lane >> 5;
  const int pr = (qi & 19) | ((qi & 4) << 1) | ((qi & 8) >> 1);
  const float lam_init = layer == 0 ? 0.2f : 0.35550906759096f;
  float gq = lane < 32 ? fabsf(p.da_q_gain[layer * 32 + lane]) : 0.f, gk = lane < 32 ? fabsf(p.da_k_gain[layer * 32 + lane]) : 0.f;
  gq = wave_max(gq); gk = wave_max(gk);
  const float negM2 = -(0.17677669529663687f * LOG2E * 32.f * 1.02f) * gq * gk;
  float la = 0.f, lb_ = 0.f;
  if (lane < 32) { const float* lv = p.da_lambda + layer * 128; la = lv[lane] * lv[32 + lane]; lb_ = lv[64 + lane] * lv[96 + lane]; }
  la = wave_sum(la); lb_ = wave_sum(lb_);
  const float lam = expf(la) - expf(lb_) + lam_init;

  const bf16_t* qp = p.P + (size_t)(qrow0 + qi) * NP + h * 64 + 8 * hh;
  bf16x8 qf[2][2];
#pragma unroll
  for (int m = 0; m < 2; ++m)
#pragma unroll
    for (int ks = 0; ks < 2; ++ks) qf[m][ks] = *(const bf16x8*)(qp + m * 32 + ks * 16);
  const bf16_t* vbase = p.VtA + ((size_t)((b * 4 + h) * 64 + qi)) * UA + 8 * hh;
  const bf16_t* kbase = p.P + 256 + h * 64 + 8 * hh;
  f32x16 o[2][2];
#pragma unroll
  for (int m = 0; m < 2; ++m)
#pragma unroll
    for (int dh = 0; dh < 2; ++dh)
#pragma unroll
      for (int i = 0; i < 16; ++i) o[m][dh][i] = 0.f;
  float ls[2] = {0.f, 0.f};
  bf16x8 kn[2][2], vn[2][2];
  {
    const bf16_t* kp = kbase + (size_t)rowOfU(b, ubeg + pr) * NP;
#pragma unroll
    for (int m = 0; m < 2; ++m)
#pragma unroll
      for (int ks = 0; ks < 2; ++ks) kn[m][ks] = *(const bf16x8*)(kp + m * 32 + ks * 16);
#pragma unroll
    for (int dh = 0; dh < 2; ++dh)
#pragma unroll
      for (int s2 = 0; s2 < 2; ++s2) vn[dh][s2] = *(const bf16x8*)(vbase + (size_t)dh * 32 * UA + ubeg + s2 * 16);
  }
  for (int u0 = ubeg; u0 < uend; u0 += 32) {
    bf16x8 kf[2][2], vf[2][2];
#pragma unroll
    for (int a = 0; a < 2; ++a)
#pragma unroll
      for (int c = 0; c < 2; ++c) { kf[a][c] = kn[a][c]; vf[a][c] = vn[a][c]; }
    if (u0 + 32 < uend) {
      const bf16_t* kp = kbase + (size_t)rowOfU(b, u0 + 32 + pr) * NP;
#pragma unroll
      for (int m = 0; m < 2; ++m)
#pragma unroll
        for (int ks = 0; ks < 2; ++ks) kn[m][ks] = *(const bf16x8*)(kp + m * 32 + ks * 16);
#pragma unroll
      for (int dh = 0; dh < 2; ++dh)
#pragma unroll
        for (int s2 = 0; s2 < 2; ++s2) vn[dh][s2] = *(const bf16x8*)(vbase + (size_t)dh * 32 * UA + u0 + 32 + s2 * 16);
    }
#pragma unroll
    for (int m = 0; m < 2; ++m) {
      f32x16 s;
#pragma unroll
      for (int i = 0; i < 16; ++i) s[i] = negM2;
      s = MFMA32(kf[m][0], qf[m][0], s);
      s = MFMA32(kf[m][1], qf[m][1], s);
      float pe[16];
#pragma unroll
      for (int i = 0; i < 16; ++i) { pe[i] = fexp2(s[i]); ls[m] += pe[i]; }
#pragma unroll
      for (int s2 = 0; s2 < 2; ++s2) {
        u32x4 pw;
#pragma unroll
        for (int q = 0; q < 4; ++q) pw[q] = pk2(pe[8 * s2 + 2 * q], pe[8 * s2 + 2 * q + 1]);
        const bf16x8 pf = __builtin_bit_cast(bf16x8, pw);
#pragma unroll
        for (int dh = 0; dh < 2; ++dh) o[m][dh] = MFMA32(vf[dh][s2], pf, o[m][dh]);
      }
    }
  }
  const float l0 = ls[0] + __shfl_xor(ls[0], 32), l1 = ls[1] + __shfl_xor(ls[1], 32);
  const float i0 = 1.f / l0, c1 = lam / l1;
  float ss = 0.f;
#pragma unroll
  for (int dh = 0; dh < 2; ++dh)
#pragma unroll
    for (int i = 0; i < 16; ++i) { const float v = o[0][dh][i] * i0 - o[1][dh][i] * c1; o[0][dh][i] = v; ss += v * v; }
  ss += __shfl_xor(ss, 32);
  const float r = rsqrtf(ss * (1.f / 64.f) + EPS) * (1.f - lam_init);
  bf16_t* op = p.MO + (size_t)(qrow0 + qi) * DM + h * 64;
  const float* sg = p.da_sub_gain + layer * 64;
#pragma unroll
  for (int dh = 0; dh < 2; ++dh)
#pragma unroll
    for (int g = 0; g < 4; ++g) {
      const int dv = 32 * dh + 8 * g + 4 * hh;
      const f32x4 g4 = *(const f32x4*)(sg + dv);
      u32x2 w;
      w[0] = pk2(o[0][dh][4 * g] * r * g4[0], o[0][dh][4 * g + 1] * r * g4[1]);
      w[1] = pk2(o[0][dh][4 * g + 2] * r * g4[2], o[0][dh][4 * g + 3] * r * g4[3]);
      *(u32x2*)(op + dv) = w;
    }
}

template <class MaskF>
DI void attn64_step(const bf16_t* kp  , const bf16_t* vp  ,
                    const bf16x8 (&qf)[4], f32x16 (&o)[2], float& ls, float negM2, int hh, MaskF maskf) {
  bf16x8 kf[4], vf[2][2];
#pragma unroll
  for (int ks = 0; ks < 4; ++ks) kf[ks] = *(const bf16x8*)(kp + ks * 16);
#pragma unroll
  for (int dh = 0; dh < 2; ++dh)
#pragma unroll
    for (int s2 = 0; s2 < 2; ++s2) vf[dh][s2] = *(const bf16x8*)(vp + (size_t)dh * 32 * UA + s2 * 16);
  f32x16 s;
#pragma unroll
  for (int i = 0; i < 16; ++i) s[i] = negM2;
#pragma unroll
  for (int ks = 0; ks < 4; ++ks) s = MFMA32(kf[ks], qf[ks], s);
  float pe[16];
#pragma unroll
  for (int i = 0; i < 16; ++i) { const int kslot = 16 * (i >> 3) + 8 * hh + (i & 7); pe[i] = fexp2(maskf(kslot, s[i])); ls += pe[i]; }
#pragma unroll
  for (int s2 = 0; s2 < 2; ++s2) {
    u32x4 pw;
#pragma unroll
    for (int q = 0; q < 4; ++q) pw[q] = pk2(pe[8 * s2 + 2 * q], pe[8 * s2 + 2 * q + 1]);
    const bf16x8 pf = __builtin_bit_cast(bf16x8, pw);
#pragma unroll
    for (int dh = 0; dh < 2; ++dh) o[dh] = MFMA32(vf[dh][s2], pf, o[dh]);
  }
}

template <int MODE>
DI void attn64_wave(const Params& p, int layer, int b, int hq, int qrow0, int t0) {
  constexpr bool isC = (MODE == 0 || MODE == 2);
  const int lane = threadIdx.x & 63, qi = lane & 31, hh = lane >> 5;
  const int pr = (qi & 19) | ((qi & 4) << 1) | ((qi & 8) >> 1);
  const float* gqp = (isC ? p.na_q_gain : p.sw_q_gain) + layer * 64;
  const float* gkp = (isC ? p.na_k_gain : p.sw_k_gain) + layer * 64;
  const float gq = wave_max(fabsf(gqp[lane])), gk = wave_max(fabsf(gkp[lane]));
  const float negM2 = -(0.125f * LOG2E * 64.f * 1.02f) * gq * gk;
  const int kvh = isC ? hq : (hq >> 1);
  const int qcol = isC ? 2048 + 64 * hq : 2816 + 64 * hq;
  const int kcol = isC ? 2304 + 64 * hq : 3072 + 64 * kvh;
  const bf16_t* vt = isC ? p.VtC + (size_t)(b * 4 + hq) * 64 * UA : p.VtD + (size_t)(b * 2 + kvh) * 64 * UA;
  const bf16_t* vbase = vt + (size_t)qi * UA + 8 * hh;
  const bf16_t* kbase = p.P + kcol + 8 * hh;
  const bf16_t* qp = p.P + (size_t)(qrow0 + qi) * NP + qcol + 8 * hh;
  bf16x8 qf[4];
#pragma unroll
  for (int ks = 0; ks < 4; ++ks) qf[ks] = *(const bf16x8*)(qp + ks * 16);
  f32x16 o[2];
#pragma unroll
  for (int dh = 0; dh < 2; ++dh)
#pragma unroll
    for (int i = 0; i < 16; ++i) o[dh][i] = 0.f;
  float ls = 0.f;
  for (int u0 = 0; u0 < CTX; u0 += 32) {
    const bf16_t* kp = kbase + (size_t)(TL + b * CTX + u0 + pr) * NP;
    attn64_step(kp, vbase + u0, qf, o, ls, negM2, hh, [](int, float s) { return s; });
  }
  if (MODE == 0) {
    const int r = t0 >> 6, c = (t0 & 63) + qi;
    const int rs = min(max(r - 4, 0), 248);
    const int ws = min(max(c - 8, 0), 48);
    const float* rpb = p.na_rpb + (size_t)(layer * 4 + hq) * 15 * 31;
    for (int kr = rs; kr < rs + 8; ++kr) {
      const float* rrow = rpb + (kr - r + 7) * 31 + 15 - c;
#pragma unroll
      for (int hf = 0; hf < 2; ++hf) {
        const int kt0 = kr * 64 + hf * 32;
        const bf16_t* kp = kbase + (size_t)(b * SEQ + kt0 + pr) * NP;
        attn64_step(kp, vbase + CTX + kt0, qf, o, ls, negM2, hh, [&](int kslot, float s) {
          const int kc = hf * 32 + kslot;
          const bool valid = (kc >= ws) && (kc < ws + 16);
          const int kcc = min(max(kc, ws), ws + 15);
          return valid ? s + rrow[kcc] * LOG2E : -1e30f;
        });
      }
    }
  } else if (MODE == 1) {
    const int qt = t0 + qi;
    for (int jt = 0; jt < 9; ++jt) {
      const int kt0 = t0 - 128 + 32 * jt;
      if (kt0 < 0 || kt0 >= SEQ) continue;
      const bf16_t* kp = kbase + (size_t)(b * SEQ + kt0 + pr) * NP;
      if (jt == 0 || jt == 8) {
        attn64_step(kp, vbase + CTX + kt0, qf, o, ls, negM2, hh, [&](int kslot, float s) {
          const int dd = kt0 + kslot - qt;
          return (dd <= 128 && dd >= -128) ? s : -1e30f;
        });
      } else {
        attn64_step(kp, vbase + CTX + kt0, qf, o, ls, negM2, hh, [](int, float s) { return s; });
      }
    }
  }
  float l = ls + __shfl_xor(ls, 32);
  if (!isC) l += fexp2(p.sw_sink[layer * 4 + hq] * LOG2E + negM2);
  const float il = 1.f / l;
  bf16_t* op = p.MO + (size_t)(qrow0 + qi) * DM + (isC ? 512 : 768) + hq * 64;
#pragma unroll
  for (int dh = 0; dh < 2; ++dh)
#pragma unroll
    for (int g = 0; g < 4; ++g) {
      const int dv = 32 * dh + 8 * g + 4 * hh;
      u32x2 w;
      w[0] = pk2(o[dh][4 * g] * il, o[dh][4 * g + 1] * il);
      w[1] = pk2(o[dh][4 * g + 2] * il, o[dh][4 * g + 3] * il);
      *(u32x2*)(op + dv) = w;
    }
}

DI void mix_phase(const Params& p, int layer, int bid, int nb) {
  const int wave = threadIdx.x >> 6;
  const int n_scan = 256, n_lat = 1024, n_ctx = layer == 0 ? 16 : 0;
  const int e0 = n_scan, e1 = e0 + n_lat, e2 = e1 + n_ctx, e3 = e2 + n_lat, e4 = e3 + n_lat, e5 = e4 + n_ctx, e6 = e5 + n_ctx;
  for (int it = bid; it < e6; it += nb) {
    if (it < e0) scan_item(p, it);
    else if (it < e1) {
      const int j = it - e0, qb = j & 127, h = (j >> 7) & 3, b = j >> 9;
      attnA_wave(p, layer, b, h, b * SEQ + qb * 128 + wave * 32, 0, UA);
    } else if (it < e2) {
      const int j = it - e1, qb = j & 1, h = (j >> 1) & 3, b = j >> 3;
      attnA_wave(p, layer, b, h, TL + b * CTX + qb * 128 + wave * 32, 0, CTX);
    } else if (it < e3) {
      const int j = it - e2, qb = j & 127, hq = (j >> 7) & 3, b = j >> 9;
      const int t0 = qb * 128 + wave * 32;
      attn64_wave<1>(p, layer, b, hq, b * SEQ + t0, t0);
    } else if (it < e4) {
      const int j = it - e3, qb = j & 127, hq = (j >> 7) & 3, b = j >> 9;
      const int t0 = qb * 128 + wave * 32;
      attn64_wave<0>(p, layer, b, hq, b * SEQ + t0, t0);
    } else if (it < e5) {
      const int j = it - e4, qb = j & 1, hq = (j >> 1) & 3, b = j >> 3;
      attn64_wave<3>(p, layer, b, hq, TL + b * CTX + qb * 128 + wave * 32, 0);
    } else {
      const int j = it - e5, qb = j & 1, hq = (j >> 1) & 3, b = j >> 3;
      attn64_wave<2>(p, layer, b, hq, TL + b * CTX + qb * 128 + wave * 32, 0);
    }
  }
}

template <int D>
DI void hgrn_dir(const Params& p, int layer, unsigned char* smem, int b, int hh, int n, float (&o)[16]) {
  const int tid = threadIdx.x;
  const int chain = (b * 4 + hh) * 2 + D;
  float* cumT = (float*)smem;
  float* qT = cumT + 64 * 68;
  float* kT = qT + 64 * 68;
  float* vv = kT + 64 * 68;
  {
    const int pp = tid >> 2, kq = (tid & 3) * 16;
    const int row = hg_row(b, D, n, pp);
    const bf16_t* pr = p.P + (size_t)row * NP;
    const bf16_t* qp = pr + 768 + hh * 64 + kq;
    const bf16_t* fp = pr + 1536 + D * 256 + hh * 64 + kq;
    const bf16_t* vp = pr + 1024 + hh * 64 + kq;
    const u32x4 q0 = *(const u32x4*)qp, q1 = *(const u32x4*)(qp + 8), f0 = *(const u32x4*)fp, f1 = *(const u32x4*)(fp + 8),
                v0 = *(const u32x4*)vp, v1 = *(const u32x4*)(vp + 8);
    float qx[16], fx[16], vx[16];
#pragma unroll
    for (int q = 0; q < 4; ++q) {
      qx[2 * q] = bf_lo(q0[q]); qx[2 * q + 1] = bf_hi(q0[q]); qx[8 + 2 * q] = bf_lo(q1[q]); qx[8 + 2 * q + 1] = bf_hi(q1[q]);
      fx[2 * q] = bf_lo(f0[q]); fx[2 * q + 1] = bf_hi(f0[q]); fx[8 + 2 * q] = bf_lo(f1[q]); fx[8 + 2 * q + 1] = bf_hi(f1[q]);
      vx[2 * q] = bf_lo(v0[q]); vx[2 * q + 1] = bf_hi(v0[q]); vx[8 + 2 * q] = bf_lo(v1[q]); vx[8 + 2 * q + 1] = bf_hi(v1[q]);
    }
#pragma unroll
    for (int j = 0; j < 16; ++j) {
      const float lb = hg_lb(p, layer, D, hh * 64 + kq + j);
      const float sg = 1.f / (1.f + expf(-fx[j]));
      const float f = lb + (1.f - lb) * sg;
      cumT[(kq + j) * 68 + pp] = logf(f) * LOG2E;
      qT[(kq + j) * 68 + pp] = qx[j];
      kT[(kq + j) * 68 + pp] = 1.f - f;
      vv[pp * 64 + kq + j] = vx[j];
    }
  }
  __syncthreads();
  if (tid < 64) {
    float run = 0.f;
    for (int q = 0; q < 64; ++q) { run += cumT[tid * 68 + q]; cumT[tid * 68 + q] = run; }
  }
  __syncthreads();
  const int tg = tid >> 6, v = tid & 63, tgp = D ? 3 - tg : tg;
  {
    const float* S = p.HL + ((size_t)(chain * NCHUNK + n)) * 4096 + v;
    for (int k = 0; k < 64; ++k) {
      const float Sv = S[k * 64];
#pragma unroll
      for (int j4 = 0; j4 < 4; ++j4) {
        const f32x4 c4 = *(const f32x4*)(cumT + k * 68 + 16 * tgp + 4 * j4);
        const f32x4 q4 = *(const f32x4*)(qT + k * 68 + 16 * tgp + 4 * j4);
#pragma unroll
        for (int a = 0; a < 4; ++a) { const int j = 4 * j4 + a; o[D ? 15 - j : j] += q4[a] * fexp2(c4[a]) * Sv; }
      }
    }
  }
  const int bt = tid >> 4, bs = tid & 15;
  float sc[4][4];
#pragma unroll
  for (int a = 0; a < 4; ++a)
#pragma unroll
    for (int c = 0; c < 4; ++c) sc[a][c] = 0.f;
  if (bs <= bt) {
    for (int k = 0; k < 64; ++k) {
      const f32x4 ct = *(const f32x4*)(cumT + k * 68 + 4 * bt), qt = *(const f32x4*)(qT + k * 68 + 4 * bt);
      const f32x4 cs = *(const f32x4*)(cumT + k * 68 + 4 * bs), ks = *(const f32x4*)(kT + k * 68 + 4 * bs);
      const float ref = ct[0];
      float et[4], es[4];
#pragma unroll
      for (int a = 0; a < 4; ++a) { et[a] = qt[a] * fexp2(ct[a] - ref); es[a] = ks[a] * fexp2(ref - cs[a]); }
#pragma unroll
      for (int a = 0; a < 4; ++a)
#pragma unroll
        for (int c = 0; c < 4; ++c) sc[a][c] += et[a] * es[c];
    }
  }
  __syncthreads();
#pragma unroll
  for (int a = 0; a < 4; ++a) {
    f32x4 w;
#pragma unroll
    for (int c = 0; c < 4; ++c) w[c] = (bs <= bt && (4 * bs + c) <= (4 * bt + a)) ? sc[a][c] : 0.f;
    *(f32x4*)(kT + (4 * bt + a) * 68 + 4 * bs) = w;
  }
  __syncthreads();
  {
    const int send = 4 * (tgp + 1);
    for (int s4 = 0; s4 < send; ++s4) {
      float vq[4];
#pragma unroll
      for (int c = 0; c < 4; ++c) vq[c] = vv[(4 * s4 + c) * 64 + v];
#pragma unroll
      for (int j = 0; j < 16; ++j) {
        const f32x4 w = *(const f32x4*)(kT + (16 * tgp + j) * 68 + 4 * s4);
        o[D ? 15 - j : j] += w[0] * vq[0] + w[1] * vq[1] + w[2] * vq[2] + w[3] * vq[3];
      }
    }
  }
  __syncthreads();
}

DI void hgout_phase(const Params& p, int layer, unsigned char* smem, int bid, int nb) {
  const int tid = threadIdx.x;
  const int n_lat = 2 * 4 * 256, n_ctx = layer == 0 ? 2 * 4 * 4 : 0;
  for (int it = bid; it < n_lat + n_ctx; it += nb) {
    int b, hh, n0, n1, rowbase;
    if (it < n_lat) { const int m = it & 255; hh = (it >> 8) & 3; b = it >> 10; n0 = 4 + m; n1 = 4 + 255 - m; rowbase = b * SEQ + 64 * m; }
    else { const int j = it - n_lat, mc = j & 3; hh = (j >> 2) & 3; b = j >> 4; n0 = mc; n1 = 3 - mc; rowbase = TL + b * CTX + 64 * mc; }
    float o[16];
#pragma unroll
    for (int j = 0; j < 16; ++j) o[j] = 0.f;
    hgrn_dir<0>(p, layer, smem, b, hh, n0, o);
    hgrn_dir<1>(p, layer, smem, b, hh, n1, o);
    const int tg = tid >> 6, v = tid & 63;
    const float og = p.hg_out_gain[layer * 64 + v];
#pragma unroll
    for (int j = 0; j < 16; ++j) {
      const int row = rowbase + 16 * tg + j;
      const float ss = wave_sum(o[j] * o[j]);
      const float r = rsqrtf(ss * (1.f / 64.f) + EPS);
      const unsigned short gb = p.P[(size_t)row * NP + 1280 + hh * 64 + v];
      const float gx = __uint_as_float(((unsigned)gb) << 16);
      const float y = o[j] * r * og * (gx / (1.f + expf(-gx)));
      p.MO[(size_t)row * DM + 256 + hh * 64 + v] = tobf(y);
    }
  }
}

#if MULTI_LAUNCH
#define SYNC_OR_RETURN(ph) do { if (phase_sel == (ph)) return; } while (0)
#define RUN(ph) (phase_sel == (ph))
#else
#define RUN(ph) (true)
#endif

__global__ void __launch_bounds__(256, 1) fwd_kernel(Params p, int phase_sel) {
  __shared__ __attribute__((aligned(16))) unsigned char smem[SMEM_BYTES];
  const int bid = blockIdx.x, nb = gridDim.x;
#if !MULTI_LAUNCH
  cg::grid_group grid = cg::this_grid();
#define GSYNC() grid.sync()
#else
#define GSYNC() do {} while (0)
#endif
  int ph = 0;
  if (RUN(ph)) phase0(p, smem, bid, nb);
  GSYNC(); ++ph;
  for (int layer = 0; layer < 2; ++layer) {
    const float* modl = p.mod + layer * 3 * 6144;
    const float* rl = layer == 0 ? p.x : p.out;
    const float* rc = layer == 0 ? p.ctx : p.Xc;
    if (RUN(ph)) norm_phase(rl, rc, TA, p.norm1_g + layer * DM, modl, 0, 1024, p.H, bid, nb);
    GSYNC(); ++ph;
    if (RUN(ph)) { EpiBf16 e{p.P, NP}; gemm_phase(p.H, p.WinT + (size_t)layer * NP * 1024, TA / 128, NP / 128, 1024, e, smem, bid, nb); }
    GSYNC(); ++ph;
    if (RUN(ph)) prep_phase(p, layer, smem, bid, nb);
    GSYNC(); ++ph;
    if (RUN(ph)) mix_phase(p, layer, bid, nb);
    GSYNC(); ++ph;
    if (RUN(ph)) hgout_phase(p, layer, smem, bid, nb);
    GSYNC(); ++ph;
    const int mrows = layer == 0 ? TA : TL;
    if (RUN(ph)) { EpiResid e{rl, rc, p.out, p.Xc, modl + 2048, 0}; gemm_phase(p.MO, p.WoutT + (size_t)layer * 1024 * 1024, mrows / 128, 8, 1024, e, smem, bid, nb); }
    GSYNC(); ++ph;
    if (RUN(ph)) norm_phase(p.out, p.Xc, mrows, p.norm2_g + layer * DM, modl, 3072, 4096, p.H, bid, nb);
    GSYNC(); ++ph;
    const int nchunks = layer == 0 ? 3 : 2;
    for (int ch = 0; ch < nchunks; ++ch) {
      const int row0 = ch * 16384, rows = ch < 2 ? 16384 : TC;
      if (RUN(ph)) { EpiRelu2 e{p.P, DFF}; gemm_phase(p.H + (size_t)row0 * DM, p.W1T + (size_t)layer * DFF * 1024, rows / 128, DFF / 128, 1024, e, smem, bid, nb); }
      GSYNC(); ++ph;
      if (RUN(ph)) { EpiResid e{p.out, p.Xc, p.out, p.Xc, modl + 5 * 1024, row0}; gemm_phase(p.P, p.W2T + (size_t)layer * 1024 * DFF, rows / 128, 8, DFF, e, smem, bid, nb); }
      GSYNC(); ++ph;
    }
  }
}

static size_t align_up(size_t v) { return (v + 255) & ~(size_t)255; }

extern "C" void kernel_launch(void* const* d_in, const int* in_sizes, int n_in, void* d_out, int out_size, void* d_ws, size_t ws_size,
                              hipStream_t stream) {
  Params p{};
  const float** f = (const float**)&p;
  for (int i = 0; i < 24; ++i) f[i] = (const float*)d_in[i];
  p.out = (float*)d_out;
  unsigned char* w = (unsigned char*)d_ws; size_t off = 0;
  auto take = [&](size_t bytes) { void* r = w + off; off = align_up(off + bytes); return r; };
  p.Xc = (float*)take((size_t)TC * DM * 4);
  p.mod = (float*)take((size_t)2 * 3 * 6144 * 4);
  p.Hdec = (float*)take((size_t)16 * NCHUNK * 64 * 4);
  p.WinT = (bf16_t*)take((size_t)2 * NP * 1024 * 2);
  p.WoutT = (bf16_t*)take((size_t)2 * 1024 * 1024 * 2);
  p.W1T = (bf16_t*)take((size_t)2 * DFF * 1024 * 2);
  p.W2T = (bf16_t*)take((size_t)2 * DFF * 1024 * 2);
  p.H = (bf16_t*)take((size_t)TA * DM * 2);
  p.HL = (float*)p.H;
  p.P = (bf16_t*)take((size_t)TA * NP * 2);
  p.MO = (bf16_t*)take((size_t)TA * DM * 2);
  p.VtA = (bf16_t*)take((size_t)2 * 4 * 64 * UA * 2);
  p.VtC = (bf16_t*)take((size_t)2 * 4 * 64 * UA * 2);
  p.VtD = (bf16_t*)take((size_t)2 * 2 * 64 * UA * 2);
  if (off > ws_size) { fprintf(stderr, "workspace too small: need %zu have %zu\n", off, ws_size); return; }
#if MULTI_LAUNCH
  const int nphase = 1 + 7 + 6 + 7 + 4;
  for (int ph = 0; ph < nphase; ++ph) hipLaunchKernelGGL(fwd_kernel, dim3(512), dim3(256), 0, stream, p, ph);
#else
  static int grid_blocks = 0;
  if (!grid_blocks) {
    int dev = 0, cus = 0, per_cu = 0;
    (void)hipGetDevice(&dev);
    (void)hipDeviceGetAttribute(&cus, hipDeviceAttributeMultiprocessorCount, dev);
    (void)hipOccupancyMaxActiveBlocksPerMultiprocessor(&per_cu, fwd_kernel, 256, 0);
    if (per_cu > 1) per_cu = 1;
    grid_blocks = cus * per_cu;
  }
  int phase_sel = -1;
  void* args[] = {&p, &phase_sel};
  hipError_t e = hipLaunchCooperativeKernel((void*)fwd_kernel, dim3(grid_blocks), dim3(256), args, 0, stream);
  if (e != hipSuccess) fprintf(stderr, "cooperative launch failed: %s (grid %d)\n", hipGetErrorString(e), grid_blocks);
#endif
}
```

```cpp
#include <hip/hip_runtime.h>
#include <hip/hip_cooperative_groups.h>
#include <cstdio>
#include <cstdint>
namespace cg = cooperative_groups;

#ifndef MULTI_LAUNCH
#define MULTI_LAUNCH 0
#endif

#define DI __device__ __forceinline__
typedef unsigned short bf16_t;
typedef short bf16x8 __attribute__((ext_vector_type(8)));
typedef float f32x16 __attribute__((ext_vector_type(16)));
typedef float f32x4 __attribute__((ext_vector_type(4)));
typedef float f32x2 __attribute__((ext_vector_type(2)));
typedef unsigned u32x4 __attribute__((ext_vector_type(4)));
typedef unsigned u32x2 __attribute__((ext_vector_type(2)));
typedef __bf16 bf16x2_t __attribute__((ext_vector_type(2)));

constexpr int SEQ = 16384, CTX = 256, DM = 1024, TL = 32768, TC = 512, TA = 33280, NP = 3328, DFF = 4096, UA = 16640;
constexpr int NCHUNK = 260;
constexpr float EPS = 1e-6f, LOG2E = 1.4426950408889634f;
constexpr int SMEM_BYTES = 73728;
constexpr int LDS_STRIDE = 144;

#define MFMA32(a, b, c) __builtin_amdgcn_mfma_f32_32x32x16_bf16((a), (b), (c), 0, 0, 0)

DI unsigned pk2(float a, float b) { f32x2 v = {a, b}; return __builtin_bit_cast(unsigned, __builtin_convertvector(v, bf16x2_t)); }
DI float bf_lo(unsigned u) { return __uint_as_float(u << 16); }
DI float bf_hi(unsigned u) { return __uint_as_float(u & 0xffff0000u); }
DI bf16_t tobf(float a) { return (bf16_t)(pk2(a, 0.f) & 0xffffu); }
DI float fexp2(float x) { return __builtin_amdgcn_exp2f(x); }
DI float wave_sum(float v) {
#pragma unroll
  for (int o = 32; o > 0; o >>= 1) v += __shfl_xor(v, o);
  return v;
}
DI float wave_max(float v) {
#pragma unroll
  for (int o = 32; o > 0; o >>= 1) v = fmaxf(v, __shfl_xor(v, o));
  return v;
}
DI int ltid() { int t = threadIdx.x; asm volatile("" : "+v"(t)); return t; }
DI int rowOfU(int b, int u) { return u < CTX ? TL + b * CTX + u : b * SEQ + (u - CTX); }

struct Params {
  const float *x, *c, *ctx, *c_ctx, *w_mod, *b_mod, *norm1_g, *norm2_g, *w_in, *w_out;
  const float *da_q_gain, *da_k_gain, *da_lambda, *da_sub_gain, *hg_lb_logits, *hg_out_gain;
  const float *na_q_gain, *na_k_gain, *na_rpb, *sw_q_gain, *sw_k_gain, *sw_sink, *w_ff1, *w_ff2;
  float* out;
  float* Xc;
  float* mod;
  float* Hdec;
  bf16_t* WinT;
  bf16_t* WoutT;
  bf16_t* W1T;
  bf16_t* W2T;
  bf16_t* H;
  float* HL;
  bf16_t* P;
  bf16_t* MO;
  bf16_t* VtA;
  bf16_t* VtC;
  bf16_t* VtD;
};

DI void phase0(const Params& p, unsigned char* smem, int bid, int nb) {
  const int tid = ltid();
  constexpr int n_mod = 2 * 96;
  constexpr int t_in = 16 * 52, t_out = 16 * 16, t_f1 = 16 * 64, t_f2 = 64 * 16;
  constexpr int per_layer = t_in + t_out + t_f1 + t_f2;
  constexpr int total = n_mod + 2 * per_layer;
  float* fs = (float*)smem;
  for (int it = bid; it < total; it += nb) {
    if (it < n_mod) {
      const int l = it / 96, col0 = (it % 96) * 64;
      float* sc = fs;
      float* red = fs + 3072;
      for (int i = tid; i < 3072; i += 256) {
        const int cond = i >> 10, k = i & 1023;
        const float v = cond == 0 ? p.c[k] : (cond == 1 ? p.c[1024 + k] : p.c_ctx[k]);
        sc[i] = v / (1.f + expf(-v));
      }
      __syncthreads();
      const int kg = tid >> 6, j = tid & 63;
      float a0 = 0.f, a1 = 0.f, a2 = 0.f;
      const float* wp = p.w_mod + ((size_t)l * 1024 + kg * 256) * 6144 + col0 + j;
#pragma unroll 8
      for (int k = 0; k < 256; ++k) {
        const float w = wp[(size_t)k * 6144];
        a0 += sc[kg * 256 + k] * w; a1 += sc[1024 + kg * 256 + k] * w; a2 += sc[2048 + kg * 256 + k] * w;
      }
      red[(kg * 3 + 0) * 64 + j] = a0; red[(kg * 3 + 1) * 64 + j] = a1; red[(kg * 3 + 2) * 64 + j] = a2;
      __syncthreads();
      if (tid < 192) {
        const int cond = tid >> 6, jj = tid & 63;
        float s = p.b_mod[l * 6144 + col0 + jj];
#pragma unroll
        for (int g = 0; g < 4; ++g) s += red[(g * 3 + cond) * 64 + jj];
        p.mod[(l * 3 + cond) * 6144 + col0 + jj] = s;
      }
    } else {
      int idx = it - n_mod;
      const int l = idx / per_layer; idx -= l * per_layer;
      const float* src; bf16_t* dst; int K, N;
      if (idx < t_in) { src = p.w_in + (size_t)l * 1024 * NP; dst = p.WinT + (size_t)l * NP * 1024; K = 1024; N = NP; }
      else if (idx < t_in + t_out) { idx -= t_in; src = p.w_out + (size_t)l * 1024 * 1024; dst = p.WoutT + (size_t)l * 1024 * 1024; K = 1024; N = 1024; }
      else if (idx < t_in + t_out + t_f1) { idx -= t_in + t_out; src = p.w_ff1 + (size_t)l * 1024 * DFF; dst = p.W1T + (size_t)l * DFF * 1024; K = 1024; N = DFF; }
      else { idx -= t_in + t_out + t_f1; src = p.w_ff2 + (size_t)l * DFF * 1024; dst = p.W2T + (size_t)l * 1024 * DFF; K = DFF; N = 1024; }
      const int ntn = N >> 6, kt = idx / ntn, nt = idx % ntn, k0 = kt * 64, n0 = nt * 64;
#pragma unroll
      for (int i = 0; i < 4; ++i) {
        const int r = (tid >> 4) + 16 * i, c4 = (tid & 15) * 4;
        const f32x4 v = *(const f32x4*)(src + (size_t)(k0 + r) * N + n0 + c4);
        fs[r * 65 + c4] = v[0]; fs[r * 65 + c4 + 1] = v[1]; fs[r * 65 + c4 + 2] = v[2]; fs[r * 65 + c4 + 3] = v[3];
      }
      __syncthreads();
      const int n = tid >> 2, kq = (tid & 3) * 16;
      u32x4 w0, w1;
#pragma unroll
      for (int i = 0; i < 4; ++i) {
        w0[i] = pk2(fs[(kq + 2 * i) * 65 + n], fs[(kq + 2 * i + 1) * 65 + n]);
        w1[i] = pk2(fs[(kq + 8 + 2 * i) * 65 + n], fs[(kq + 8 + 2 * i + 1) * 65 + n]);
      }
      bf16_t* dp = dst + (size_t)(n0 + n) * K + k0 + kq;
      *(u32x4*)dp = w0; *(u32x4*)(dp + 8) = w1;
    }
    __syncthreads();
  }
}

DI void norm_phase(const float* lat, const float* ctxp, int nrows, const float* g, const float* modl, int shift_off, int scale_off,
                   bf16_t* H, int bid, int nb) {
  const int wave = ltid() >> 6, lane = ltid() & 63;
  for (int r4 = bid; r4 < nrows / 4; r4 += nb) {
    const int row = r4 * 4 + wave;
    const float* src = row < TL ? lat + (size_t)row * DM : ctxp + (size_t)(row - TL) * DM;
    const int mi = row < TL ? (row >> 14) : 2;
    const float* sh = modl + mi * 6144 + shift_off;
    const float* sc = modl + mi * 6144 + scale_off;
    f32x4 v[4]; float ss = 0.f;
#pragma unroll
    for (int i = 0; i < 4; ++i) { v[i] = *(const f32x4*)(src + lane * 4 + 256 * i); ss += v[i][0] * v[i][0] + v[i][1] * v[i][1] + v[i][2] * v[i][2] + v[i][3] * v[i][3]; }
    ss = wave_sum(ss);
    const float rs = rsqrtf(ss * (1.f / 1024.f) + EPS);
#pragma unroll
    for (int i = 0; i < 4; ++i) {
      const int col = lane * 4 + 256 * i;
      const f32x4 gg = *(const f32x4*)(g + col), s4 = *(const f32x4*)(sc + col), h4 = *(const f32x4*)(sh + col);
      float y[4];
#pragma unroll
      for (int j = 0; j < 4; ++j) y[j] = (v[i][j] * rs * gg[j]) * (1.f + s4[j]) + h4[j];
      u32x2 w; w[0] = pk2(y[0], y[1]); w[1] = pk2(y[2], y[3]);
      *(u32x2*)(H + (size_t)row * DM + col) = w;
    }
  }
}

struct EpiBf16 {
  bf16_t* O; int ldc;
  DI void operator()(int m, int n, f32x4 v) const {
    u32x2 w; w[0] = pk2(v[0], v[1]); w[1] = pk2(v[2], v[3]);
    *(u32x2*)(O + (size_t)m * ldc + n) = w;
  }
};
struct EpiRelu2 {
  bf16_t* O; int ldc;
  DI void operator()(int m, int n, f32x4 v) const {
    float y[4];
#pragma unroll
    for (int j = 0; j < 4; ++j) { const float t = fmaxf(v[j], 0.f); y[j] = t * t; }
    u32x2 w; w[0] = pk2(y[0], y[1]); w[1] = pk2(y[2], y[3]);
    *(u32x2*)(O + (size_t)m * ldc + n) = w;
  }
};
struct EpiResid {
  const float* sl; const float* sc; float* dl; float* dc; const float* gate; int row0;
  DI void operator()(int m, int n, f32x4 v) const {
    const int row = m + row0;
    const float* s = row < TL ? sl + (size_t)row * DM : sc + (size_t)(row - TL) * DM;
    float* d = row < TL ? dl + (size_t)row * DM : dc + (size_t)(row - TL) * DM;
    const int mi = row < TL ? (row >> 14) : 2;
    const f32x4 g = *(const f32x4*)(gate + mi * 6144 + n);
    const f32x4 r = *(const f32x4*)(s + n);
    f32x4 o;
#pragma unroll
    for (int j = 0; j < 4; ++j) o[j] = r[j] + g[j] * v[j];
    *(f32x4*)(d + n) = o;
  }
};

template <class Epi>
DI void gemm_phase(const bf16_t* A, const bf16_t* Bt, int mtiles, int ntiles, int K, const Epi& epi, unsigned char* smem, int bid, int nb) {
  const int tid = ltid(), lane = tid & 63, wave = tid >> 6;
  const int wm = wave & 1, wn = wave >> 1, l31 = lane & 31, hh = lane >> 5;
  unsigned char* As0 = smem;
  unsigned char* Bs0 = smem + 2 * 128 * LDS_STRIDE;
  const int nk = K >> 6;
  const int ldrow = tid >> 3, ldcol = (tid & 7) * 8;
  const int total = mtiles * ntiles;
  for (int it = bid; it < total; it += nb) {
    const int pm = it / ntiles, pn = it % ntiles;
    const bf16_t* Ap = A + (size_t)(pm * 128 + ldrow) * K + ldcol;
    const bf16_t* Bp = Bt + (size_t)(pn * 128 + ldrow) * K + ldcol;
    f32x16 acc[2][2];
#pragma unroll
    for (int a = 0; a < 2; ++a)
#pragma unroll
      for (int b = 0; b < 2; ++b)
#pragma unroll
        for (int i = 0; i < 16; ++i) acc[a][b][i] = 0.f;
    u32x4 ra[4], rb[4];
#pragma unroll
    for (int i = 0; i < 4; ++i) { ra[i] = *(const u32x4*)(Ap + (size_t)i * 32 * K); rb[i] = *(const u32x4*)(Bp + (size_t)i * 32 * K); }
#pragma unroll
    for (int i = 0; i < 4; ++i) {
      *(u32x4*)(As0 + (ldrow + 32 * i) * LDS_STRIDE + ldcol * 2) = ra[i];
      *(u32x4*)(Bs0 + (ldrow + 32 * i) * LDS_STRIDE + ldcol * 2) = rb[i];
    }
    __syncthreads();
    for (int kt = 0; kt < nk; ++kt) {
      const int buf = kt & 1;
      if (kt + 1 < nk) {
#pragma unroll
        for (int i = 0; i < 4; ++i) { ra[i] = *(const u32x4*)(Ap + (size_t)i * 32 * K + (kt + 1) * 64); rb[i] = *(const u32x4*)(Bp + (size_t)i * 32 * K + (kt + 1) * 64); }
      }
      const unsigned char* As = As0 + buf * 128 * LDS_STRIDE;
      const unsigned char* Bs = Bs0 + buf * 128 * LDS_STRIDE;
#pragma unroll
      for (int ks = 0; ks < 4; ++ks) {
        bf16x8 wf[2], af[2];
#pragma unroll
        for (int i = 0; i < 2; ++i) {
          wf[i] = *(const bf16x8*)(Bs + (wn * 64 + i * 32 + l31) * LDS_STRIDE + (ks * 16 + 8 * hh) * 2);
          af[i] = *(const bf16x8*)(As + (wm * 64 + i * 32 + l31) * LDS_STRIDE + (ks * 16 + 8 * hh) * 2);
        }
#pragma unroll
        for (int ni = 0; ni < 2; ++ni)
#pragma unroll
          for (int mi = 0; mi < 2; ++mi) acc[ni][mi] = MFMA32(wf[ni], af[mi], acc[ni][mi]);
      }
      if (kt + 1 < nk) {
        unsigned char* Aw = As0 + (buf ^ 1) * 128 * LDS_STRIDE;
        unsigned char* Bw = Bs0 + (buf ^ 1) * 128 * LDS_STRIDE;
#pragma unroll
        for (int i = 0; i < 4; ++i) {
          *(u32x4*)(Aw + (ldrow + 32 * i) * LDS_STRIDE + ldcol * 2) = ra[i];
          *(u32x4*)(Bw + (ldrow + 32 * i) * LDS_STRIDE + ldcol * 2) = rb[i];
        }
      }
      __syncthreads();
    }
#pragma unroll
    for (int ni = 0; ni < 2; ++ni)
#pragma unroll
      for (int mi = 0; mi < 2; ++mi) {
        const int m = pm * 128 + wm * 64 + mi * 32 + l31;
#pragma unroll
        for (int g = 0; g < 4; ++g) {
          const int n = pn * 128 + wn * 64 + ni * 32 + 8 * g + 4 * hh;
          f32x4 v = {acc[ni][mi][4 * g], acc[ni][mi][4 * g + 1], acc[ni][mi][4 * g + 2], acc[ni][mi][4 * g + 3]};
          epi(m, n, v);
        }
      }
  }
}

DI float hg_lb(const Params& p, int layer, int d, int j) {
  if (layer == 0) return 0.f;
  const float l0 = p.hg_lb_logits[d * 256 + j], l1 = p.hg_lb_logits[512 + d * 256 + j];
  return 1.f / (1.f + expf(l0 - l1));
}

DI void prep32_item(const Params& p, int layer, int it) {
  const int idx = it * 256 + ltid();
  const int row = idx >> 4, j = idx & 15, isk = j >> 3, sub = j & 7;
  bf16_t* ptr = p.P + (size_t)row * NP + isk * 256 + sub * 32;
  const float* gain = (isk ? p.da_k_gain : p.da_q_gain) + layer * 32;
  float v[32];
#pragma unroll
  for (int i = 0; i < 4; ++i) {
    const u32x4 w = *(const u32x4*)(ptr + 8 * i);
#pragma unroll
    for (int q = 0; q < 4; ++q) { v[8 * i + 2 * q] = bf_lo(w[q]); v[8 * i + 2 * q + 1] = bf_hi(w[q]); }
  }
  float ss = 0.f;
#pragma unroll
  for (int i = 0; i < 32; ++i) ss += v[i] * v[i];
  const float r = rsqrtf(ss * (1.f / 32.f) + EPS);
#pragma unroll
  for (int i = 0; i < 32; ++i) v[i] = v[i] * r * gain[i];
  if (row < TL) {
    const int t = row & (SEQ - 1);
    const float gr = (float)(t >> 6), gc = (float)(t & 63);
#pragma unroll
    for (int i = 0; i < 8; ++i) {
      constexpr float FRA[8] = {1.f, 0.31622776601683794f, 0.1f, 0.031622776601683794f, 0.01f, 0.0031622776601683794f, 0.001f, 0.00031622776601683794f};
      const float fr = FRA[i];
      const float ar = gr * fr, ac = gc * fr;
      const float cr = __cosf(ar), sr = __sinf(ar), cc = __cosf(ac), sc = __sinf(ac);
      const float x1 = v[i], x2 = v[8 + i];
      v[i] = x1 * cr - x2 * sr; v[8 + i] = x1 * sr + x2 * cr;
      const float y1 = v[16 + i], y2 = v[24 + i];
      v[16 + i] = y1 * cc - y2 * sc; v[24 + i] = y1 * sc + y2 * cc;
    }
  }
  const float qs = isk ? 1.f : (0.17677669529663687f * LOG2E);
#pragma unroll
  for (int i = 0; i < 4; ++i) {
    u32x4 w;
#pragma unroll
    for (int q = 0; q < 4; ++q) w[q] = pk2(v[8 * i + 2 * q] * qs, v[8 * i + 2 * q + 1] * qs);
    *(u32x4*)(ptr + 8 * i) = w;
  }
}

DI void prep64_item(const Params& p, int layer, int it) {
  const int idx = it * 256 + ltid();
  const int row = idx / 14, j = idx % 14;
  int col; const float* gain; bool rope, isq;
  if (j < 4) { col = 2048 + 64 * j; gain = p.na_q_gain; rope = false; isq = true; }
  else if (j < 8) { col = 2304 + 64 * (j - 4); gain = p.na_k_gain; rope = false; isq = false; }
  else if (j < 12) { col = 2816 + 64 * (j - 8); gain = p.sw_q_gain; rope = true; isq = true; }
  else { col = 3072 + 64 * (j - 12); gain = p.sw_k_gain; rope = true; isq = false; }
  gain += layer * 64;
  bf16_t* ptr = p.P + (size_t)row * NP + col;
  float v[64];
#pragma unroll
  for (int i = 0; i < 8; ++i) {
    const u32x4 w = *(const u32x4*)(ptr + 8 * i);
#pragma unroll
    for (int q = 0; q < 4; ++q) { v[8 * i + 2 * q] = bf_lo(w[q]); v[8 * i + 2 * q + 1] = bf_hi(w[q]); }
  }
  float ss = 0.f;
#pragma unroll
  for (int i = 0; i < 64; ++i) ss += v[i] * v[i];
  const float r = rsqrtf(ss * (1.f / 64.f) + EPS);
#pragma unroll
  for (int i = 0; i < 64; ++i) v[i] = v[i] * r * gain[i];
  if (rope && row < TL) {
    const int t = row & (SEQ - 1);
    const float gr = (float)(t >> 6), gc = (float)(t & 63);
#pragma unroll
    for (int i = 0; i < 16; ++i) {
      constexpr float FRD[16] = {1.f, 0.5623413251903491f, 0.31622776601683794f, 0.1778279410038923f, 0.1f, 0.05623413251903491f, 0.031622776601683794f, 0.01778279410038923f, 0.01f, 0.005623413251903491f, 0.0031622776601683794f, 0.001778279410038923f, 0.001f, 0.0005623413251903491f, 0.00031622776601683794f, 0.0001778279410038923f};
      const float fr = FRD[i];
      const float ar = gr * fr, ac = gc * fr;
      const float cr = __cosf(ar), sr = __sinf(ar), cc = __cosf(ac), sc = __sinf(ac);
      const float x1 = v[i], x2 = v[16 + i];
      v[i] = x1 * cr - x2 * sr; v[16 + i] = x1 * sr + x2 * cr;
      const float y1 = v[32 + i], y2 = v[48 + i];
      v[32 + i] = y1 * cc - y2 * sc; v[48 + i] = y1 * sc + y2 * cc;
    }
  }
  const float qs = isq ? (0.125f * LOG2E) : 1.f;
#pragma unroll
  for (int i = 0; i < 8; ++i) {
    u32x4 w;
#pragma unroll
    for (int q = 0; q < 4; ++q) w[q] = pk2(v[8 * i + 2 * q] * qs, v[8 * i + 2 * q + 1] * qs);
    *(u32x4*)(ptr + 8 * i) = w;
  }
}

DI void vt_item(const Params& p, int it, unsigned char* smem) {
  const int tid = ltid();
  const int hv = it % 10, ug = (it / 10) % NCHUNK, b = it / (10 * NCHUNK);
  int vcol; bf16_t* dst;
  if (hv < 4) { vcol = 512 + 64 * hv; dst = p.VtA + (size_t)(b * 4 + hv) * 64 * UA; }
  else if (hv < 8) { vcol = 2560 + 64 * (hv - 4); dst = p.VtC + (size_t)(b * 4 + hv - 4) * 64 * UA; }
  else { vcol = 3200 + 64 * (hv - 8); dst = p.VtD + (size_t)(b * 2 + hv - 8) * 64 * UA; }
  const int u0 = ug * 64;
  bf16_t* tile = (bf16_t*)smem;
  {
    const int tk = tid >> 2, seg = (tid & 3) * 16;
    const int row = rowOfU(b, u0 + tk);
    const bf16_t* src = p.P + (size_t)row * NP + vcol + seg;
    const u32x4 w0 = *(const u32x4*)src, w1 = *(const u32x4*)(src + 8);
    unsigned* tp = (unsigned*)(tile + tk * 66 + seg);
#pragma unroll
    for (int q = 0; q < 4; ++q) { tp[q] = w0[q]; tp[4 + q] = w1[q]; }
  }
  __syncthreads();
  {
    const int dv = tid >> 2, tq = (tid & 3) * 16;
    u32x4 w0, w1;
#pragma unroll
    for (int q = 0; q < 4; ++q) {
      w0[q] = (unsigned)tile[(tq + 2 * q) * 66 + dv] | ((unsigned)tile[(tq + 2 * q + 1) * 66 + dv] << 16);
      w1[q] = (unsigned)tile[(tq + 8 + 2 * q) * 66 + dv] | ((unsigned)tile[(tq + 8 + 2 * q + 1) * 66 + dv] << 16);
    }
    bf16_t* dp = dst + (size_t)dv * UA + u0 + tq;
    *(u32x4*)dp = w0; *(u32x4*)(dp + 8) = w1;
  }
  __syncthreads();
}

DI int hg_row(int b, int d, int n, int pp) {
  if (n < 4) { const int c = d ? 255 - (64 * n + pp) : 64 * n + pp; return TL + b * CTX + c; }
  const int t = d ? SEQ - 1 - (64 * (n - 4) + pp) : 64 * (n - 4) + pp;
  return b * SEQ + t;
}

DI void hgsum_item(const Params& p, int layer, int it, unsigned char* smem) {
  const int tid = ltid();
  const int n = it % NCHUNK, chain = it / NCHUNK, d = chain & 1, hh = (chain >> 1) & 3, b = chain >> 3;
  float* cumT = (float*)smem;
  float* wk = cumT + 64 * 65;
  float* vv = wk + 64 * 64;
  const int pp = tid >> 2, kq = (tid & 3) * 16;
  {
    const int row = hg_row(b, d, n, pp);
    const bf16_t* pr = p.P + (size_t)row * NP;
    const bf16_t* fp = pr + 1536 + d * 256 + hh * 64 + kq;
    const bf16_t* vp = pr + 1024 + hh * 64 + kq;
    const u32x4 f0 = *(const u32x4*)fp, f1 = *(const u32x4*)(fp + 8), v0 = *(const u32x4*)vp, v1 = *(const u32x4*)(vp + 8);
    float fx[16], vx[16];
#pragma unroll
    for (int q = 0; q < 4; ++q) { fx[2 * q] = bf_lo(f0[q]); fx[2 * q + 1] = bf_hi(f0[q]); fx[8 + 2 * q] = bf_lo(f1[q]); fx[8 + 2 * q + 1] = bf_hi(f1[q]);
                                  vx[2 * q] = bf_lo(v0[q]); vx[2 * q + 1] = bf_hi(v0[q]); vx[8 + 2 * q] = bf_lo(v1[q]); vx[8 + 2 * q + 1] = bf_hi(v1[q]); }
#pragma unroll
    for (int j = 0; j < 16; ++j) {
      const float lb = hg_lb(p, layer, d, hh * 64 + kq + j);
      const float sg = 1.f / (1.f + expf(-fx[j]));
      const float f = lb + (1.f - lb) * sg;
      cumT[(kq + j) * 65 + pp] = logf(f) * LOG2E;
      wk[pp * 64 + kq + j] = 1.f - f;
      vv[pp * 64 + kq + j] = vx[j];
    }
  }
  __syncthreads();
  if (tid < 64) {
    float run = 0.f;
    for (int q = 0; q < 64; ++q) { run += cumT[tid * 65 + q]; cumT[tid * 65 + q] = run; }
  }
  __syncthreads();
#pragma unroll
  for (int j = 0; j < 16; ++j) {
    const int k = kq + j;
    wk[pp * 64 + k] *= fexp2(cumT[k * 65 + 63] - cumT[k * 65 + pp]);
  }
  __syncthreads();
  {
    const int kg = tid >> 6, v = tid & 63;
    float acc[16];
#pragma unroll
    for (int j = 0; j < 16; ++j) acc[j] = 0.f;
    for (int q = 0; q < 64; ++q) {
      const float vq = vv[q * 64 + v];
#pragma unroll
      for (int j4 = 0; j4 < 4; ++j4) {
        const f32x4 w4 = *(const f32x4*)(wk + q * 64 + kg * 16 + 4 * j4);
#pragma unroll
        for (int a = 0; a < 4; ++a) acc[4 * j4 + a] += w4[a] * vq;
      }
    }
    float* L = p.HL + ((size_t)(chain * NCHUNK + n)) * 4096;
#pragma unroll
    for (int j = 0; j < 16; ++j) L[(kg * 16 + j) * 64 + v] = acc[j];
    if (tid < 64) p.Hdec[(chain * NCHUNK + n) * 64 + tid] = fexp2(cumT[tid * 65 + 63]);
  }
  __syncthreads();
}

DI void prep_phase(const Params& p, int layer, unsigned char* smem, int bid, int nb) {
  constexpr int n_hg = 16 * NCHUNK;
  constexpr int n_vt = 2 * NCHUNK * 10;
  constexpr int n_p32 = TA * 16 / 256;
  constexpr int n_p64 = TA * 14 / 256;
  constexpr int total = n_hg + n_vt + n_p32 + n_p64;
  for (int it = bid; it < total; it += nb) {
    if (it < n_hg) hgsum_item(p, layer, it, smem);
    else if (it < n_hg + n_vt) vt_item(p, it - n_hg, smem);
    else if (it < n_hg + n_vt + n_p32) prep32_item(p, layer, it - n_hg - n_vt);
    else prep64_item(p, layer, it - n_hg - n_vt - n_p32);
  }
}

DI void scan_item(const Params& p, int it) {
  const int chain = it >> 4, e = (it & 15) * 256 + ltid(), k = e >> 6;
  float* L = p.HL + (size_t)chain * NCHUNK * 4096 + e;
  const float* dc = p.Hdec + chain * NCHUNK * 64 + k;
  float S = 0.f;
  for (int n0 = 0; n0 < NCHUNK; n0 += 10) {
    float l[10], dd[10];
#pragma unroll
    for (int j = 0; j < 10; ++j) { l[j] = L[(size_t)(n0 + j) * 4096]; dd[j] = dc[(n0 + j) * 64]; }
#pragma unroll
    for (int j = 0; j < 10; ++j) { L[(size_t)(n0 + j) * 4096] = S; S = dd[j] * S + l[j]; }
  }
}

DI void attnA_block(const Params& p, int layer, unsigned char* smem, int b, int h, int qrow_blk, int ubeg, int uend) {
  const int tid = ltid(), wave = tid >> 6;
  const int lane = tid & 63, qi = lane & 31, hh = lane >> 5;
  const int qrow0 = qrow_blk + wave * 32;
  const int pr = (qi & 19) | ((qi & 4) << 1) | ((qi & 8) >> 1);
  const float lam_init = layer == 0 ? 0.2f : 0.35550906759096f;
  float gq = lane < 32 ? fabsf(p.da_q_gain[layer * 32 + lane]) : 0.f, gk = lane < 32 ? fabsf(p.da_k_gain[layer * 32 + lane]) : 0.f;
  gq = wave_max(gq); gk = wave_max(gk);
  const float negM2 = -(0.17677669529663687f * LOG2E * 32.f * 1.02f) * gq * gk;
  float la = 0.f, lb_ = 0.f;
  if (lane < 32) { const float* lv = p.da_lambda + layer * 128; la = lv[lane] * lv[32 + lane]; lb_ = lv[64 + lane] * lv[96 + lane]; }
  la = wave_sum(la); lb_ = wave_sum(lb_);
  const float lam = expf(la) - expf(lb_) + lam_init;

  const bf16_t* qp = p.P + (size_t)(qrow0 + qi) * NP + h * 64 + 8 * hh;
  bf16x8 qf[2][2];
#pragma unroll
  for (int m = 0; m < 2; ++m)
#pragma unroll
    for (int ks = 0; ks < 2; ++ks) qf[m][ks] = *(const bf16x8*)(qp + m * 32 + ks * 16);
  f32x16 o[2][2];
#pragma unroll
  for (int m = 0; m < 2; ++m)
#pragma unroll
    for (int dh = 0; dh < 2; ++dh)
#pragma unroll
      for (int i = 0; i < 16; ++i) o[m][dh][i] = 0.f;
  float ls[2] = {0.f, 0.f};
  constexpr int STG = 2 * 64 * LDS_STRIDE;
  const int lrow = tid >> 3, lch = tid & 7;
  const bf16_t* kg = p.P + 256 + h * 64 + lch * 8;
  const bf16_t* vg = p.VtA + ((size_t)((b * 4 + h) * 64 + lrow)) * UA + lch * 8;
  u32x4 rk0, rk1, rv0, rv1;
  rk0 = *(const u32x4*)(kg + (size_t)rowOfU(b, ubeg + lrow) * NP);
  rk1 = *(const u32x4*)(kg + (size_t)rowOfU(b, ubeg + lrow + 32) * NP);
  rv0 = *(const u32x4*)(vg + ubeg);
  rv1 = *(const u32x4*)(vg + (size_t)32 * UA + ubeg);
  __syncthreads();
  {
    unsigned char* Ks = smem; unsigned char* Vs = smem + 64 * LDS_STRIDE;
    *(u32x4*)(Ks + lrow * LDS_STRIDE + lch * 16) = rk0; *(u32x4*)(Ks + (lrow + 32) * LDS_STRIDE + lch * 16) = rk1;
    *(u32x4*)(Vs + lrow * LDS_STRIDE + lch * 16) = rv0; *(u32x4*)(Vs + (lrow + 32) * LDS_STRIDE + lch * 16) = rv1;
  }
  __syncthreads();
  int buf = 0;
  for (int u0 = ubeg; u0 < uend; u0 += 64) {
    const bool more = u0 + 64 < uend;
    if (more) {
      rk0 = *(const u32x4*)(kg + (size_t)rowOfU(b, u0 + 64 + lrow) * NP);
      rk1 = *(const u32x4*)(kg + (size_t)rowOfU(b, u0 + 64 + lrow + 32) * NP);
      rv0 = *(const u32x4*)(vg + u0 + 64);
      rv1 = *(const u32x4*)(vg + (size_t)32 * UA + u0 + 64);
    }
    const unsigned char* Ks = smem + buf * STG;
    const unsigned char* Vs = Ks + 64 * LDS_STRIDE;
#pragma unroll 1
    for (int sub = 0; sub < 2; ++sub) {
      bf16x8 vf[2][2];
#pragma unroll
      for (int dh = 0; dh < 2; ++dh)
#pragma unroll
        for (int s2 = 0; s2 < 2; ++s2) vf[dh][s2] = *(const bf16x8*)(Vs + (32 * dh + qi) * LDS_STRIDE + (32 * sub + 16 * s2 + 8 * hh) * 2);
#pragma unroll
      for (int m = 0; m < 2; ++m) {
        const unsigned char* kr = Ks + (32 * sub + pr) * LDS_STRIDE + (m * 32 + 8 * hh) * 2;
        const bf16x8 kf0 = *(const bf16x8*)kr, kf1 = *(const bf16x8*)(kr + 32);
        f32x16 s;
#pragma unroll
        for (int i = 0; i < 16; ++i) s[i] = negM2;
        s = MFMA32(kf0, qf[m][0], s);
        s = MFMA32(kf1, qf[m][1], s);
        float pe[16];
#pragma unroll
        for (int i = 0; i < 16; ++i) { pe[i] = fexp2(s[i]); ls[m] += pe[i]; }
#pragma unroll
        for (int s2 = 0; s2 < 2; ++s2) {
          u32x4 pw;
#pragma unroll
          for (int q = 0; q < 4; ++q) pw[q] = pk2(pe[8 * s2 + 2 * q], pe[8 * s2 + 2 * q + 1]);
          const bf16x8 pf = __builtin_bit_cast(bf16x8, pw);
#pragma unroll
          for (int dh = 0; dh < 2; ++dh) o[m][dh] = MFMA32(vf[dh][s2], pf, o[m][dh]);
        }
      }
    }
    if (more) {
      unsigned char* Kw = smem + (buf ^ 1) * STG; unsigned char* Vw = Kw + 64 * LDS_STRIDE;
      *(u32x4*)(Kw + lrow * LDS_STRIDE + lch * 16) = rk0; *(u32x4*)(Kw + (lrow + 32) * LDS_STRIDE + lch * 16) = rk1;
      *(u32x4*)(Vw + lrow * LDS_STRIDE + lch * 16) = rv0; *(u32x4*)(Vw + (lrow + 32) * LDS_STRIDE + lch * 16) = rv1;
    }
    __syncthreads();
    buf ^= 1;
  }
  const float l0 = ls[0] + __shfl_xor(ls[0], 32), l1 = ls[1] + __shfl_xor(ls[1], 32);
  const float i0 = 1.f / l0, c1 = lam / l1;
  float ss = 0.f;
#pragma unroll
  for (int dh = 0; dh < 2; ++dh)
#pragma unroll
    for (int i = 0; i < 16; ++i) { const float v = o[0][dh][i] * i0 - o[1][dh][i] * c1; o[0][dh][i] = v; ss += v * v; }
  ss += __shfl_xor(ss, 32);
  const float r = rsqrtf(ss * (1.f / 64.f) + EPS) * (1.f - lam_init);
  bf16_t* op = p.MO + (size_t)(qrow0 + qi) * DM + h * 64;
  const float* sg = p.da_sub_gain + layer * 64;
#pragma unroll
  for (int dh = 0; dh < 2; ++dh)
#pragma unroll
    for (int g = 0; g < 4; ++g) {
      const int dv = 32 * dh + 8 * g + 4 * hh;
      const f32x4 g4 = *(const f32x4*)(sg + dv);
      u32x2 w;
      w[0] = pk2(o[0][dh][4 * g] * r * g4[0], o[0][dh][4 * g + 1] * r * g4[1]);
      w[1] = pk2(o[0][dh][4 * g + 2] * r * g4[2], o[0][dh][4 * g + 3] * r * g4[3]);
      *(u32x2*)(op + dv) = w;
    }
}

template <class MaskF>
DI void attn64_step(const bf16_t* kp  , const bf16_t* vp  ,
                    const bf16x8 (&qf)[4], f32x16 (&o)[2], float& ls, float negM2, int hh, MaskF maskf) {
  bf16x8 kf[4], vf[2][2];
#pragma unroll
  for (int ks = 0; ks < 4; ++ks) kf[ks] = *(const bf16x8*)(kp + ks * 16);
#pragma unroll
  for (int dh = 0; dh < 2; ++dh)
#pragma unroll
    for (int s2 = 0; s2 < 2; ++s2) vf[dh][s2] = *(const bf16x8*)(vp + (size_t)dh * 32 * UA + s2 * 16);
  f32x16 s;
#pragma unroll
  for (int i = 0; i < 16; ++i) s[i] = negM2;
#pragma unroll
  for (int ks = 0; ks < 4; ++ks) s = MFMA32(kf[ks], qf[ks], s);
  float pe[16];
#pragma unroll
  for (int i = 0; i < 16; ++i) { const int kslot = 16 * (i >> 3) + 8 * hh + (i & 7); pe[i] = fexp2(maskf(kslot, s[i])); ls += pe[i]; }
#pragma unroll
  for (int s2 = 0; s2 < 2; ++s2) {
    u32x4 pw;
#pragma unroll
    for (int q = 0; q < 4; ++q) pw[q] = pk2(pe[8 * s2 + 2 * q], pe[8 * s2 + 2 * q + 1]);
    const bf16x8 pf = __builtin_bit_cast(bf16x8, pw);
#pragma unroll
    for (int dh = 0; dh < 2; ++dh) o[dh] = MFMA32(vf[dh][s2], pf, o[dh]);
  }
}

template <int MODE>
DI void attn64_wave(const Params& p, int layer, int b, int hq, int qrow0, int t0) {
  constexpr bool isC = (MODE == 0 || MODE == 2);
  const int lane = ltid() & 63, qi = lane & 31, hh = lane >> 5;
  const int pr = (qi & 19) | ((qi & 4) << 1) | ((qi & 8) >> 1);
  const float* gqp = (isC ? p.na_q_gain : p.sw_q_gain) + layer * 64;
  const float* gkp = (isC ? p.na_k_gain : p.sw_k_gain) + layer * 64;
  const float gq = wave_max(fabsf(gqp[lane])), gk = wave_max(fabsf(gkp[lane]));
  const float negM2 = -(0.125f * LOG2E * 64.f * 1.02f) * gq * gk;
  const int kvh = isC ? hq : (hq >> 1);
  const int qcol = isC ? 2048 + 64 * hq : 2816 + 64 * hq;
  const int kcol = isC ? 2304 + 64 * hq : 3072 + 64 * kvh;
  const bf16_t* vt = isC ? p.VtC + (size_t)(b * 4 + hq) * 64 * UA : p.VtD + (size_t)(b * 2 + kvh) * 64 * UA;
  const bf16_t* vbase = vt + (size_t)qi * UA + 8 * hh;
  const bf16_t* kbase = p.P + kcol + 8 * hh;
  const bf16_t* qp = p.P + (size_t)(qrow0 + qi) * NP + qcol + 8 * hh;
  bf16x8 qf[4];
#pragma unroll
  for (int ks = 0; ks < 4; ++ks) qf[ks] = *(const bf16x8*)(qp + ks * 16);
  f32x16 o[2];
#pragma unroll
  for (int dh = 0; dh < 2; ++dh)
#pragma unroll
    for (int i = 0; i < 16; ++i) o[dh][i] = 0.f;
  float ls = 0.f;
  for (int u0 = 0; u0 < CTX; u0 += 32) {
    const bf16_t* kp = kbase + (size_t)(TL + b * CTX + u0 + pr) * NP;
    attn64_step(kp, vbase + u0, qf, o, ls, negM2, hh, [](int, float s) { return s; });
  }
  if (MODE == 0) {
    const int r = t0 >> 6, c = (t0 & 63) + qi;
    const int rs = min(max(r - 4, 0), 248);
    const int ws = min(max(c - 8, 0), 48);
    const float* rpb = p.na_rpb + (size_t)(layer * 4 + hq) * 15 * 31;
    for (int kr = rs; kr < rs + 8; ++kr) {
      const float* rrow = rpb + (kr - r + 7) * 31 + 15 - c;
#pragma unroll 1
      for (int hf = 0; hf < 2; ++hf) {
        const int kt0 = kr * 64 + hf * 32;
        const bf16_t* kp = kbase + (size_t)(b * SEQ + kt0 + pr) * NP;
        attn64_step(kp, vbase + CTX + kt0, qf, o, ls, negM2, hh, [&](int kslot, float s) {
          const int kc = hf * 32 + kslot;
          const bool valid = (kc >= ws) && (kc < ws + 16);
          const int kcc = min(max(kc, ws), ws + 15);
          return valid ? s + rrow[kcc] * LOG2E : -1e30f;
        });
      }
    }
  } else if (MODE == 1) {
    const int qt = t0 + qi;
    for (int jt = 0; jt < 9; ++jt) {
      const int kt0 = t0 - 128 + 32 * jt;
      if (kt0 < 0 || kt0 >= SEQ) continue;
      const bf16_t* kp = kbase + (size_t)(b * SEQ + kt0 + pr) * NP;
      if (jt == 0 || jt == 8) {
        attn64_step(kp, vbase + CTX + kt0, qf, o, ls, negM2, hh, [&](int kslot, float s) {
          const int dd = kt0 + kslot - qt;
          return (dd <= 128 && dd >= -128) ? s : -1e30f;
        });
      } else {
        attn64_step(kp, vbase + CTX + kt0, qf, o, ls, negM2, hh, [](int, float s) { return s; });
      }
    }
  }
  float l = ls + __shfl_xor(ls, 32);
  if (!isC) l += fexp2(p.sw_sink[layer * 4 + hq] * LOG2E + negM2);
  const float il = 1.f / l;
  bf16_t* op = p.MO + (size_t)(qrow0 + qi) * DM + (isC ? 512 : 768) + hq * 64;
#pragma unroll
  for (int dh = 0; dh < 2; ++dh)
#pragma unroll
    for (int g = 0; g < 4; ++g) {
      const int dv = 32 * dh + 8 * g + 4 * hh;
      u32x2 w;
      w[0] = pk2(o[dh][4 * g] * il, o[dh][4 * g + 1] * il);
      w[1] = pk2(o[dh][4 * g + 2] * il, o[dh][4 * g + 3] * il);
      *(u32x2*)(op + dv) = w;
    }
}

DI void mix_phase(const Params& p, int layer, unsigned char* smem, int bid, int nb) {
  const int wave = ltid() >> 6;
  const int n_scan = 256, n_lat = 1024, n_ctx = layer == 0 ? 16 : 0;
  const int e0 = n_scan, e1 = e0 + n_lat, e2 = e1 + n_ctx, e3 = e2 + n_lat, e4 = e3 + n_lat, e5 = e4 + n_ctx, e6 = e5 + n_ctx;
  for (int it = bid; it < e6; it += nb) {
    if (it < e0) scan_item(p, it);
    else if (it < e1) {
      const int j = it - e0, qb = j & 127, h = (j >> 7) & 3, b = j >> 9;
      attnA_block(p, layer, smem, b, h, b * SEQ + qb * 128, 0, UA);
    } else if (it < e2) {
      const int j = it - e1, qb = j & 1, h = (j >> 1) & 3, b = j >> 3;
      attnA_block(p, layer, smem, b, h, TL + b * CTX + qb * 128, 0, CTX);
    } else if (it < e3) {
      const int j = it - e2, qb = j & 127, hq = (j >> 7) & 3, b = j >> 9;
      const int t0 = qb * 128 + wave * 32;
      attn64_wave<1>(p, layer, b, hq, b * SEQ + t0, t0);
    } else if (it < e4) {
      const int j = it - e3, qb = j & 127, hq = (j >> 7) & 3, b = j >> 9;
      const int t0 = qb * 128 + wave * 32;
      attn64_wave<0>(p, layer, b, hq, b * SEQ + t0, t0);
    } else if (it < e5) {
      const int j = it - e4, qb = j & 1, hq = (j >> 1) & 3, b = j >> 3;
      attn64_wave<3>(p, layer, b, hq, TL + b * CTX + qb * 128 + wave * 32, 0);
    } else {
      const int j = it - e5, qb = j & 1, hq = (j >> 1) & 3, b = j >> 3;
      attn64_wave<2>(p, layer, b, hq, TL + b * CTX + qb * 128 + wave * 32, 0);
    }
  }
}

template <int D>
DI void hgrn_dir(const Params& p, int layer, unsigned char* smem, int b, int hh, int n, float (&o)[16]) {
  const int tid = ltid();
  const int chain = (b * 4 + hh) * 2 + D;
  float* cumT = (float*)smem;
  float* qT = cumT + 64 * 68;
  float* kT = qT + 64 * 68;
  float* vv = kT + 64 * 68;
  {
    const int pp = tid >> 2, kq = (tid & 3) * 16;
    const int row = hg_row(b, D, n, pp);
    const bf16_t* pr = p.P + (size_t)row * NP;
    const bf16_t* qp = pr + 768 + hh * 64 + kq;
    const bf16_t* fp = pr + 1536 + D * 256 + hh * 64 + kq;
    const bf16_t* vp = pr + 1024 + hh * 64 + kq;
    const u32x4 q0 = *(const u32x4*)qp, q1 = *(const u32x4*)(qp + 8), f0 = *(const u32x4*)fp, f1 = *(const u32x4*)(fp + 8),
                v0 = *(const u32x4*)vp, v1 = *(const u32x4*)(vp + 8);
    float qx[16], fx[16], vx[16];
#pragma unroll
    for (int q = 0; q < 4; ++q) {
      qx[2 * q] = bf_lo(q0[q]); qx[2 * q + 1] = bf_hi(q0[q]); qx[8 + 2 * q] = bf_lo(q1[q]); qx[8 + 2 * q + 1] = bf_hi(q1[q]);
      fx[2 * q] = bf_lo(f0[q]); fx[2 * q + 1] = bf_hi(f0[q]); fx[8 + 2 * q] = bf_lo(f1[q]); fx[8 + 2 * q + 1] = bf_hi(f1[q]);
      vx[2 * q] = bf_lo(v0[q]); vx[2 * q + 1] = bf_hi(v0[q]); vx[8 + 2 * q] = bf_lo(v1[q]); vx[8 + 2 * q + 1] = bf_hi(v1[q]);
    }
#pragma unroll
    for (int j = 0; j < 16; ++j) {
      const float lb = hg_lb(p, layer, D, hh * 64 + kq + j);
      const float sg = 1.f / (1.f + expf(-fx[j]));
      const float f = lb + (1.f - lb) * sg;
      cumT[(kq + j) * 68 + pp] = logf(f) * LOG2E;
      qT[(kq + j) * 68 + pp] = qx[j];
      kT[(kq + j) * 68 + pp] = 1.f - f;
      vv[pp * 64 + kq + j] = vx[j];
    }
  }
  __syncthreads();
  if (tid < 64) {
    float run = 0.f;
    for (int q = 0; q < 64; ++q) { run += cumT[tid * 68 + q]; cumT[tid * 68 + q] = run; }
  }
  __syncthreads();
  const int tg = tid >> 6, v = tid & 63, tgp = D ? 3 - tg : tg;
  {
    const float* S = p.HL + ((size_t)(chain * NCHUNK + n)) * 4096 + v;
    for (int k = 0; k < 64; ++k) {
      const float Sv = S[k * 64];
#pragma unroll
      for (int j4 = 0; j4 < 4; ++j4) {
        const f32x4 c4 = *(const f32x4*)(cumT + k * 68 + 16 * tgp + 4 * j4);
        const f32x4 q4 = *(const f32x4*)(qT + k * 68 + 16 * tgp + 4 * j4);
#pragma unroll
        for (int a = 0; a < 4; ++a) { const int j = 4 * j4 + a; o[D ? 15 - j : j] += q4[a] * fexp2(c4[a]) * Sv; }
      }
    }
  }
  const int bt = tid >> 4, bs = tid & 15;
  float sc[4][4];
#pragma unroll
  for (int a = 0; a < 4; ++a)
#pragma unroll
    for (int c = 0; c < 4; ++c) sc[a][c] = 0.f;
  if (bs <= bt) {
    for (int k = 0; k < 64; ++k) {
      const f32x4 ct = *(const f32x4*)(cumT + k * 68 + 4 * bt), qt = *(const f32x4*)(qT + k * 68 + 4 * bt);
      const f32x4 cs = *(const f32x4*)(cumT + k * 68 + 4 * bs), ks = *(const f32x4*)(kT + k * 68 + 4 * bs);
      const float ref = ct[0];
      float et[4], es[4];
#pragma unroll
      for (int a = 0; a < 4; ++a) { et[a] = qt[a] * fexp2(ct[a] - ref); es[a] = ks[a] * fexp2(ref - cs[a]); }
#pragma unroll
      for (int a = 0; a < 4; ++a)
#pragma unroll
        for (int c = 0; c < 4; ++c) sc[a][c] += et[a] * es[c];
    }
  }
  __syncthreads();
#pragma unroll
  for (int a = 0; a < 4; ++a) {
    f32x4 w;
#pragma unroll
    for (int c = 0; c < 4; ++c) w[c] = (bs <= bt && (4 * bs + c) <= (4 * bt + a)) ? sc[a][c] : 0.f;
    *(f32x4*)(kT + (4 * bt + a) * 68 + 4 * bs) = w;
  }
  __syncthreads();
  {
    const int send = 4 * (tgp + 1);
    for (int s4 = 0; s4 < send; ++s4) {
      float vq[4];
#pragma unroll
      for (int c = 0; c < 4; ++c) vq[c] = vv[(4 * s4 + c) * 64 + v];
#pragma unroll
      for (int j = 0; j < 16; ++j) {
        const f32x4 w = *(const f32x4*)(kT + (16 * tgp + j) * 68 + 4 * s4);
        o[D ? 15 - j : j] += w[0] * vq[0] + w[1] * vq[1] + w[2] * vq[2] + w[3] * vq[3];
      }
    }
  }
  __syncthreads();
}

DI void hgout_phase(const Params& p, int layer, unsigned char* smem, int bid, int nb) {
  const int tid = ltid();
  const int n_lat = 2 * 4 * 256, n_ctx = layer == 0 ? 2 * 4 * 4 : 0;
  for (int it = bid; it < n_lat + n_ctx; it += nb) {
    int b, hh, n0, n1, rowbase;
    if (it < n_lat) { const int m = it & 255; hh = (it >> 8) & 3; b = it >> 10; n0 = 4 + m; n1 = 4 + 255 - m; rowbase = b * SEQ + 64 * m; }
    else { const int j = it - n_lat, mc = j & 3; hh = (j >> 2) & 3; b = j >> 4; n0 = mc; n1 = 3 - mc; rowbase = TL + b * CTX + 64 * mc; }
    float o[16];
#pragma unroll
    for (int j = 0; j < 16; ++j) o[j] = 0.f;
    hgrn_dir<0>(p, layer, smem, b, hh, n0, o);
    hgrn_dir<1>(p, layer, smem, b, hh, n1, o);
    const int tg = tid >> 6, v = tid & 63;
    const float og = p.hg_out_gain[layer * 64 + v];
#pragma unroll
    for (int j = 0; j < 16; ++j) {
      const int row = rowbase + 16 * tg + j;
      const float ss = wave_sum(o[j] * o[j]);
      const float r = rsqrtf(ss * (1.f / 64.f) + EPS);
      const unsigned short gb = p.P[(size_t)row * NP + 1280 + hh * 64 + v];
      const float gx = __uint_as_float(((unsigned)gb) << 16);
      const float y = o[j] * r * og * (gx / (1.f + expf(-gx)));
      p.MO[(size_t)row * DM + 256 + hh * 64 + v] = tobf(y);
    }
  }
}

#if MULTI_LAUNCH
#define SYNC_OR_RETURN(ph) do { if (phase_sel == (ph)) return; } while (0)
#define RUN(ph) (phase_sel == (ph))
#else
#define RUN(ph) (true)
#endif

__global__ void __launch_bounds__(256, 2) fwd_kernel(Params p, int phase_sel) {
  __shared__ __attribute__((aligned(16))) unsigned char smem[SMEM_BYTES];
  const int bid = blockIdx.x, nb = gridDim.x;
#if !MULTI_LAUNCH
  cg::grid_group grid = cg::this_grid();
#define GSYNC() grid.sync()
#else
#define GSYNC() do {} while (0)
#endif
  int ph = 0;
  if (RUN(ph)) phase0(p, smem, bid, nb);
  GSYNC(); ++ph;
  for (int layer = 0; layer < 2; ++layer) {
    const float* modl = p.mod + layer * 3 * 6144;
    const float* rl = layer == 0 ? p.x : p.out;
    const float* rc = layer == 0 ? p.ctx : p.Xc;
    if (RUN(ph)) norm_phase(rl, rc, TA, p.norm1_g + layer * DM, modl, 0, 1024, p.H, bid, nb);
    GSYNC(); ++ph;
    if (RUN(ph)) { EpiBf16 e{p.P, NP}; gemm_phase(p.H, p.WinT + (size_t)layer * NP * 1024, TA / 128, NP / 128, 1024, e, smem, bid, nb); }
    GSYNC(); ++ph;
    if (RUN(ph)) prep_phase(p, layer, smem, bid, nb);
    GSYNC(); ++ph;
    if (RUN(ph)) mix_phase(p, layer, smem, bid, nb);
    GSYNC(); ++ph;
    if (RUN(ph)) hgout_phase(p, layer, smem, bid, nb);
    GSYNC(); ++ph;
    const int mrows = layer == 0 ? TA : TL;
    if (RUN(ph)) { EpiResid e{rl, rc, p.out, p.Xc, modl + 2048, 0}; gemm_phase(p.MO, p.WoutT + (size_t)layer * 1024 * 1024, mrows / 128, 8, 1024, e, smem, bid, nb); }
    GSYNC(); ++ph;
    if (RUN(ph)) norm_phase(p.out, p.Xc, mrows, p.norm2_g + layer * DM, modl, 3072, 4096, p.H, bid, nb);
    GSYNC(); ++ph;
    const int nchunks = layer == 0 ? 3 : 2;
    for (int ch = 0; ch < nchunks; ++ch) {
      const int row0 = ch * 16384, rows = ch < 2 ? 16384 : TC;
      if (RUN(ph)) { EpiRelu2 e{p.P, DFF}; gemm_phase(p.H + (size_t)row0 * DM, p.W1T + (size_t)layer * DFF * 1024, rows / 128, DFF / 128, 1024, e, smem, bid, nb); }
      GSYNC(); ++ph;
      if (RUN(ph)) { EpiResid e{p.out, p.Xc, p.out, p.Xc, modl + 5 * 1024, row0}; gemm_phase(p.P, p.W2T + (size_t)layer * 1024 * DFF, rows / 128, 8, DFF, e, smem, bid, nb); }
      GSYNC(); ++ph;
    }
  }
}

static size_t align_up(size_t v) { return (v + 255) & ~(size_t)255; }

extern "C" void kernel_launch(void* const* d_in, const int* in_sizes, int n_in, void* d_out, int out_size, void* d_ws, size_t ws_size,
                              hipStream_t stream) {
  Params p{};
  const float** f = (const float**)&p;
  for (int i = 0; i < 24; ++i) f[i] = (const float*)d_in[i];
  p.out = (float*)d_out;
  unsigned char* w = (unsigned char*)d_ws; size_t off = 0;
  auto take = [&](size_t bytes) { void* r = w + off; off = align_up(off + bytes); return r; };
  p.Xc = (float*)take((size_t)TC * DM * 4);
  p.mod = (float*)take((size_t)2 * 3 * 6144 * 4);
  p.Hdec = (float*)take((size_t)16 * NCHUNK * 64 * 4);
  p.WinT = (bf16_t*)take((size_t)2 * NP * 1024 * 2);
  p.WoutT = (bf16_t*)take((size_t)2 * 1024 * 1024 * 2);
  p.W1T = (bf16_t*)take((size_t)2 * DFF * 1024 * 2);
  p.W2T = (bf16_t*)take((size_t)2 * DFF * 1024 * 2);
  p.H = (bf16_t*)take((size_t)TA * DM * 2);
  p.HL = (float*)p.H;
  p.P = (bf16_t*)take((size_t)TA * NP * 2);
  p.MO = (bf16_t*)take((size_t)TA * DM * 2);
  p.VtA = (bf16_t*)take((size_t)2 * 4 * 64 * UA * 2);
  p.VtC = (bf16_t*)take((size_t)2 * 4 * 64 * UA * 2);
  p.VtD = (bf16_t*)take((size_t)2 * 2 * 64 * UA * 2);
  if (off > ws_size) { fprintf(stderr, "workspace too small: need %zu have %zu\n", off, ws_size); return; }
#if MULTI_LAUNCH
  const int nphase = 1 + 7 + 6 + 7 + 4;
  for (int ph = 0; ph < nphase; ++ph) hipLaunchKernelGGL(fwd_kernel, dim3(512), dim3(256), 0, stream, p, ph);
#else
  static int grid_blocks = 0;
  if (!grid_blocks) {
    int dev = 0, cus = 0, per_cu = 0;
    (void)hipGetDevice(&dev);
    (void)hipDeviceGetAttribute(&cus, hipDeviceAttributeMultiprocessorCount, dev);
    (void)hipOccupancyMaxActiveBlocksPerMultiprocessor(&per_cu, fwd_kernel, 256, 0);
    if (per_cu > 2) per_cu = 2;
    grid_blocks = cus * per_cu;
  }
  int phase_sel = -1;
  void* args[] = {&p, &phase_sel};
  hipError_t e = hipLaunchCooperativeKernel((void*)fwd_kernel, dim3(grid_blocks), dim3(256), args, 0, stream);
  if (e != hipSuccess) fprintf(stderr, "cooperative launch failed: %s (grid %d)\n", hipGetErrorString(e), grid_blocks);
#endif
}
```

```cpp
#include <hip/hip_runtime.h>
#include <hip/hip_cooperative_groups.h>
#include <cstdio>
#include <cstdint>
namespace cg = cooperative_groups;

#ifndef MULTI_LAUNCH
#define MULTI_LAUNCH 0
#endif

#define DI __device__ __forceinline__
typedef unsigned short bf16_t;
typedef short bf16x8 __attribute__((ext_vector_type(8)));
typedef float f32x16 __attribute__((ext_vector_type(16)));
typedef float f32x4 __attribute__((ext_vector_type(4)));
typedef float f32x2 __attribute__((ext_vector_type(2)));
typedef unsigned u32x4 __attribute__((ext_vector_type(4)));
typedef unsigned u32x2 __attribute__((ext_vector_type(2)));
typedef __bf16 bf16x2_t __attribute__((ext_vector_type(2)));

constexpr int SEQ = 16384, CTX = 256, DM = 1024, TL = 32768, TC = 512, TA = 33280, NP = 3328, DFF = 4096, UA = 16640;
constexpr int NCHUNK = 260;
constexpr float EPS = 1e-6f, LOG2E = 1.4426950408889634f;
constexpr int SMEM_BYTES = 73728;
constexpr int LDS_STRIDE = 144;

#define MFMA32(a, b, c) __builtin_amdgcn_mfma_f32_32x32x16_bf16((a), (b), (c), 0, 0, 0)

DI unsigned pk2(float a, float b) { f32x2 v = {a, b}; return __builtin_bit_cast(unsigned, __builtin_convertvector(v, bf16x2_t)); }
DI float bf_lo(unsigned u) { return __uint_as_float(u << 16); }
DI float bf_hi(unsigned u) { return __uint_as_float(u & 0xffff0000u); }
DI bf16_t tobf(float a) { return (bf16_t)(pk2(a, 0.f) & 0xffffu); }
DI float fexp2(float x) { return __builtin_amdgcn_exp2f(x); }
DI float wave_sum(float v) {
#pragma unroll
  for (int o = 32; o > 0; o >>= 1) v += __shfl_xor(v, o);
  return v;
}
DI float wave_max(float v) {
#pragma unroll
  for (int o = 32; o > 0; o >>= 1) v = fmaxf(v, __shfl_xor(v, o));
  return v;
}
DI int ltid() { int t = threadIdx.x & 255; asm volatile("" : "+v"(t)); return t; }
DI int ltid512() { int t = threadIdx.x; asm volatile("" : "+v"(t)); return t; }
DI int rowOfU(int b, int u) { return u < CTX ? TL + b * CTX + u : b * SEQ + (u - CTX); }

struct Params {
  const float *x, *c, *ctx, *c_ctx, *w_mod, *b_mod, *norm1_g, *norm2_g, *w_in, *w_out;
  const float *da_q_gain, *da_k_gain, *da_lambda, *da_sub_gain, *hg_lb_logits, *hg_out_gain;
  const float *na_q_gain, *na_k_gain, *na_rpb, *sw_q_gain, *sw_k_gain, *sw_sink, *w_ff1, *w_ff2;
  float* out;
  float* Xc;
  float* mod;
  float* Hdec;
  bf16_t* WinT;
  bf16_t* WoutT;
  bf16_t* W1T;
  bf16_t* W2T;
  bf16_t* H;
  float* HL;
  bf16_t* P;
  bf16_t* MO;
  bf16_t* VtA;
  bf16_t* VtC;
  bf16_t* VtD;
};

DI void phase0(const Params& p, unsigned char* smem, int bid, int nb) {
  const int tid = ltid();
  constexpr int n_mod = 2 * 96;
  constexpr int t_in = 16 * 52, t_out = 16 * 16, t_f1 = 16 * 64, t_f2 = 64 * 16;
  constexpr int per_layer = t_in + t_out + t_f1 + t_f2;
  constexpr int total = n_mod + 2 * per_layer;
  float* fs = (float*)smem;
  for (int it = bid; it < total; it += nb) {
    if (it < n_mod) {
      const int l = it / 96, col0 = (it % 96) * 64;
      float* sc = fs;
      float* red = fs + 3072;
      for (int i = tid; i < 3072; i += 256) {
        const int cond = i >> 10, k = i & 1023;
        const float v = cond == 0 ? p.c[k] : (cond == 1 ? p.c[1024 + k] : p.c_ctx[k]);
        sc[i] = v / (1.f + expf(-v));
      }
      __syncthreads();
      const int kg = tid >> 6, j = tid & 63;
      float a0 = 0.f, a1 = 0.f, a2 = 0.f;
      const float* wp = p.w_mod + ((size_t)l * 1024 + kg * 256) * 6144 + col0 + j;
#pragma unroll 8
      for (int k = 0; k < 256; ++k) {
        const float w = wp[(size_t)k * 6144];
        a0 += sc[kg * 256 + k] * w; a1 += sc[1024 + kg * 256 + k] * w; a2 += sc[2048 + kg * 256 + k] * w;
      }
      red[(kg * 3 + 0) * 64 + j] = a0; red[(kg * 3 + 1) * 64 + j] = a1; red[(kg * 3 + 2) * 64 + j] = a2;
      __syncthreads();
      if (tid < 192) {
        const int cond = tid >> 6, jj = tid & 63;
        float s = p.b_mod[l * 6144 + col0 + jj];
#pragma unroll
        for (int g = 0; g < 4; ++g) s += red[(g * 3 + cond) * 64 + jj];
        p.mod[(l * 3 + cond) * 6144 + col0 + jj] = s;
      }
    } else {
      int idx = it - n_mod;
      const int l = idx / per_layer; idx -= l * per_layer;
      const float* src; bf16_t* dst; int K, N;
      if (idx < t_in) { src = p.w_in + (size_t)l * 1024 * NP; dst = p.WinT + (size_t)l * NP * 1024; K = 1024; N = NP; }
      else if (idx < t_in + t_out) { idx -= t_in; src = p.w_out + (size_t)l * 1024 * 1024; dst = p.WoutT + (size_t)l * 1024 * 1024; K = 1024; N = 1024; }
      else if (idx < t_in + t_out + t_f1) { idx -= t_in + t_out; src = p.w_ff1 + (size_t)l * 1024 * DFF; dst = p.W1T + (size_t)l * DFF * 1024; K = 1024; N = DFF; }
      else { idx -= t_in + t_out + t_f1; src = p.w_ff2 + (size_t)l * DFF * 1024; dst = p.W2T + (size_t)l * 1024 * DFF; K = DFF; N = 1024; }
      const int ntn = N >> 6, kt = idx / ntn, nt = idx % ntn, k0 = kt * 64, n0 = nt * 64;
#pragma unroll
      for (int i = 0; i < 4; ++i) {
        const int r = (tid >> 4) + 16 * i, c4 = (tid & 15) * 4;
        const f32x4 v = *(const f32x4*)(src + (size_t)(k0 + r) * N + n0 + c4);
        fs[r * 65 + c4] = v[0]; fs[r * 65 + c4 + 1] = v[1]; fs[r * 65 + c4 + 2] = v[2]; fs[r * 65 + c4 + 3] = v[3];
      }
      __syncthreads();
      const int n = tid >> 2, kq = (tid & 3) * 16;
      u32x4 w0, w1;
#pragma unroll
      for (int i = 0; i < 4; ++i) {
        w0[i] = pk2(fs[(kq + 2 * i) * 65 + n], fs[(kq + 2 * i + 1) * 65 + n]);
        w1[i] = pk2(fs[(kq + 8 + 2 * i) * 65 + n], fs[(kq + 8 + 2 * i + 1) * 65 + n]);
      }
      bf16_t* dp = dst + (size_t)(n0 + n) * K + k0 + kq;
      *(u32x4*)dp = w0; *(u32x4*)(dp + 8) = w1;
    }
    __syncthreads();
  }
}

DI void norm_phase(const float* lat, const float* ctxp, int nrows, const float* g, const float* modl, int shift_off, int scale_off,
                   bf16_t* H, int bid, int nb) {
  const int wave = ltid() >> 6, lane = ltid() & 63;
  for (int r4 = bid; r4 < nrows / 4; r4 += nb) {
    const int row = r4 * 4 + wave;
    const float* src = row < TL ? lat + (size_t)row * DM : ctxp + (size_t)(row - TL) * DM;
    const int mi = row < TL ? (row >> 14) : 2;
    const float* sh = modl + mi * 6144 + shift_off;
    const float* sc = modl + mi * 6144 + scale_off;
    f32x4 v[4]; float ss = 0.f;
#pragma unroll
    for (int i = 0; i < 4; ++i) { v[i] = *(const f32x4*)(src + lane * 4 + 256 * i); ss += v[i][0] * v[i][0] + v[i][1] * v[i][1] + v[i][2] * v[i][2] + v[i][3] * v[i][3]; }
    ss = wave_sum(ss);
    const float rs = rsqrtf(ss * (1.f / 1024.f) + EPS);
#pragma unroll
    for (int i = 0; i < 4; ++i) {
      const int col = lane * 4 + 256 * i;
      const f32x4 gg = *(const f32x4*)(g + col), s4 = *(const f32x4*)(sc + col), h4 = *(const f32x4*)(sh + col);
      float y[4];
#pragma unroll
      for (int j = 0; j < 4; ++j) y[j] = (v[i][j] * rs * gg[j]) * (1.f + s4[j]) + h4[j];
      u32x2 w; w[0] = pk2(y[0], y[1]); w[1] = pk2(y[2], y[3]);
      *(u32x2*)(H + (size_t)row * DM + col) = w;
    }
  }
}

struct EpiBf16 {
  bf16_t* O; int ldc;
  DI void operator()(int m, int n, f32x4 v) const {
    u32x2 w; w[0] = pk2(v[0], v[1]); w[1] = pk2(v[2], v[3]);
    *(u32x2*)(O + (size_t)m * ldc + n) = w;
  }
};
struct EpiRelu2 {
  bf16_t* O; int ldc;
  DI void operator()(int m, int n, f32x4 v) const {
    float y[4];
#pragma unroll
    for (int j = 0; j < 4; ++j) { const float t = fmaxf(v[j], 0.f); y[j] = t * t; }
    u32x2 w; w[0] = pk2(y[0], y[1]); w[1] = pk2(y[2], y[3]);
    *(u32x2*)(O + (size_t)m * ldc + n) = w;
  }
};
struct EpiResid {
  const float* sl; const float* sc; float* dl; float* dc; const float* gate; int row0;
  DI void operator()(int m, int n, f32x4 v) const {
    const int row = m + row0;
    const float* s = row < TL ? sl + (size_t)row * DM : sc + (size_t)(row - TL) * DM;
    float* d = row < TL ? dl + (size_t)row * DM : dc + (size_t)(row - TL) * DM;
    const int mi = row < TL ? (row >> 14) : 2;
    const f32x4 g = *(const f32x4*)(gate + mi * 6144 + n);
    const f32x4 r = *(const f32x4*)(s + n);
    f32x4 o;
#pragma unroll
    for (int j = 0; j < 4; ++j) o[j] = r[j] + g[j] * v[j];
    *(f32x4*)(d + n) = o;
  }
};

template <class Epi>
DI void gemm_phase(const bf16_t* A, const bf16_t* Bt, int mtiles, int ntiles, int K, const Epi& epi, unsigned char* smem, int bid, int nb) {
  const int tid = ltid(), lane = tid & 63, wave = tid >> 6;
  const int wm = wave & 1, wn = wave >> 1, l31 = lane & 31, hh = lane >> 5;
  unsigned char* As0 = smem;
  unsigned char* Bs0 = smem + 2 * 128 * LDS_STRIDE;
  const int nk = K >> 6;
  const int ldrow = tid >> 3, ldcol = (tid & 7) * 8;
  const int total = mtiles * ntiles;
  const int xper = (nb >> 3) > 0 ? (nb >> 3) : 1;
  const int xcd = nb >= 8 ? (bid & 7) : 0, xj = nb >= 8 ? (bid >> 3) : bid, xstep = nb >= 8 ? 8 : 1;
  if (nb >= 8 && bid >= xper * 8) return;
  for (int ch = xcd; ch * xper + xj < total; ch += xstep) {
    const int it = ch * xper + xj;
    const int band = it / (8 * ntiles), rr = it - band * 8 * ntiles;
    const int rib = (mtiles - 8 * band) < 8 ? (mtiles - 8 * band) : 8;
    const int pn = rr / rib, pm = 8 * band + rr % rib;
    const bf16_t* Ap = A + (size_t)(pm * 128 + ldrow) * K + ldcol;
    const bf16_t* Bp = Bt + (size_t)(pn * 128 + ldrow) * K + ldcol;
    f32x16 acc[2][2];
#pragma unroll
    for (int a = 0; a < 2; ++a)
#pragma unroll
      for (int b = 0; b < 2; ++b)
#pragma unroll
        for (int i = 0; i < 16; ++i) acc[a][b][i] = 0.f;
    u32x4 ra0[4], rb0[4], ra1[4], rb1[4];
#define G_LOAD(RA, RB, KT) do { _Pragma("unroll") for (int i = 0; i < 4; ++i) { RA[i] = *(const u32x4*)(Ap + (size_t)i * 32 * K + (KT) * 64); RB[i] = *(const u32x4*)(Bp + (size_t)i * 32 * K + (KT) * 64); } } while (0)
#define G_STORE(RA, RB, BUF) do { unsigned char* Aw = As0 + (BUF) * 128 * LDS_STRIDE; unsigned char* Bw = Bs0 + (BUF) * 128 * LDS_STRIDE; \
      _Pragma("unroll") for (int i = 0; i < 4; ++i) { *(u32x4*)(Aw + (ldrow + 32 * i) * LDS_STRIDE + ldcol * 2) = RA[i]; *(u32x4*)(Bw + (ldrow + 32 * i) * LDS_STRIDE + ldcol * 2) = RB[i]; } } while (0)
#define G_COMPUTE(BUF) do { const unsigned char* As = As0 + (BUF) * 128 * LDS_STRIDE; const unsigned char* Bs = Bs0 + (BUF) * 128 * LDS_STRIDE; \
      _Pragma("unroll") for (int ks = 0; ks < 4; ++ks) { bf16x8 wf[2], af[2]; \
        _Pragma("unroll") for (int i = 0; i < 2; ++i) { \
          wf[i] = *(const bf16x8*)(Bs + (wn * 64 + i * 32 + l31) * LDS_STRIDE + (ks * 16 + 8 * hh) * 2); \
          af[i] = *(const bf16x8*)(As + (wm * 64 + i * 32 + l31) * LDS_STRIDE + (ks * 16 + 8 * hh) * 2); } \
        _Pragma("unroll") for (int ni = 0; ni < 2; ++ni) _Pragma("unroll") for (int mi = 0; mi < 2; ++mi) acc[ni][mi] = MFMA32(wf[ni], af[mi], acc[ni][mi]); } } while (0)
    G_LOAD(ra0, rb0, 0);
    G_LOAD(ra1, rb1, 1);
    G_STORE(ra0, rb0, 0);
    __syncthreads();
#pragma unroll 1
    for (int kt = 0; kt < nk; kt += 2) {
      const int k2 = kt + 2 < nk ? kt + 2 : 0, k3 = kt + 3 < nk ? kt + 3 : 1;
      G_LOAD(ra0, rb0, k2);
      G_COMPUTE(0);
      G_STORE(ra1, rb1, 1);
      __syncthreads();
      G_LOAD(ra1, rb1, k3);
      G_COMPUTE(1);
      G_STORE(ra0, rb0, 0);
      __syncthreads();
    }
#pragma unroll
    for (int ni = 0; ni < 2; ++ni)
#pragma unroll
      for (int mi = 0; mi < 2; ++mi) {
        const int m = pm * 128 + wm * 64 + mi * 32 + l31;
#pragma unroll
        for (int g = 0; g < 4; ++g) {
          const int n = pn * 128 + wn * 64 + ni * 32 + 8 * g + 4 * hh;
          f32x4 v = {acc[ni][mi][4 * g], acc[ni][mi][4 * g + 1], acc[ni][mi][4 * g + 2], acc[ni][mi][4 * g + 3]};
          epi(m, n, v);
        }
      }
  }
}

struct EpiResidAtomic {
  float* dl; float* dc; const float* gate; int row0;
  DI void operator()(int m, int n, f32x4 v) const {
    const int row = m + row0;
    float* d = row < TL ? dl + (size_t)row * DM : dc + (size_t)(row - TL) * DM;
    const int mi = row < TL ? (row >> 14) : 2;
    const f32x4 g = *(const f32x4*)(gate + mi * 6144 + n);
#pragma unroll
    for (int j = 0; j < 4; ++j) unsafeAtomicAdd(d + n + j, g[j] * v[j]);
  }
};

template <class Epi>
DI void gemm_phase512(const bf16_t* A, const bf16_t* Bt, int mtiles, int ntiles, int K, int Kper, int ksplit, const Epi& epi,
                      unsigned char* smem, int bid, int nb) {
  const int tid = ltid512(), lane = tid & 63, wave = tid >> 6;
  const int wm = wave & 1, wn = wave >> 1, l31 = lane & 31, hh = lane >> 5;
  constexpr int OPB = 256 * LDS_STRIDE;
  unsigned char* As0 = smem;
  unsigned char* Bs0 = smem + 2 * OPB;
  const int nk = Kper >> 6;
  const int ldrow = tid >> 3, ldcol = (tid & 7) * 8;
  const int ntile = mtiles * ntiles, total = ntile * ksplit;
  const int xper = (nb >> 3) > 0 ? (nb >> 3) : 1;
  const bool grouped = (ksplit == 1) && (nb >= 8) && ((nb & 7) == 0);
  const int xcd = bid & 7, xj = bid >> 3;
  for (int step = 0;; ++step) {
    int it;
    if (grouped) it = (xcd + 8 * step) * xper + xj; else it = bid + step * nb;
    if (it >= total) break;
    const int tile = it / ksplit, ks = it - tile * ksplit;
    const int band = tile / (8 * ntiles), rr = tile - band * 8 * ntiles;
    const int rib = (mtiles - 8 * band) < 8 ? (mtiles - 8 * band) : 8;
    const int pn = rr / rib, pm = 8 * band + rr % rib;
    const bf16_t* Ap = A + (size_t)(pm * 256 + ldrow) * K + ks * Kper + ldcol;
    const bf16_t* Bp = Bt + (size_t)(pn * 256 + ldrow) * K + ks * Kper + ldcol;
    f32x16 acc[2][4];
#pragma unroll
    for (int a = 0; a < 2; ++a)
#pragma unroll
      for (int b = 0; b < 4; ++b)
#pragma unroll
        for (int i = 0; i < 16; ++i) acc[a][b][i] = 0.f;
    u32x4 ra[4], rb[4];
#define H_LOAD(KT) do { _Pragma("unroll") for (int i = 0; i < 4; ++i) { ra[i] = *(const u32x4*)(Ap + (size_t)i * 64 * K + (KT) * 64); rb[i] = *(const u32x4*)(Bp + (size_t)i * 64 * K + (KT) * 64); } } while (0)
#define H_STORE(BUF) do { unsigned char* Aw = As0 + (BUF) * OPB; unsigned char* Bw = Bs0 + (BUF) * OPB; \
      _Pragma("unroll") for (int i = 0; i < 4; ++i) { *(u32x4*)(Aw + (ldrow + 64 * i) * LDS_STRIDE + ldcol * 2) = ra[i]; *(u32x4*)(Bw + (ldrow + 64 * i) * LDS_STRIDE + ldcol * 2) = rb[i]; } } while (0)
    H_LOAD(0);
    H_STORE(0);
    __syncthreads();
#pragma unroll 1
    for (int kt = 0; kt < nk; ++kt) {
      const int buf = kt & 1;
      const int kn = kt + 1 < nk ? kt + 1 : 0;
      H_LOAD(kn);
      const unsigned char* As = As0 + buf * OPB;
      const unsigned char* Bs = Bs0 + buf * OPB;
#pragma unroll
      for (int k16 = 0; k16 < 4; ++k16) {
        bf16x8 wf[2], af[4];
#pragma unroll
        for (int i = 0; i < 2; ++i) wf[i] = *(const bf16x8*)(Bs + (wn * 64 + i * 32 + l31) * LDS_STRIDE + (k16 * 16 + 8 * hh) * 2);
#pragma unroll
        for (int i = 0; i < 4; ++i) af[i] = *(const bf16x8*)(As + (wm * 128 + i * 32 + l31) * LDS_STRIDE + (k16 * 16 + 8 * hh) * 2);
#pragma unroll
        for (int ni = 0; ni < 2; ++ni)
#pragma unroll
          for (int mi = 0; mi < 4; ++mi) acc[ni][mi] = MFMA32(wf[ni], af[mi], acc[ni][mi]);
      }
      H_STORE(buf ^ 1);
      __syncthreads();
    }
#pragma unroll
    for (int ni = 0; ni < 2; ++ni)
#pragma unroll
      for (int mi = 0; mi < 4; ++mi) {
        const int m = pm * 256 + wm * 128 + mi * 32 + l31;
#pragma unroll
        for (int g = 0; g < 4; ++g) {
          const int n = pn * 256 + wn * 64 + ni * 32 + 8 * g + 4 * hh;
          f32x4 v = {acc[ni][mi][4 * g], acc[ni][mi][4 * g + 1], acc[ni][mi][4 * g + 2], acc[ni][mi][4 * g + 3]};
          epi(m, n, v);
        }
      }
  }
}

DI float hg_lb(const Params& p, int layer, int d, int j) {
  if (layer == 0) return 0.f;
  const float l0 = p.hg_lb_logits[d * 256 + j], l1 = p.hg_lb_logits[512 + d * 256 + j];
  return 1.f / (1.f + expf(l0 - l1));
}

DI void prep32_item(const Params& p, int layer, int it) {
  const int idx = it * 256 + ltid();
  const int row = idx >> 4, j = idx & 15, isk = j >> 3, sub = j & 7;
  bf16_t* ptr = p.P + (size_t)row * NP + isk * 256 + sub * 32;
  const float* gain = (isk ? p.da_k_gain : p.da_q_gain) + layer * 32;
  float v[32];
#pragma unroll
  for (int i = 0; i < 4; ++i) {
    const u32x4 w = *(const u32x4*)(ptr + 8 * i);
#pragma unroll
    for (int q = 0; q < 4; ++q) { v[8 * i + 2 * q] = bf_lo(w[q]); v[8 * i + 2 * q + 1] = bf_hi(w[q]); }
  }
  float ss = 0.f;
#pragma unroll
  for (int i = 0; i < 32; ++i) ss += v[i] * v[i];
  const float r = rsqrtf(ss * (1.f / 32.f) + EPS);
#pragma unroll
  for (int i = 0; i < 32; ++i) v[i] = v[i] * r * gain[i];
  if (row < TL) {
    const int t = row & (SEQ - 1);
    const float gr = (float)(t >> 6), gc = (float)(t & 63);
#pragma unroll
    for (int i = 0; i < 8; ++i) {
      constexpr float FRA[8] = {1.f, 0.31622776601683794f, 0.1f, 0.031622776601683794f, 0.01f, 0.0031622776601683794f, 0.001f, 0.00031622776601683794f};
      const float fr = FRA[i];
      const float ar = gr * fr, ac = gc * fr;
      const float cr = __cosf(ar), sr = __sinf(ar), cc = __cosf(ac), sc = __sinf(ac);
      const float x1 = v[i], x2 = v[8 + i];
      v[i] = x1 * cr - x2 * sr; v[8 + i] = x1 * sr + x2 * cr;
      const float y1 = v[16 + i], y2 = v[24 + i];
      v[16 + i] = y1 * cc - y2 * sc; v[24 + i] = y1 * sc + y2 * cc;
    }
  }
  const float qs = isk ? 1.f : (0.17677669529663687f * LOG2E);
#pragma unroll
  for (int i = 0; i < 4; ++i) {
    u32x4 w;
#pragma unroll
    for (int q = 0; q < 4; ++q) w[q] = pk2(v[8 * i + 2 * q] * qs, v[8 * i + 2 * q + 1] * qs);
    *(u32x4*)(ptr + 8 * i) = w;
  }
}

DI void prep64_item(const Params& p, int layer, int it) {
  const int idx = it * 256 + ltid();
  const int row = idx / 14, j = idx % 14;
  int col; const float* gain; bool rope, isq;
  if (j < 4) { col = 2048 + 64 * j; gain = p.na_q_gain; rope = false; isq = true; }
  else if (j < 8) { col = 2304 + 64 * (j - 4); gain = p.na_k_gain; rope = false; isq = false; }
  else if (j < 12) { col = 2816 + 64 * (j - 8); gain = p.sw_q_gain; rope = true; isq = true; }
  else { col = 3072 + 64 * (j - 12); gain = p.sw_k_gain; rope = true; isq = false; }
  gain += layer * 64;
  bf16_t* ptr = p.P + (size_t)row * NP + col;
  float v[64];
#pragma unroll
  for (int i = 0; i < 8; ++i) {
    const u32x4 w = *(const u32x4*)(ptr + 8 * i);
#pragma unroll
    for (int q = 0; q < 4; ++q) { v[8 * i + 2 * q] = bf_lo(w[q]); v[8 * i + 2 * q + 1] = bf_hi(w[q]); }
  }
  float ss = 0.f;
#pragma unroll
  for (int i = 0; i < 64; ++i) ss += v[i] * v[i];
  const float r = rsqrtf(ss * (1.f / 64.f) + EPS);
#pragma unroll
  for (int i = 0; i < 64; ++i) v[i] = v[i] * r * gain[i];
  if (rope && row < TL) {
    const int t = row & (SEQ - 1);
    const float gr = (float)(t >> 6), gc = (float)(t & 63);
#pragma unroll
    for (int i = 0; i < 16; ++i) {
      constexpr float FRD[16] = {1.f, 0.5623413251903491f, 0.31622776601683794f, 0.1778279410038923f, 0.1f, 0.05623413251903491f, 0.031622776601683794f, 0.01778279410038923f, 0.01f, 0.005623413251903491f, 0.0031622776601683794f, 0.001778279410038923f, 0.001f, 0.0005623413251903491f, 0.00031622776601683794f, 0.0001778279410038923f};
      const float fr = FRD[i];
      const float ar = gr * fr, ac = gc * fr;
      const float cr = __cosf(ar), sr = __sinf(ar), cc = __cosf(ac), sc = __sinf(ac);
      const float x1 = v[i], x2 = v[16 + i];
      v[i] = x1 * cr - x2 * sr; v[16 + i] = x1 * sr + x2 * cr;
      const float y1 = v[32 + i], y2 = v[48 + i];
      v[32 + i] = y1 * cc - y2 * sc; v[48 + i] = y1 * sc + y2 * cc;
    }
  }
  const float qs = isq ? (0.125f * LOG2E) : 1.f;
#pragma unroll
  for (int i = 0; i < 8; ++i) {
    u32x4 w;
#pragma unroll
    for (int q = 0; q < 4; ++q) w[q] = pk2(v[8 * i + 2 * q] * qs, v[8 * i + 2 * q + 1] * qs);
    *(u32x4*)(ptr + 8 * i) = w;
  }
}

DI void vt_item(const Params& p, int it, unsigned char* smem) {
  const int tid = ltid();
  const int hv = it % 10, ug = (it / 10) % NCHUNK, b = it / (10 * NCHUNK);
  int vcol; bf16_t* dst;
  if (hv < 4) { vcol = 512 + 64 * hv; dst = p.VtA + (size_t)(b * 4 + hv) * 64 * UA; }
  else if (hv < 8) { vcol = 2560 + 64 * (hv - 4); dst = p.VtC + (size_t)(b * 4 + hv - 4) * 64 * UA; }
  else { vcol = 3200 + 64 * (hv - 8); dst = p.VtD + (size_t)(b * 2 + hv - 8) * 64 * UA; }
  const int u0 = ug * 64;
  bf16_t* tile = (bf16_t*)smem;
  {
    const int tk = tid >> 2, seg = (tid & 3) * 16;
    const int row = rowOfU(b, u0 + tk);
    const bf16_t* src = p.P + (size_t)row * NP + vcol + seg;
    const u32x4 w0 = *(const u32x4*)src, w1 = *(const u32x4*)(src + 8);
    unsigned* tp = (unsigned*)(tile + tk * 66 + seg);
#pragma unroll
    for (int q = 0; q < 4; ++q) { tp[q] = w0[q]; tp[4 + q] = w1[q]; }
  }
  __syncthreads();
  {
    const int dv = tid >> 2, tq = (tid & 3) * 16;
    u32x4 w0, w1;
#pragma unroll
    for (int q = 0; q < 4; ++q) {
      w0[q] = (unsigned)tile[(tq + 2 * q) * 66 + dv] | ((unsigned)tile[(tq + 2 * q + 1) * 66 + dv] << 16);
      w1[q] = (unsigned)tile[(tq + 8 + 2 * q) * 66 + dv] | ((unsigned)tile[(tq + 8 + 2 * q + 1) * 66 + dv] << 16);
    }
    bf16_t* dp = dst + (size_t)dv * UA + u0 + tq;
    *(u32x4*)dp = w0; *(u32x4*)(dp + 8) = w1;
  }
  __syncthreads();
}

DI int hg_row(int b, int d, int n, int pp) {
  if (n < 4) { const int c = d ? 255 - (64 * n + pp) : 64 * n + pp; return TL + b * CTX + c; }
  const int t = d ? SEQ - 1 - (64 * (n - 4) + pp) : 64 * (n - 4) + pp;
  return b * SEQ + t;
}

DI void hgsum_item(const Params& p, int layer, int it, unsigned char* smem) {
  const int tid = ltid();
  const int n = it % NCHUNK, chain = it / NCHUNK, d = chain & 1, hh = (chain >> 1) & 3, b = chain >> 3;
  float* cumT = (float*)smem;
  float* wk = cumT + 64 * 65;
  float* vv = wk + 64 * 64;
  const int pp = tid >> 2, kq = (tid & 3) * 16;
  {
    const int row = hg_row(b, d, n, pp);
    const bf16_t* pr = p.P + (size_t)row * NP;
    const bf16_t* fp = pr + 1536 + d * 256 + hh * 64 + kq;
    const bf16_t* vp = pr + 1024 + hh * 64 + kq;
    const u32x4 f0 = *(const u32x4*)fp, f1 = *(const u32x4*)(fp + 8), v0 = *(const u32x4*)vp, v1 = *(const u32x4*)(vp + 8);
    float fx[16], vx[16];
#pragma unroll
    for (int q = 0; q < 4; ++q) { fx[2 * q] = bf_lo(f0[q]); fx[2 * q + 1] = bf_hi(f0[q]); fx[8 + 2 * q] = bf_lo(f1[q]); fx[8 + 2 * q + 1] = bf_hi(f1[q]);
                                  vx[2 * q] = bf_lo(v0[q]); vx[2 * q + 1] = bf_hi(v0[q]); vx[8 + 2 * q] = bf_lo(v1[q]); vx[8 + 2 * q + 1] = bf_hi(v1[q]); }
#pragma unroll
    for (int j = 0; j < 16; ++j) {
      const float lb = hg_lb(p, layer, d, hh * 64 + kq + j);
      const float sg = 1.f / (1.f + expf(-fx[j]));
      const float f = lb + (1.f - lb) * sg;
      cumT[(kq + j) * 65 + pp] = logf(f) * LOG2E;
      wk[pp * 64 + kq + j] = 1.f - f;
      vv[pp * 64 + kq + j] = vx[j];
    }
  }
  __syncthreads();
  if (tid < 64) {
    float run = 0.f;
    for (int q = 0; q < 64; ++q) { run += cumT[tid * 65 + q]; cumT[tid * 65 + q] = run; }
  }
  __syncthreads();
#pragma unroll
  for (int j = 0; j < 16; ++j) {
    const int k = kq + j;
    wk[pp * 64 + k] *= fexp2(cumT[k * 65 + 63] - cumT[k * 65 + pp]);
  }
  __syncthreads();
  {
    const int kg = tid >> 6, v = tid & 63;
    float acc[16];
#pragma unroll
    for (int j = 0; j < 16; ++j) acc[j] = 0.f;
    for (int q = 0; q < 64; ++q) {
      const float vq = vv[q * 64 + v];
#pragma unroll
      for (int j4 = 0; j4 < 4; ++j4) {
        const f32x4 w4 = *(const f32x4*)(wk + q * 64 + kg * 16 + 4 * j4);
#pragma unroll
        for (int a = 0; a < 4; ++a) acc[4 * j4 + a] += w4[a] * vq;
      }
    }
    float* L = p.HL + ((size_t)(chain * NCHUNK + n)) * 4096;
#pragma unroll
    for (int j = 0; j < 16; ++j) L[(kg * 16 + j) * 64 + v] = acc[j];
    if (tid < 64) p.Hdec[(chain * NCHUNK + n) * 64 + tid] = fexp2(cumT[tid * 65 + 63]);
  }
  __syncthreads();
}

DI void prep_phase(const Params& p, int layer, unsigned char* smem, int bid, int nb) {
  constexpr int n_hg = 16 * NCHUNK;
  constexpr int n_vt = 2 * NCHUNK * 10;
  constexpr int n_p32 = TA * 16 / 256;
  constexpr int n_p64 = TA * 14 / 256;
  constexpr int total = n_hg + n_vt + n_p32 + n_p64;
  for (int it = bid; it < total; it += nb) {
    if (it < n_hg) hgsum_item(p, layer, it, smem);
    else if (it < n_hg + n_vt) vt_item(p, it - n_hg, smem);
    else if (it < n_hg + n_vt + n_p32) prep32_item(p, layer, it - n_hg - n_vt);
    else prep64_item(p, layer, it - n_hg - n_vt - n_p32);
  }
}

DI void scan_item(const Params& p, int it) {
  const int chain = it >> 4, e = (it & 15) * 256 + ltid(), k = e >> 6;
  float* L = p.HL + (size_t)chain * NCHUNK * 4096 + e;
  const float* dc = p.Hdec + chain * NCHUNK * 64 + k;
  float S = 0.f;
  for (int n0 = 0; n0 < NCHUNK; n0 += 10) {
    float l[10], dd[10];
#pragma unroll
    for (int j = 0; j < 10; ++j) { l[j] = L[(size_t)(n0 + j) * 4096]; dd[j] = dc[(n0 + j) * 64]; }
#pragma unroll
    for (int j = 0; j < 10; ++j) { L[(size_t)(n0 + j) * 4096] = S; S = dd[j] * S + l[j]; }
  }
}

DI void attnA_block(const Params& p, int layer, unsigned char* smem, int b, int h, int qrow_blk, int ubeg, int uend) {
  const int tid = ltid(), wave = tid >> 6;
  const int lane = tid & 63, qi = lane & 31, hh = lane >> 5;
  const int qrow0 = qrow_blk + wave * 32;
  const int pr = (qi & 19) | ((qi & 4) << 1) | ((qi & 8) >> 1);
  const float lam_init = layer == 0 ? 0.2f : 0.35550906759096f;
  float gq = lane < 32 ? fabsf(p.da_q_gain[layer * 32 + lane]) : 0.f, gk = lane < 32 ? fabsf(p.da_k_gain[layer * 32 + lane]) : 0.f;
  gq = wave_max(gq); gk = wave_max(gk);
  const float negM2 = -(0.17677669529663687f * LOG2E * 32.f * 1.02f) * gq * gk;
  float la = 0.f, lb_ = 0.f;
  if (lane < 32) { const float* lv = p.da_lambda + layer * 128; la = lv[lane] * lv[32 + lane]; lb_ = lv[64 + lane] * lv[96 + lane]; }
  la = wave_sum(la); lb_ = wave_sum(lb_);
  const float lam = expf(la) - expf(lb_) + lam_init;

  const bf16_t* qp = p.P + (size_t)(qrow0 + qi) * NP + h * 64 + 8 * hh;
  bf16x8 qf[2][2];
#pragma unroll
  for (int m = 0; m < 2; ++m)
#pragma unroll
    for (int ks = 0; ks < 2; ++ks) qf[m][ks] = *(const bf16x8*)(qp + m * 32 + ks * 16);
  f32x16 o[2][2];
#pragma unroll
  for (int m = 0; m < 2; ++m)
#pragma unroll
    for (int dh = 0; dh < 2; ++dh)
#pragma unroll
      for (int i = 0; i < 16; ++i) o[m][dh][i] = 0.f;
  float ls[2] = {0.f, 0.f};
  constexpr int STG = 2 * 64 * LDS_STRIDE;
  const int lrow = tid >> 3, lch = tid & 7;
  const bf16_t* kg = p.P + 256 + h * 64 + lch * 8;
  const bf16_t* vg = p.VtA + ((size_t)((b * 4 + h) * 64 + lrow)) * UA + lch * 8;
  u32x4 rk0, rk1, rv0, rv1;
  rk0 = *(const u32x4*)(kg + (size_t)rowOfU(b, ubeg + lrow) * NP);
  rk1 = *(const u32x4*)(kg + (size_t)rowOfU(b, ubeg + lrow + 32) * NP);
  rv0 = *(const u32x4*)(vg + ubeg);
  rv1 = *(const u32x4*)(vg + (size_t)32 * UA + ubeg);
  __syncthreads();
  asm volatile("" :: "v"(qf[0][0]), "v"(qf[0][1]), "v"(qf[1][0]), "v"(qf[1][1]));
  {
    unsigned char* Ks = smem; unsigned char* Vs = smem + 64 * LDS_STRIDE;
    *(u32x4*)(Ks + lrow * LDS_STRIDE + lch * 16) = rk0; *(u32x4*)(Ks + (lrow + 32) * LDS_STRIDE + lch * 16) = rk1;
    *(u32x4*)(Vs + lrow * LDS_STRIDE + lch * 16) = rv0; *(u32x4*)(Vs + (lrow + 32) * LDS_STRIDE + lch * 16) = rv1;
  }
  __syncthreads();
  int buf = 0;
  for (int u0 = ubeg; u0 < uend; u0 += 64) {
    const bool more = u0 + 64 < uend;
    if (more) {
      rk0 = *(const u32x4*)(kg + (size_t)rowOfU(b, u0 + 64 + lrow) * NP);
      rk1 = *(const u32x4*)(kg + (size_t)rowOfU(b, u0 + 64 + lrow + 32) * NP);
      rv0 = *(const u32x4*)(vg + u0 + 64);
      rv1 = *(const u32x4*)(vg + (size_t)32 * UA + u0 + 64);
    }
    const unsigned char* Ks = smem + buf * STG;
    const unsigned char* Vs = Ks + 64 * LDS_STRIDE;
#pragma unroll
    for (int sub = 0; sub < 2; ++sub) {
      bf16x8 vf[2][2];
#pragma unroll
      for (int dh = 0; dh < 2; ++dh)
#pragma unroll
        for (int s2 = 0; s2 < 2; ++s2) vf[dh][s2] = *(const bf16x8*)(Vs + (32 * dh + qi) * LDS_STRIDE + (32 * sub + 16 * s2 + 8 * hh) * 2);
#pragma unroll
      for (int m = 0; m < 2; ++m) {
        const unsigned char* kr = Ks + (32 * sub + pr) * LDS_STRIDE + (m * 32 + 8 * hh) * 2;
        const bf16x8 kf0 = *(const bf16x8*)kr, kf1 = *(const bf16x8*)(kr + 32);
        f32x16 s;
#pragma unroll
        for (int i = 0; i < 16; ++i) s[i] = negM2;
        s = MFMA32(kf0, qf[m][0], s);
        s = MFMA32(kf1, qf[m][1], s);
        float pe[16];
#pragma unroll
        for (int i = 0; i < 16; ++i) { pe[i] = fexp2(s[i]); ls[m] += pe[i]; }
#pragma unroll
        for (int s2 = 0; s2 < 2; ++s2) {
          u32x4 pw;
#pragma unroll
          for (int q = 0; q < 4; ++q) pw[q] = pk2(pe[8 * s2 + 2 * q], pe[8 * s2 + 2 * q + 1]);
          const bf16x8 pf = __builtin_bit_cast(bf16x8, pw);
#pragma unroll
          for (int dh = 0; dh < 2; ++dh) o[m][dh] = MFMA32(vf[dh][s2], pf, o[m][dh]);
        }
      }
    }
    if (more) {
      unsigned char* Kw = smem + (buf ^ 1) * STG; unsigned char* Vw = Kw + 64 * LDS_STRIDE;
      *(u32x4*)(Kw + lrow * LDS_STRIDE + lch * 16) = rk0; *(u32x4*)(Kw + (lrow + 32) * LDS_STRIDE + lch * 16) = rk1;
      *(u32x4*)(Vw + lrow * LDS_STRIDE + lch * 16) = rv0; *(u32x4*)(Vw + (lrow + 32) * LDS_STRIDE + lch * 16) = rv1;
    }
    __syncthreads();
    buf ^= 1;
  }
  const float l0 = ls[0] + __shfl_xor(ls[0], 32), l1 = ls[1] + __shfl_xor(ls[1], 32);
  const float i0 = 1.f / l0, c1 = lam / l1;
  float ss = 0.f;
#pragma unroll
  for (int dh = 0; dh < 2; ++dh)
#pragma unroll
    for (int i = 0; i < 16; ++i) { const float v = o[0][dh][i] * i0 - o[1][dh][i] * c1; o[0][dh][i] = v; ss += v * v; }
  ss += __shfl_xor(ss, 32);
  const float r = rsqrtf(ss * (1.f / 64.f) + EPS) * (1.f - lam_init);
  bf16_t* op = p.MO + (size_t)(qrow0 + qi) * DM + h * 64;
  const float* sg = p.da_sub_gain + layer * 64;
#pragma unroll
  for (int dh = 0; dh < 2; ++dh)
#pragma unroll
    for (int g = 0; g < 4; ++g) {
      const int dv = 32 * dh + 8 * g + 4 * hh;
      const f32x4 g4 = *(const f32x4*)(sg + dv);
      u32x2 w;
      w[0] = pk2(o[0][dh][4 * g] * r * g4[0], o[0][dh][4 * g + 1] * r * g4[1]);
      w[1] = pk2(o[0][dh][4 * g + 2] * r * g4[2], o[0][dh][4 * g + 3] * r * g4[3]);
      *(u32x2*)(op + dv) = w;
    }
}

template <class MaskF>
DI void attn64_step(const bf16_t* kp  , const bf16_t* vp  ,
                    const bf16x8 (&qf)[4], f32x16 (&o)[2], float& ls, float negM2, int hh, MaskF maskf) {
  bf16x8 kf[4], vf[2][2];
#pragma unroll
  for (int ks = 0; ks < 4; ++ks) kf[ks] = *(const bf16x8*)(kp + ks * 16);
#pragma unroll
  for (int dh = 0; dh < 2; ++dh)
#pragma unroll
    for (int s2 = 0; s2 < 2; ++s2) vf[dh][s2] = *(const bf16x8*)(vp + (size_t)dh * 32 * UA + s2 * 16);
  f32x16 s;
#pragma unroll
  for (int i = 0; i < 16; ++i) s[i] = negM2;
#pragma unroll
  for (int ks = 0; ks < 4; ++ks) s = MFMA32(kf[ks], qf[ks], s);
  float pe[16];
#pragma unroll
  for (int i = 0; i < 16; ++i) { const int kslot = 16 * (i >> 3) + 8 * hh + (i & 7); pe[i] = fexp2(maskf(kslot, s[i])); ls += pe[i]; }
#pragma unroll
  for (int s2 = 0; s2 < 2; ++s2) {
    u32x4 pw;
#pragma unroll
    for (int q = 0; q < 4; ++q) pw[q] = pk2(pe[8 * s2 + 2 * q], pe[8 * s2 + 2 * q + 1]);
    const bf16x8 pf = __builtin_bit_cast(bf16x8, pw);
#pragma unroll
    for (int dh = 0; dh < 2; ++dh) o[dh] = MFMA32(vf[dh][s2], pf, o[dh]);
  }
}

template <int MODE>
DI void attn64_wave(const Params& p, int layer, int b, int hq, int qrow0, int t0) {
  constexpr bool isC = (MODE == 0 || MODE == 2);
  const int lane = ltid() & 63, qi = lane & 31, hh = lane >> 5;
  const int pr = (qi & 19) | ((qi & 4) << 1) | ((qi & 8) >> 1);
  const float* gqp = (isC ? p.na_q_gain : p.sw_q_gain) + layer * 64;
  const float* gkp = (isC ? p.na_k_gain : p.sw_k_gain) + layer * 64;
  const float gq = wave_max(fabsf(gqp[lane])), gk = wave_max(fabsf(gkp[lane]));
  const float negM2 = -(0.125f * LOG2E * 64.f * 1.02f) * gq * gk;
  const int kvh = isC ? hq : (hq >> 1);
  const int qcol = isC ? 2048 + 64 * hq : 2816 + 64 * hq;
  const int kcol = isC ? 2304 + 64 * hq : 3072 + 64 * kvh;
  const bf16_t* vt = isC ? p.VtC + (size_t)(b * 4 + hq) * 64 * UA : p.VtD + (size_t)(b * 2 + kvh) * 64 * UA;
  const bf16_t* vbase = vt + (size_t)qi * UA + 8 * hh;
  const bf16_t* kbase = p.P + kcol + 8 * hh;
  const bf16_t* qp = p.P + (size_t)(qrow0 + qi) * NP + qcol + 8 * hh;
  bf16x8 qf[4];
#pragma unroll
  for (int ks = 0; ks < 4; ++ks) qf[ks] = *(const bf16x8*)(qp + ks * 16);
  f32x16 o[2];
#pragma unroll
  for (int dh = 0; dh < 2; ++dh)
#pragma unroll
    for (int i = 0; i < 16; ++i) o[dh][i] = 0.f;
  float ls = 0.f;
  for (int u0 = 0; u0 < CTX; u0 += 32) {
    const bf16_t* kp = kbase + (size_t)(TL + b * CTX + u0 + pr) * NP;
    attn64_step(kp, vbase + u0, qf, o, ls, negM2, hh, [](int, float s) { return s; });
  }
  if (MODE == 0) {
    const int r = t0 >> 6, c = (t0 & 63) + qi;
    const int rs = min(max(r - 4, 0), 248);
    const int ws = min(max(c - 8, 0), 48);
    const float* rpb = p.na_rpb + (size_t)(layer * 4 + hq) * 15 * 31;
    for (int kr = rs; kr < rs + 8; ++kr) {
      const float* rrow = rpb + (kr - r + 7) * 31 + 15 - c;
#pragma unroll 1
      for (int hf = 0; hf < 2; ++hf) {
        const int kt0 = kr * 64 + hf * 32;
        const bf16_t* kp = kbase + (size_t)(b * SEQ + kt0 + pr) * NP;
        attn64_step(kp, vbase + CTX + kt0, qf, o, ls, negM2, hh, [&](int kslot, float s) {
          const int kc = hf * 32 + kslot;
          const bool valid = (kc >= ws) && (kc < ws + 16);
          const int kcc = min(max(kc, ws), ws + 15);
          return valid ? s + rrow[kcc] * LOG2E : -1e30f;
        });
      }
    }
  } else if (MODE == 1) {
    const int qt = t0 + qi;
    for (int jt = 0; jt < 9; ++jt) {
      const int kt0 = t0 - 128 + 32 * jt;
      if (kt0 < 0 || kt0 >= SEQ) continue;
      const bf16_t* kp = kbase + (size_t)(b * SEQ + kt0 + pr) * NP;
      if (jt == 0 || jt == 8) {
        attn64_step(kp, vbase + CTX + kt0, qf, o, ls, negM2, hh, [&](int kslot, float s) {
          const int dd = kt0 + kslot - qt;
          return (dd <= 128 && dd >= -128) ? s : -1e30f;
        });
      } else {
        attn64_step(kp, vbase + CTX + kt0, qf, o, ls, negM2, hh, [](int, float s) { return s; });
      }
    }
  }
  float l = ls + __shfl_xor(ls, 32);
  if (!isC) l += fexp2(p.sw_sink[layer * 4 + hq] * LOG2E + negM2);
  const float il = 1.f / l;
  bf16_t* op = p.MO + (size_t)(qrow0 + qi) * DM + (isC ? 512 : 768) + hq * 64;
#pragma unroll
  for (int dh = 0; dh < 2; ++dh)
#pragma unroll
    for (int g = 0; g < 4; ++g) {
      const int dv = 32 * dh + 8 * g + 4 * hh;
      u32x2 w;
      w[0] = pk2(o[dh][4 * g] * il, o[dh][4 * g + 1] * il);
      w[1] = pk2(o[dh][4 * g + 2] * il, o[dh][4 * g + 3] * il);
      *(u32x2*)(op + dv) = w;
    }
}

DI void mix_phase(const Params& p, int layer, unsigned char* smem, int bid, int nb) {
  const int wave = ltid() >> 6;
  const int n_scan = 256, n_lat = 1024, n_ctx = layer == 0 ? 16 : 0;
  const int e0 = n_scan, e1 = e0 + n_lat, e2 = e1 + n_ctx, e3 = e2 + n_lat, e4 = e3 + n_lat, e5 = e4 + n_ctx, e6 = e5 + n_ctx;
  {
    const int rb = bid >> 1, bh = rb & 7, per = nb >> 3;
    if (bid < per * 8)
    for (int qb = ((rb >> 3) << 1) | (bid & 1); qb < 128; qb += per) attnA_block(p, layer, smem, bh >> 2, bh & 3, (bh >> 2) * SEQ + qb * 128, 0, UA);
  }
  for (int it = bid; it < e6; it += nb) {
    if (it < e0) scan_item(p, it);
    else if (it < e1) {
    } else if (it < e2) {
      const int j = it - e1, qb = j & 1, h = (j >> 1) & 3, b = j >> 3;
      attnA_block(p, layer, smem, b, h, TL + b * CTX + qb * 128, 0, CTX);
    } else if (it < e3) {
      const int j = it - e2, qb = j & 127, hq = (j >> 7) & 3, b = j >> 9;
      const int t0 = qb * 128 + wave * 32;
      attn64_wave<1>(p, layer, b, hq, b * SEQ + t0, t0);
    } else if (it < e4) {
      const int j = it - e3, qb = j & 127, hq = (j >> 7) & 3, b = j >> 9;
      const int t0 = qb * 128 + wave * 32;
      attn64_wave<0>(p, layer, b, hq, b * SEQ + t0, t0);
    } else if (it < e5) {
      const int j = it - e4, qb = j & 1, hq = (j >> 1) & 3, b = j >> 3;
      attn64_wave<3>(p, layer, b, hq, TL + b * CTX + qb * 128 + wave * 32, 0);
    } else {
      const int j = it - e5, qb = j & 1, hq = (j >> 1) & 3, b = j >> 3;
      attn64_wave<2>(p, layer, b, hq, TL + b * CTX + qb * 128 + wave * 32, 0);
    }
  }
}

template <int D>
DI void hgrn_dir(const Params& p, int layer, unsigned char* smem, int b, int hh, int n, float (&o)[16]) {
  const int tid = ltid();
  const int chain = (b * 4 + hh) * 2 + D;
  float* cumT = (float*)smem;
  float* qT = cumT + 64 * 68;
  float* kT = qT + 64 * 68;
  float* vv = kT + 64 * 68;
  float kreg[16];
  {
    const int pp = tid >> 2, kq = (tid & 3) * 16;
    const int row = hg_row(b, D, n, pp);
    const bf16_t* pr = p.P + (size_t)row * NP;
    const bf16_t* qp = pr + 768 + hh * 64 + kq;
    const bf16_t* fp = pr + 1536 + D * 256 + hh * 64 + kq;
    const bf16_t* vp = pr + 1024 + hh * 64 + kq;
    const u32x4 q0 = *(const u32x4*)qp, q1 = *(const u32x4*)(qp + 8), f0 = *(const u32x4*)fp, f1 = *(const u32x4*)(fp + 8),
                v0 = *(const u32x4*)vp, v1 = *(const u32x4*)(vp + 8);
    float qx[16], fx[16], vx[16];
#pragma unroll
    for (int q = 0; q < 4; ++q) {
      qx[2 * q] = bf_lo(q0[q]); qx[2 * q + 1] = bf_hi(q0[q]); qx[8 + 2 * q] = bf_lo(q1[q]); qx[8 + 2 * q + 1] = bf_hi(q1[q]);
      fx[2 * q] = bf_lo(f0[q]); fx[2 * q + 1] = bf_hi(f0[q]); fx[8 + 2 * q] = bf_lo(f1[q]); fx[8 + 2 * q + 1] = bf_hi(f1[q]);
      vx[2 * q] = bf_lo(v0[q]); vx[2 * q + 1] = bf_hi(v0[q]); vx[8 + 2 * q] = bf_lo(v1[q]); vx[8 + 2 * q + 1] = bf_hi(v1[q]);
    }
#pragma unroll
    for (int j = 0; j < 16; ++j) {
      const float lb = hg_lb(p, layer, D, hh * 64 + kq + j);
      const float sg = 1.f / (1.f + expf(-fx[j]));
      const float f = lb + (1.f - lb) * sg;
      cumT[(kq + j) * 68 + pp] = logf(f) * LOG2E;
      qT[(kq + j) * 68 + pp] = qx[j];
      kreg[j] = 1.f - f;
      vv[pp * 64 + kq + j] = vx[j];
    }
    const float* Sg = p.HL + ((size_t)(chain * NCHUNK + n)) * 4096 + tid * 16;
#pragma unroll
    for (int i = 0; i < 4; ++i) *(f32x4*)(kT + tid * 16 + 4 * i) = *(const f32x4*)(Sg + 4 * i);
  }
  __syncthreads();
  if (tid < 64) {
    float run = 0.f;
    for (int q = 0; q < 64; ++q) { run += cumT[tid * 68 + q]; cumT[tid * 68 + q] = run; }
  }
  __syncthreads();
  const int tg = tid >> 6, v = tid & 63, tgp = D ? 3 - tg : tg;
  {
#pragma unroll 2
    for (int k = 0; k < 64; ++k) {
      const float Sv = kT[k * 64 + v];
#pragma unroll
      for (int j4 = 0; j4 < 4; ++j4) {
        const f32x4 c4 = *(const f32x4*)(cumT + k * 68 + 16 * tgp + 4 * j4);
        const f32x4 q4 = *(const f32x4*)(qT + k * 68 + 16 * tgp + 4 * j4);
#pragma unroll
        for (int a = 0; a < 4; ++a) { const int j = 4 * j4 + a; o[D ? 15 - j : j] += q4[a] * fexp2(c4[a]) * Sv; }
      }
    }
  }
  __syncthreads();
  {
    const int pp = tid >> 2, kq = (tid & 3) * 16;
#pragma unroll
    for (int j = 0; j < 16; ++j) kT[(kq + j) * 68 + pp] = kreg[j];
  }
  __syncthreads();
  const int bt = tid >> 4, bs = tid & 15;
  float sc[4][4];
#pragma unroll
  for (int a = 0; a < 4; ++a)
#pragma unroll
    for (int c = 0; c < 4; ++c) sc[a][c] = 0.f;
  if (bs <= bt) {
    for (int k = 0; k < 64; ++k) {
      const f32x4 ct = *(const f32x4*)(cumT + k * 68 + 4 * bt), qt = *(const f32x4*)(qT + k * 68 + 4 * bt);
      const f32x4 cs = *(const f32x4*)(cumT + k * 68 + 4 * bs), ks = *(const f32x4*)(kT + k * 68 + 4 * bs);
      const float ref = ct[0];
      float et[4], es[4];
#pragma unroll
      for (int a = 0; a < 4; ++a) { et[a] = qt[a] * fexp2(ct[a] - ref); es[a] = ks[a] * fexp2(ref - cs[a]); }
#pragma unroll
      for (int a = 0; a < 4; ++a)
#pragma unroll
        for (int c = 0; c < 4; ++c) sc[a][c] += et[a] * es[c];
    }
  }
  __syncthreads();
#pragma unroll
  for (int a = 0; a < 4; ++a) {
    f32x4 w;
#pragma unroll
    for (int c = 0; c < 4; ++c) w[c] = (bs <= bt && (4 * bs + c) <= (4 * bt + a)) ? sc[a][c] : 0.f;
    *(f32x4*)(kT + (4 * bt + a) * 68 + 4 * bs) = w;
  }
  __syncthreads();
  {
    const int send = 4 * (tgp + 1);
    for (int s4 = 0; s4 < send; ++s4) {
      float vq[4];
#pragma unroll
      for (int c = 0; c < 4; ++c) vq[c] = vv[(4 * s4 + c) * 64 + v];
#pragma unroll
      for (int j = 0; j < 16; ++j) {
        const f32x4 w = *(const f32x4*)(kT + (16 * tgp + j) * 68 + 4 * s4);
        o[D ? 15 - j : j] += w[0] * vq[0] + w[1] * vq[1] + w[2] * vq[2] + w[3] * vq[3];
      }
    }
  }
  __syncthreads();
}

DI void hgout_phase(const Params& p, int layer, unsigned char* smem, int bid, int nb) {
  const int tid = ltid();
  const int n_lat = 2 * 4 * 256, n_ctx = layer == 0 ? 2 * 4 * 4 : 0;
  for (int it = bid; it < n_lat + n_ctx; it += nb) {
    int b, hh, n0, n1, rowbase;
    if (it < n_lat) { const int m = it & 255; hh = (it >> 8) & 3; b = it >> 10; n0 = 4 + m; n1 = 4 + 255 - m; rowbase = b * SEQ + 64 * m; }
    else { const int j = it - n_lat, mc = j & 3; hh = (j >> 2) & 3; b = j >> 4; n0 = mc; n1 = 3 - mc; rowbase = TL + b * CTX + 64 * mc; }
    float o[16];
#pragma unroll
    for (int j = 0; j < 16; ++j) o[j] = 0.f;
    hgrn_dir<0>(p, layer, smem, b, hh, n0, o);
    hgrn_dir<1>(p, layer, smem, b, hh, n1, o);
    const int tg = tid >> 6, v = tid & 63;
    const float og = p.hg_out_gain[layer * 64 + v];
#pragma unroll
    for (int j = 0; j < 16; ++j) {
      const int row = rowbase + 16 * tg + j;
      const float ss = wave_sum(o[j] * o[j]);
      const float r = rsqrtf(ss * (1.f / 64.f) + EPS);
      const unsigned short gb = p.P[(size_t)row * NP + 1280 + hh * 64 + v];
      const float gx = __uint_as_float(((unsigned)gb) << 16);
      const float y = o[j] * r * og * (gx / (1.f + expf(-gx)));
      p.MO[(size_t)row * DM + 256 + hh * 64 + v] = tobf(y);
    }
  }
}

#if MULTI_LAUNCH
#define SYNC_OR_RETURN(ph) do { if (phase_sel == (ph)) return; } while (0)
#define RUN(ph) (phase_sel == (ph))
#else
#define RUN(ph) (true)
#endif

__global__ void __launch_bounds__(512) fwd_kernel(Params p, int phase_sel) {
  __shared__ __attribute__((aligned(16))) unsigned char smem_all[2 * SMEM_BYTES];
  const int rbid = blockIdx.x, rnb = gridDim.x;
  const int vb = __builtin_amdgcn_readfirstlane((int)(threadIdx.x >> 8));
  const int bid = rbid * 2 + vb, nb = rnb * 2;
  unsigned char* smem = smem_all + vb * SMEM_BYTES;
#if !MULTI_LAUNCH
  cg::grid_group grid = cg::this_grid();
#define GSYNC() grid.sync()
#else
#define GSYNC() do {} while (0)
#endif
  int ph = 0;
  if (RUN(ph)) phase0(p, smem, bid, nb);
  GSYNC(); ++ph;
  for (int layer = 0; layer < 2; ++layer) {
    const float* modl = p.mod + layer * 3 * 6144;
    const float* rl = layer == 0 ? p.x : p.out;
    const float* rc = layer == 0 ? p.ctx : p.Xc;
    if (RUN(ph)) norm_phase(rl, rc, TA, p.norm1_g + layer * DM, modl, 0, 1024, p.H, bid, nb);
    GSYNC(); ++ph;
    if (RUN(ph)) { EpiBf16 e{p.P, NP}; gemm_phase512(p.H, p.WinT + (size_t)layer * NP * 1024, TA / 256, NP / 256, 1024, 1024, 1, e, smem_all, rbid, rnb); }
    GSYNC(); ++ph;
    if (RUN(ph)) prep_phase(p, layer, smem, bid, nb);
    GSYNC(); ++ph;
    if (RUN(ph)) mix_phase(p, layer, smem, bid, nb);
    GSYNC(); ++ph;
    if (RUN(ph)) hgout_phase(p, layer, smem, bid, nb);
    GSYNC(); ++ph;
    const int mrows = layer == 0 ? TA : TL;
    if (RUN(ph)) { EpiResid e{rl, rc, p.out, p.Xc, modl + 2048, 0}; gemm_phase512(p.MO, p.WoutT + (size_t)layer * 1024 * 1024, mrows / 256, 4, 1024, 1024, 1, e, smem_all, rbid, rnb); }
    GSYNC(); ++ph;
    if (RUN(ph)) norm_phase(p.out, p.Xc, mrows, p.norm2_g + layer * DM, modl, 3072, 4096, p.H, bid, nb);
    GSYNC(); ++ph;
    const int nchunks = layer == 0 ? 3 : 2;
    for (int ch = 0; ch < nchunks; ++ch) {
      const int row0 = ch * 16384, rows = ch < 2 ? 16384 : TC;
      if (RUN(ph)) { EpiRelu2 e{p.P, DFF}; gemm_phase512(p.H + (size_t)row0 * DM, p.W1T + (size_t)layer * DFF * 1024, rows / 256, DFF / 256, 1024, 1024, 1, e, smem_all, rbid, rnb); }
      GSYNC(); ++ph;
      if (RUN(ph)) {
        if (ch < 2) { EpiResid e{p.out, p.Xc, p.out, p.Xc, modl + 5 * 1024, row0}; gemm_phase512(p.P, p.W2T + (size_t)layer * 1024 * DFF, rows / 256, 4, DFF, DFF, 1, e, smem_all, rbid, rnb); }
        else { EpiResidAtomic e{p.out, p.Xc, modl + 5 * 1024, row0}; gemm_phase512(p.P, p.W2T + (size_t)layer * 1024 * DFF, rows / 256, 4, DFF, 256, 16, e, smem_all, rbid, rnb); }
      }
      GSYNC(); ++ph;
    }
  }
}

static size_t align_up(size_t v) { return (v + 255) & ~(size_t)255; }

extern "C" void kernel_launch(void* const* d_in, const int* in_sizes, int n_in, void* d_out, int out_size, void* d_ws, size_t ws_size,
                              hipStream_t stream) {
  Params p{};
  const float** f = (const float**)&p;
  for (int i = 0; i < 24; ++i) f[i] = (const float*)d_in[i];
  p.out = (float*)d_out;
  unsigned char* w = (unsigned char*)d_ws; size_t off = 0;
  auto take = [&](size_t bytes) { void* r = w + off; off = align_up(off + bytes); return r; };
  p.Xc = (float*)take((size_t)TC * DM * 4);
  p.mod = (float*)take((size_t)2 * 3 * 6144 * 4);
  p.Hdec = (float*)take((size_t)16 * NCHUNK * 64 * 4);
  p.WinT = (bf16_t*)take((size_t)2 * NP * 1024 * 2);
  p.WoutT = (bf16_t*)take((size_t)2 * 1024 * 1024 * 2);
  p.W1T = (bf16_t*)take((size_t)2 * DFF * 1024 * 2);
  p.W2T = (bf16_t*)take((size_t)2 * DFF * 1024 * 2);
  p.H = (bf16_t*)take((size_t)TA * DM * 2);
  p.HL = (float*)p.H;
  p.P = (bf16_t*)take((size_t)TA * NP * 2);
  p.MO = (bf16_t*)take((size_t)TA * DM * 2);
  p.VtA = (bf16_t*)take((size_t)2 * 4 * 64 * UA * 2);
  p.VtC = (bf16_t*)take((size_t)2 * 4 * 64 * UA * 2);
  p.VtD = (bf16_t*)take((size_t)2 * 2 * 64 * UA * 2);
  if (off > ws_size) { fprintf(stderr, "workspace too small: need %zu have %zu\n", off, ws_size); return; }
#if MULTI_LAUNCH
  const int nphase = 1 + 7 + 6 + 7 + 4;
  for (int ph = 0; ph < nphase; ++ph) hipLaunchKernelGGL(fwd_kernel, dim3(256), dim3(512), 0, stream, p, ph);
#else
  static int grid_blocks = 0;
  int phase_sel = -1;
  void* args[] = {&p, &phase_sel};
  if (!grid_blocks) {
    int dev = 0, cus = 0, per_cu = 0;
    (void)hipGetDevice(&dev);
    (void)hipDeviceGetAttribute(&cus, hipDeviceAttributeMultiprocessorCount, dev);
    (void)hipOccupancyMaxActiveBlocksPerMultiprocessor(&per_cu, fwd_kernel, 512, 0);
    if (per_cu < 1) per_cu = 1;
    grid_blocks = cus;
  }
  hipError_t e = hipLaunchCooperativeKernel((void*)fwd_kernel, dim3(grid_blocks), dim3(512), args, 0, stream);
  if (e != hipSuccess) fprintf(stderr, "cooperative launch failed: %s (grid %d)\n", hipGetErrorString(e), grid_blocks);
#endif
}
```

```cpp
#include <hip/hip_runtime.h>
#include <hip/hip_cooperative_groups.h>
#include <cstdio>
#include <cstdint>
namespace cg = cooperative_groups;

#ifndef MULTI_LAUNCH
#define MULTI_LAUNCH 0
#endif

#define DI __device__ __forceinline__
typedef unsigned short bf16_t;
typedef short bf16x8 __attribute__((ext_vector_type(8)));
typedef float f32x16 __attribute__((ext_vector_type(16)));
typedef float f32x4 __attribute__((ext_vector_type(4)));
typedef float f32x2 __attribute__((ext_vector_type(2)));
typedef unsigned u32x4 __attribute__((ext_vector_type(4)));
typedef unsigned u32x2 __attribute__((ext_vector_type(2)));
typedef __bf16 bf16x2_t __attribute__((ext_vector_type(2)));

constexpr int SEQ = 16384, CTX = 256, DM = 1024, TL = 32768, TC = 512, TA = 33280, NP = 3328, DFF = 4096, UA = 16640;
constexpr int NCHUNK = 260;
constexpr float EPS = 1e-6f, LOG2E = 1.4426950408889634f;
constexpr int SMEM_BYTES = 73728;
constexpr int LDS_STRIDE = 144;

#define MFMA32(a, b, c) __builtin_amdgcn_mfma_f32_32x32x16_bf16((a), (b), (c), 0, 0, 0)

DI unsigned pk2(float a, float b) { f32x2 v = {a, b}; return __builtin_bit_cast(unsigned, __builtin_convertvector(v, bf16x2_t)); }
DI float bf_lo(unsigned u) { return __uint_as_float(u << 16); }
DI float bf_hi(unsigned u) { return __uint_as_float(u & 0xffff0000u); }
DI bf16_t tobf(float a) { return (bf16_t)(pk2(a, 0.f) & 0xffffu); }
DI float fexp2(float x) { return __builtin_amdgcn_exp2f(x); }
DI void sum16_nopk(float& acc, const float (&pe)[16]) {
  asm volatile("s_nop 0\n\tv_add_f32 %0, %1, %0\n\tv_add_f32 %0, %2, %0\n\tv_add_f32 %0, %3, %0\n\tv_add_f32 %0, %4, %0\n\t"
               "v_add_f32 %0, %5, %0\n\tv_add_f32 %0, %6, %0\n\tv_add_f32 %0, %7, %0\n\tv_add_f32 %0, %8, %0\n\t"
               "v_add_f32 %0, %9, %0\n\tv_add_f32 %0, %10, %0\n\tv_add_f32 %0, %11, %0\n\tv_add_f32 %0, %12, %0\n\t"
               "v_add_f32 %0, %13, %0\n\tv_add_f32 %0, %14, %0\n\tv_add_f32 %0, %15, %0\n\tv_add_f32 %0, %16, %0"
               : "+v"(acc)
               : "v"(pe[0]), "v"(pe[1]), "v"(pe[2]), "v"(pe[3]), "v"(pe[4]), "v"(pe[5]), "v"(pe[6]), "v"(pe[7]),
                 "v"(pe[8]), "v"(pe[9]), "v"(pe[10]), "v"(pe[11]), "v"(pe[12]), "v"(pe[13]), "v"(pe[14]), "v"(pe[15]));
}
DI float wave_sum(float v) {
#pragma unroll
  for (int o = 32; o > 0; o >>= 1) v += __shfl_xor(v, o);
  return v;
}
DI float wave_max(float v) {
#pragma unroll
  for (int o = 32; o > 0; o >>= 1) v = fmaxf(v, __shfl_xor(v, o));
  return v;
}
DI int ltid() { int t = threadIdx.x & 255; asm volatile("" : "+v"(t)); return t; }
DI int ltid512() { int t = threadIdx.x; asm volatile("" : "+v"(t)); return t; }
DI unsigned xcc_id() { return (unsigned)__builtin_amdgcn_s_getreg((3 << 11) | 20) & 0xFu; }
DI int rowOfU(int b, int u) { return u < CTX ? TL + b * CTX + u : b * SEQ + (u - CTX); }

struct Params {
  const float *x, *c, *ctx, *c_ctx, *w_mod, *b_mod, *norm1_g, *norm2_g, *w_in, *w_out;
  const float *da_q_gain, *da_k_gain, *da_lambda, *da_sub_gain, *hg_lb_logits, *hg_out_gain;
  const float *na_q_gain, *na_k_gain, *na_rpb, *sw_q_gain, *sw_k_gain, *sw_sink, *w_ff1, *w_ff2;
  float* out;
  float* Xc;
  float* mod;
  float* Hdec;
  bf16_t* WinT;
  bf16_t* WoutT;
  bf16_t* W1T;
  bf16_t* W2T;
  bf16_t* H;
  float* HL;
  bf16_t* P;
  bf16_t* MO;
  bf16_t* VtA;
  bf16_t* VtC;
  bf16_t* VtD;
  unsigned* xcnt;
};

DI void phase0(const Params& p, unsigned char* smem, int bid, int nb) {
  const int tid = ltid();
  constexpr int n_mod = 2 * 96;
  constexpr int t_in = 16 * 52, t_out = 16 * 16, t_f1 = 16 * 64, t_f2 = 64 * 16;
  constexpr int per_layer = t_in + t_out + t_f1 + t_f2;
  constexpr int total = n_mod + 2 * per_layer;
  float* fs = (float*)smem;
  for (int it = bid; it < total; it += nb) {
    if (it < n_mod) {
      const int l = it / 96, col0 = (it % 96) * 64;
      float* sc = fs;
      float* red = fs + 3072;
      for (int i = tid; i < 3072; i += 256) {
        const int cond = i >> 10, k = i & 1023;
        const float v = cond == 0 ? p.c[k] : (cond == 1 ? p.c[1024 + k] : p.c_ctx[k]);
        sc[i] = v / (1.f + expf(-v));
      }
      __syncthreads();
      const int kg = tid >> 6, j = tid & 63;
      float a0 = 0.f, a1 = 0.f, a2 = 0.f;
      const float* wp = p.w_mod + ((size_t)l * 1024 + kg * 256) * 6144 + col0 + j;
#pragma unroll 8
      for (int k = 0; k < 256; ++k) {
        const float w = wp[(size_t)k * 6144];
        a0 += sc[kg * 256 + k] * w; a1 += sc[1024 + kg * 256 + k] * w; a2 += sc[2048 + kg * 256 + k] * w;
      }
      red[(kg * 3 + 0) * 64 + j] = a0; red[(kg * 3 + 1) * 64 + j] = a1; red[(kg * 3 + 2) * 64 + j] = a2;
      __syncthreads();
      if (tid < 192) {
        const int cond = tid >> 6, jj = tid & 63;
        float s = p.b_mod[l * 6144 + col0 + jj];
#pragma unroll
        for (int g = 0; g < 4; ++g) s += red[(g * 3 + cond) * 64 + jj];
        p.mod[(l * 3 + cond) * 6144 + col0 + jj] = s;
      }
    } else {
      int idx = it - n_mod;
      const int l = idx / per_layer; idx -= l * per_layer;
      const float* src; bf16_t* dst; int K, N;
      if (idx < t_in) { src = p.w_in + (size_t)l * 1024 * NP; dst = p.WinT + (size_t)l * NP * 1024; K = 1024; N = NP; }
      else if (idx < t_in + t_out) { idx -= t_in; src = p.w_out + (size_t)l * 1024 * 1024; dst = p.WoutT + (size_t)l * 1024 * 1024; K = 1024; N = 1024; }
      else if (idx < t_in + t_out + t_f1) { idx -= t_in + t_out; src = p.w_ff1 + (size_t)l * 1024 * DFF; dst = p.W1T + (size_t)l * DFF * 1024; K = 1024; N = DFF; }
      else { idx -= t_in + t_out + t_f1; src = p.w_ff2 + (size_t)l * DFF * 1024; dst = p.W2T + (size_t)l * 1024 * DFF; K = DFF; N = 1024; }
      const int ntn = N >> 6, kt = idx / ntn, nt = idx % ntn, k0 = kt * 64, n0 = nt * 64;
#pragma unroll
      for (int i = 0; i < 4; ++i) {
        const int r = (tid >> 4) + 16 * i, c4 = (tid & 15) * 4;
        const f32x4 v = *(const f32x4*)(src + (size_t)(k0 + r) * N + n0 + c4);
        fs[r * 65 + c4] = v[0]; fs[r * 65 + c4 + 1] = v[1]; fs[r * 65 + c4 + 2] = v[2]; fs[r * 65 + c4 + 3] = v[3];
      }
      __syncthreads();
      const int n = tid >> 2, kq = (tid & 3) * 16;
      u32x4 w0, w1;
#pragma unroll
      for (int i = 0; i < 4; ++i) {
        w0[i] = pk2(fs[(kq + 2 * i) * 65 + n], fs[(kq + 2 * i + 1) * 65 + n]);
        w1[i] = pk2(fs[(kq + 8 + 2 * i) * 65 + n], fs[(kq + 8 + 2 * i + 1) * 65 + n]);
      }
      bf16_t* dp = dst + (size_t)(n0 + n) * K + k0 + kq;
      *(u32x4*)dp = w0; *(u32x4*)(dp + 8) = w1;
    }
    __syncthreads();
  }
}

DI void norm_phase(const float* lat, const float* ctxp, int nrows, const float* g, const float* modl, int shift_off, int scale_off,
                   bf16_t* H, int bid, int nb) {
  const int wave = ltid() >> 6, lane = ltid() & 63;
  for (int r4 = bid; r4 < nrows / 4; r4 += nb) {
    const int row = r4 * 4 + wave;
    const float* src = row < TL ? lat + (size_t)row * DM : ctxp + (size_t)(row - TL) * DM;
    const int mi = row < TL ? (row >> 14) : 2;
    const float* sh = modl + mi * 6144 + shift_off;
    const float* sc = modl + mi * 6144 + scale_off;
    f32x4 v[4]; float ss = 0.f;
#pragma unroll
    for (int i = 0; i < 4; ++i) { v[i] = *(const f32x4*)(src + lane * 4 + 256 * i); ss += v[i][0] * v[i][0] + v[i][1] * v[i][1] + v[i][2] * v[i][2] + v[i][3] * v[i][3]; }
    ss = wave_sum(ss);
    const float rs = rsqrtf(ss * (1.f / 1024.f) + EPS);
#pragma unroll
    for (int i = 0; i < 4; ++i) {
      const int col = lane * 4 + 256 * i;
      const f32x4 gg = *(const f32x4*)(g + col), s4 = *(const f32x4*)(sc + col), h4 = *(const f32x4*)(sh + col);
      float y[4];
#pragma unroll
      for (int j = 0; j < 4; ++j) y[j] = (v[i][j] * rs * gg[j]) * (1.f + s4[j]) + h4[j];
      u32x2 w; w[0] = pk2(y[0], y[1]); w[1] = pk2(y[2], y[3]);
      *(u32x2*)(H + (size_t)row * DM + col) = w;
    }
  }
}

struct EpiBf16 {
  bf16_t* O; int ldc;
  DI void operator()(int m, int n, f32x4 v) const {
    u32x2 w; w[0] = pk2(v[0], v[1]); w[1] = pk2(v[2], v[3]);
    *(u32x2*)(O + (size_t)m * ldc + n) = w;
  }
};
struct EpiRelu2 {
  bf16_t* O; int ldc;
  DI void operator()(int m, int n, f32x4 v) const {
    float y[4];
#pragma unroll
    for (int j = 0; j < 4; ++j) { const float t = fmaxf(v[j], 0.f); y[j] = t * t; }
    u32x2 w; w[0] = pk2(y[0], y[1]); w[1] = pk2(y[2], y[3]);
    *(u32x2*)(O + (size_t)m * ldc + n) = w;
  }
};
struct EpiResid {
  const float* sl; const float* sc; float* dl; float* dc; const float* gate; int row0;
  DI void operator()(int m, int n, f32x4 v) const {
    const int row = m + row0;
    const float* s = row < TL ? sl + (size_t)row * DM : sc + (size_t)(row - TL) * DM;
    float* d = row < TL ? dl + (size_t)row * DM : dc + (size_t)(row - TL) * DM;
    const int mi = row < TL ? (row >> 14) : 2;
    const f32x4 g = *(const f32x4*)(gate + mi * 6144 + n);
    const f32x4 r = *(const f32x4*)(s + n);
    f32x4 o;
#pragma unroll
    for (int j = 0; j < 4; ++j) o[j] = r[j] + g[j] * v[j];
    *(f32x4*)(d + n) = o;
  }
};

template <class Epi>
DI void gemm_phase(const bf16_t* A, const bf16_t* Bt, int mtiles, int ntiles, int K, const Epi& epi, unsigned char* smem, int bid, int nb) {
  const int tid = ltid(), lane = tid & 63, wave = tid >> 6;
  const int wm = wave & 1, wn = wave >> 1, l31 = lane & 31, hh = lane >> 5;
  unsigned char* As0 = smem;
  unsigned char* Bs0 = smem + 2 * 128 * LDS_STRIDE;
  const int nk = K >> 6;
  const int ldrow = tid >> 3, ldcol = (tid & 7) * 8;
  const int total = mtiles * ntiles;
  const int xper = (nb >> 3) > 0 ? (nb >> 3) : 1;
  const int xcd = nb >= 8 ? (bid & 7) : 0, xj = nb >= 8 ? (bid >> 3) : bid, xstep = nb >= 8 ? 8 : 1;
  if (nb >= 8 && bid >= xper * 8) return;
  for (int ch = xcd; ch * xper + xj < total; ch += xstep) {
    const int it = ch * xper + xj;
    const int band = it / (8 * ntiles), rr = it - band * 8 * ntiles;
    const int rib = (mtiles - 8 * band) < 8 ? (mtiles - 8 * band) : 8;
    const int pn = rr / rib, pm = 8 * band + rr % rib;
    const bf16_t* Ap = A + (size_t)(pm * 128 + ldrow) * K + ldcol;
    const bf16_t* Bp = Bt + (size_t)(pn * 128 + ldrow) * K + ldcol;
    f32x16 acc[2][2];
#pragma unroll
    for (int a = 0; a < 2; ++a)
#pragma unroll
      for (int b = 0; b < 2; ++b)
#pragma unroll
        for (int i = 0; i < 16; ++i) acc[a][b][i] = 0.f;
    u32x4 ra0[4], rb0[4], ra1[4], rb1[4];
#define G_LOAD(RA, RB, KT) do { _Pragma("unroll") for (int i = 0; i < 4; ++i) { RA[i] = *(const u32x4*)(Ap + (size_t)i * 32 * K + (KT) * 64); RB[i] = *(const u32x4*)(Bp + (size_t)i * 32 * K + (KT) * 64); } } while (0)
#define G_STORE(RA, RB, BUF) do { unsigned char* Aw = As0 + (BUF) * 128 * LDS_STRIDE; unsigned char* Bw = Bs0 + (BUF) * 128 * LDS_STRIDE; \
      _Pragma("unroll") for (int i = 0; i < 4; ++i) { *(u32x4*)(Aw + (ldrow + 32 * i) * LDS_STRIDE + ldcol * 2) = RA[i]; *(u32x4*)(Bw + (ldrow + 32 * i) * LDS_STRIDE + ldcol * 2) = RB[i]; } } while (0)
#define G_COMPUTE(BUF) do { const unsigned char* As = As0 + (BUF) * 128 * LDS_STRIDE; const unsigned char* Bs = Bs0 + (BUF) * 128 * LDS_STRIDE; \
      _Pragma("unroll") for (int ks = 0; ks < 4; ++ks) { bf16x8 wf[2], af[2]; \
        _Pragma("unroll") for (int i = 0; i < 2; ++i) { \
          wf[i] = *(const bf16x8*)(Bs + (wn * 64 + i * 32 + l31) * LDS_STRIDE + (ks * 16 + 8 * hh) * 2); \
          af[i] = *(const bf16x8*)(As + (wm * 64 + i * 32 + l31) * LDS_STRIDE + (ks * 16 + 8 * hh) * 2); } \
        _Pragma("unroll") for (int ni = 0; ni < 2; ++ni) _Pragma("unroll") for (int mi = 0; mi < 2; ++mi) acc[ni][mi] = MFMA32(wf[ni], af[mi], acc[ni][mi]); } } while (0)
    G_LOAD(ra0, rb0, 0);
    G_LOAD(ra1, rb1, 1);
    G_STORE(ra0, rb0, 0);
    __syncthreads();
#pragma unroll 1
    for (int kt = 0; kt < nk; kt += 2) {
      const int k2 = kt + 2 < nk ? kt + 2 : 0, k3 = kt + 3 < nk ? kt + 3 : 1;
      G_LOAD(ra0, rb0, k2);
      G_COMPUTE(0);
      G_STORE(ra1, rb1, 1);
      __syncthreads();
      G_LOAD(ra1, rb1, k3);
      G_COMPUTE(1);
      G_STORE(ra0, rb0, 0);
      __syncthreads();
    }
#pragma unroll
    for (int ni = 0; ni < 2; ++ni)
#pragma unroll
      for (int mi = 0; mi < 2; ++mi) {
        const int m = pm * 128 + wm * 64 + mi * 32 + l31;
#pragma unroll
        for (int g = 0; g < 4; ++g) {
          const int n = pn * 128 + wn * 64 + ni * 32 + 8 * g + 4 * hh;
          f32x4 v = {acc[ni][mi][4 * g], acc[ni][mi][4 * g + 1], acc[ni][mi][4 * g + 2], acc[ni][mi][4 * g + 3]};
          epi(m, n, v);
        }
      }
  }
}

struct EpiResidAtomic {
  float* dl; float* dc; const float* gate; int row0;
  DI void operator()(int m, int n, f32x4 v) const {
    const int row = m + row0;
    float* d = row < TL ? dl + (size_t)row * DM : dc + (size_t)(row - TL) * DM;
    const int mi = row < TL ? (row >> 14) : 2;
    const f32x4 g = *(const f32x4*)(gate + mi * 6144 + n);
#pragma unroll
    for (int j = 0; j < 4; ++j) unsafeAtomicAdd(d + n + j, g[j] * v[j]);
  }
};

template <class Epi>
DI void gemm_phase512(const bf16_t* A, const bf16_t* Bt, int mtiles, int ntiles, int K, int Kper, int ksplit, const Epi& epi,
                      unsigned char* smem, int bid, int nb) {
  const int tid = ltid512(), lane = tid & 63, wave = tid >> 6;
  const int wm = wave & 1, wn = wave >> 1, l31 = lane & 31, hh = lane >> 5;
  constexpr int OPB = 256 * LDS_STRIDE;
  unsigned char* As0 = smem;
  unsigned char* Bs0 = smem + 2 * OPB;
  const int nk = Kper >> 6;
  const int ldrow = tid >> 3, ldcol = (tid & 7) * 8;
  const int ntile = mtiles * ntiles, total = ntile * ksplit;
  for (int it = bid; it < total; it += nb) {
    const int tile = it / ksplit, ks = it - tile * ksplit;
    const int band = tile / (8 * ntiles), rr = tile - band * 8 * ntiles;
    const int rib = (mtiles - 8 * band) < 8 ? (mtiles - 8 * band) : 8;
    const int pn = rr / rib, pm = 8 * band + rr % rib;
    const bf16_t* Ap = A + (size_t)(pm * 256 + ldrow) * K + ks * Kper + ldcol;
    const bf16_t* Bp = Bt + (size_t)(pn * 256 + ldrow) * K + ks * Kper + ldcol;
    f32x16 acc[2][4];
#pragma unroll
    for (int a = 0; a < 2; ++a)
#pragma unroll
      for (int b = 0; b < 4; ++b)
#pragma unroll
        for (int i = 0; i < 16; ++i) acc[a][b][i] = 0.f;
    u32x4 ra[4], rb[4];
#define H_LOAD(KT) do { _Pragma("unroll") for (int i = 0; i < 4; ++i) { ra[i] = *(const u32x4*)(Ap + (size_t)i * 64 * K + (KT) * 64); rb[i] = *(const u32x4*)(Bp + (size_t)i * 64 * K + (KT) * 64); } } while (0)
#define H_STORE(BUF) do { unsigned char* Aw = As0 + (BUF) * OPB; unsigned char* Bw = Bs0 + (BUF) * OPB; \
      _Pragma("unroll") for (int i = 0; i < 4; ++i) { *(u32x4*)(Aw + (ldrow + 64 * i) * LDS_STRIDE + ldcol * 2) = ra[i]; *(u32x4*)(Bw + (ldrow + 64 * i) * LDS_STRIDE + ldcol * 2) = rb[i]; } } while (0)
    H_LOAD(0);
    H_STORE(0);
    H_LOAD(1);
    __syncthreads();
#pragma unroll 1
    for (int kt = 0; kt < nk; ++kt) {
      const int buf = kt & 1;
      const int kn = kt + 2 < nk ? kt + 2 : 0;
      const unsigned char* As = As0 + buf * OPB;
      const unsigned char* Bs = Bs0 + buf * OPB;
      unsigned char* Aw = As0 + (buf ^ 1) * OPB;
      unsigned char* Bw = Bs0 + (buf ^ 1) * OPB;
#pragma unroll
      for (int k16 = 0; k16 < 4; ++k16) {
        bf16x8 wf[2], af[4];
#pragma unroll
        for (int i = 0; i < 2; ++i) wf[i] = *(const bf16x8*)(Bs + (wn * 64 + i * 32 + l31) * LDS_STRIDE + (k16 * 16 + 8 * hh) * 2);
#pragma unroll
        for (int i = 0; i < 4; ++i) af[i] = *(const bf16x8*)(As + (wm * 128 + i * 32 + l31) * LDS_STRIDE + (k16 * 16 + 8 * hh) * 2);
#pragma unroll
        for (int ni = 0; ni < 2; ++ni)
#pragma unroll
          for (int mi = 0; mi < 4; ++mi) acc[ni][mi] = MFMA32(wf[ni], af[mi], acc[ni][mi]);
        *(u32x4*)(Aw + (ldrow + 64 * k16) * LDS_STRIDE + ldcol * 2) = ra[k16];
        *(u32x4*)(Bw + (ldrow + 64 * k16) * LDS_STRIDE + ldcol * 2) = rb[k16];
        ra[k16] = *(const u32x4*)(Ap + (size_t)k16 * 64 * K + kn * 64);
        rb[k16] = *(const u32x4*)(Bp + (size_t)k16 * 64 * K + kn * 64);
        __builtin_amdgcn_sched_barrier(0);
      }
      __syncthreads();
    }
#pragma unroll
    for (int ni = 0; ni < 2; ++ni)
#pragma unroll
      for (int mi = 0; mi < 4; ++mi) {
        const int m = pm * 256 + wm * 128 + mi * 32 + l31;
#pragma unroll
        for (int g = 0; g < 4; ++g) {
          const int n = pn * 256 + wn * 64 + ni * 32 + 8 * g + 4 * hh;
          f32x4 v = {acc[ni][mi][4 * g], acc[ni][mi][4 * g + 1], acc[ni][mi][4 * g + 2], acc[ni][mi][4 * g + 3]};
          epi(m, n, v);
        }
      }
  }
}

DI float hg_lb(const Params& p, int layer, int d, int j) {
  if (layer == 0) return 0.f;
  const float l0 = p.hg_lb_logits[d * 256 + j], l1 = p.hg_lb_logits[512 + d * 256 + j];
  return 1.f / (1.f + expf(l0 - l1));
}

DI void prep32_item(const Params& p, int layer, int it) {
  const int idx = it * 256 + ltid();
  const int row = idx >> 4, j = idx & 15, isk = j >> 3, sub = j & 7;
  bf16_t* ptr = p.P + (size_t)row * NP + isk * 256 + sub * 32;
  const float* gain = (isk ? p.da_k_gain : p.da_q_gain) + layer * 32;
  float v[32];
#pragma unroll
  for (int i = 0; i < 4; ++i) {
    const u32x4 w = *(const u32x4*)(ptr + 8 * i);
#pragma unroll
    for (int q = 0; q < 4; ++q) { v[8 * i + 2 * q] = bf_lo(w[q]); v[8 * i + 2 * q + 1] = bf_hi(w[q]); }
  }
  float ss = 0.f;
#pragma unroll
  for (int i = 0; i < 32; ++i) ss += v[i] * v[i];
  const float r = rsqrtf(ss * (1.f / 32.f) + EPS);
#pragma unroll
  for (int i = 0; i < 32; ++i) v[i] = v[i] * r * gain[i];
  if (row < TL) {
    const int t = row & (SEQ - 1);
    const float gr = (float)(t >> 6), gc = (float)(t & 63);
#pragma unroll
    for (int i = 0; i < 8; ++i) {
      constexpr float FRA[8] = {1.f, 0.31622776601683794f, 0.1f, 0.031622776601683794f, 0.01f, 0.0031622776601683794f, 0.001f, 0.00031622776601683794f};
      const float fr = FRA[i];
      const float ar = gr * fr, ac = gc * fr;
      const float cr = __cosf(ar), sr = __sinf(ar), cc = __cosf(ac), sc = __sinf(ac);
      const float x1 = v[i], x2 = v[8 + i];
      v[i] = x1 * cr - x2 * sr; v[8 + i] = x1 * sr + x2 * cr;
      const float y1 = v[16 + i], y2 = v[24 + i];
      v[16 + i] = y1 * cc - y2 * sc; v[24 + i] = y1 * sc + y2 * cc;
    }
  }
  const float qs = isk ? 1.f : (0.17677669529663687f * LOG2E);
#pragma unroll
  for (int i = 0; i < 4; ++i) {
    u32x4 w;
#pragma unroll
    for (int q = 0; q < 4; ++q) w[q] = pk2(v[8 * i + 2 * q] * qs, v[8 * i + 2 * q + 1] * qs);
    *(u32x4*)(ptr + 8 * i) = w;
  }
}

DI void prep64_item(const Params& p, int layer, int it) {
  const int idx = it * 256 + ltid();
  const int row = idx / 14, j = idx % 14;
  int col; const float* gain; bool rope, isq;
  if (j < 4) { col = 2048 + 64 * j; gain = p.na_q_gain; rope = false; isq = true; }
  else if (j < 8) { col = 2304 + 64 * (j - 4); gain = p.na_k_gain; rope = false; isq = false; }
  else if (j < 12) { col = 2816 + 64 * (j - 8); gain = p.sw_q_gain; rope = true; isq = true; }
  else { col = 3072 + 64 * (j - 12); gain = p.sw_k_gain; rope = true; isq = false; }
  gain += layer * 64;
  bf16_t* ptr = p.P + (size_t)row * NP + col;
  float v[64];
#pragma unroll
  for (int i = 0; i < 8; ++i) {
    const u32x4 w = *(const u32x4*)(ptr + 8 * i);
#pragma unroll
    for (int q = 0; q < 4; ++q) { v[8 * i + 2 * q] = bf_lo(w[q]); v[8 * i + 2 * q + 1] = bf_hi(w[q]); }
  }
  float ss = 0.f;
#pragma unroll
  for (int i = 0; i < 64; ++i) ss += v[i] * v[i];
  const float r = rsqrtf(ss * (1.f / 64.f) + EPS);
#pragma unroll
  for (int i = 0; i < 64; ++i) v[i] = v[i] * r * gain[i];
  if (rope && row < TL) {
    const int t = row & (SEQ - 1);
    const float gr = (float)(t >> 6), gc = (float)(t & 63);
#pragma unroll
    for (int i = 0; i < 16; ++i) {
      constexpr float FRD[16] = {1.f, 0.5623413251903491f, 0.31622776601683794f, 0.1778279410038923f, 0.1f, 0.05623413251903491f, 0.031622776601683794f, 0.01778279410038923f, 0.01f, 0.005623413251903491f, 0.0031622776601683794f, 0.001778279410038923f, 0.001f, 0.0005623413251903491f, 0.00031622776601683794f, 0.0001778279410038923f};
      const float fr = FRD[i];
      const float ar = gr * fr, ac = gc * fr;
      const float cr = __cosf(ar), sr = __sinf(ar), cc = __cosf(ac), sc = __sinf(ac);
      const float x1 = v[i], x2 = v[16 + i];
      v[i] = x1 * cr - x2 * sr; v[16 + i] = x1 * sr + x2 * cr;
      const float y1 = v[32 + i], y2 = v[48 + i];
      v[32 + i] = y1 * cc - y2 * sc; v[48 + i] = y1 * sc + y2 * cc;
    }
  }
  const float qs = isq ? (0.125f * LOG2E) : 1.f;
#pragma unroll
  for (int i = 0; i < 8; ++i) {
    u32x4 w;
#pragma unroll
    for (int q = 0; q < 4; ++q) w[q] = pk2(v[8 * i + 2 * q] * qs, v[8 * i + 2 * q + 1] * qs);
    *(u32x4*)(ptr + 8 * i) = w;
  }
}

DI void vt_item(const Params& p, int it, unsigned char* smem) {
  const int tid = ltid();
  const int hv = it % 10, ug = (it / 10) % NCHUNK, b = it / (10 * NCHUNK);
  int vcol; bf16_t* dst;
  if (hv < 4) { vcol = 512 + 64 * hv; dst = p.VtA + (size_t)(b * 4 + hv) * 64 * UA; }
  else if (hv < 8) { vcol = 2560 + 64 * (hv - 4); dst = p.VtC + (size_t)(b * 4 + hv - 4) * 64 * UA; }
  else { vcol = 3200 + 64 * (hv - 8); dst = p.VtD + (size_t)(b * 2 + hv - 8) * 64 * UA; }
  const int u0 = ug * 64;
  bf16_t* tile = (bf16_t*)smem;
  {
    const int tk = tid >> 2, seg = (tid & 3) * 16;
    const int row = rowOfU(b, u0 + tk);
    const bf16_t* src = p.P + (size_t)row * NP + vcol + seg;
    const u32x4 w0 = *(const u32x4*)src, w1 = *(const u32x4*)(src + 8);
    unsigned* tp = (unsigned*)(tile + tk * 66 + seg);
#pragma unroll
    for (int q = 0; q < 4; ++q) { tp[q] = w0[q]; tp[4 + q] = w1[q]; }
  }
  __syncthreads();
  {
    const int dv = tid >> 2, tq = (tid & 3) * 16;
    u32x4 w0, w1;
#pragma unroll
    for (int q = 0; q < 4; ++q) {
      w0[q] = (unsigned)tile[(tq + 2 * q) * 66 + dv] | ((unsigned)tile[(tq + 2 * q + 1) * 66 + dv] << 16);
      w1[q] = (unsigned)tile[(tq + 8 + 2 * q) * 66 + dv] | ((unsigned)tile[(tq + 8 + 2 * q + 1) * 66 + dv] << 16);
    }
    bf16_t* dp = dst + (size_t)dv * UA + u0 + tq;
    *(u32x4*)dp = w0; *(u32x4*)(dp + 8) = w1;
  }
  __syncthreads();
}

DI int hg_row(int b, int d, int n, int pp) {
  if (n < 4) { const int c = d ? 255 - (64 * n + pp) : 64 * n + pp; return TL + b * CTX + c; }
  const int t = d ? SEQ - 1 - (64 * (n - 4) + pp) : 64 * (n - 4) + pp;
  return b * SEQ + t;
}

DI void prefix64(float* cumT, float* psum, int tid, float (&c)[16]) {
  const int k = tid & 63, qd = tid >> 6;
  float* row = cumT + k * 68 + 16 * qd;
#pragma unroll
  for (int i4 = 0; i4 < 4; ++i4) { const f32x4 t = *(const f32x4*)(row + 4 * i4); c[4 * i4] = t[0]; c[4 * i4 + 1] = t[1]; c[4 * i4 + 2] = t[2]; c[4 * i4 + 3] = t[3]; }
#pragma unroll
  for (int i = 1; i < 16; ++i) c[i] += c[i - 1];
  psum[qd * 64 + k] = c[15];
  __syncthreads();
  float off = 0.f;
#pragma unroll
  for (int q = 0; q < 3; ++q) off += (q < qd) ? psum[q * 64 + k] : 0.f;
#pragma unroll
  for (int i = 0; i < 16; ++i) c[i] += off;
#pragma unroll
  for (int i4 = 0; i4 < 4; ++i4) { f32x4 t = {c[4 * i4], c[4 * i4 + 1], c[4 * i4 + 2], c[4 * i4 + 3]}; *(f32x4*)(row + 4 * i4) = t; }
}

DI void hgsum_item(const Params& p, int layer, int it, unsigned char* smem) {
  const int tid = ltid();
  const int n = it % NCHUNK, chain = it / NCHUNK, d = chain & 1, hh = (chain >> 1) & 3, b = chain >> 3;
  float* cumT = (float*)smem;
  float* wk = cumT + 64 * 68;
  float* vv = wk + 64 * 64;
  float* psum = vv + 64 * 64;
  const int pp = tid >> 2, kq = (tid & 3) * 16;
  {
    const int row = hg_row(b, d, n, pp);
    const bf16_t* pr = p.P + (size_t)row * NP;
    const bf16_t* fp = pr + 1536 + d * 256 + hh * 64 + kq;
    const bf16_t* vp = pr + 1024 + hh * 64 + kq;
    const u32x4 f0 = *(const u32x4*)fp, f1 = *(const u32x4*)(fp + 8), v0 = *(const u32x4*)vp, v1 = *(const u32x4*)(vp + 8);
    float fx[16], vx[16];
#pragma unroll
    for (int q = 0; q < 4; ++q) { fx[2 * q] = bf_lo(f0[q]); fx[2 * q + 1] = bf_hi(f0[q]); fx[8 + 2 * q] = bf_lo(f1[q]); fx[8 + 2 * q + 1] = bf_hi(f1[q]);
                                  vx[2 * q] = bf_lo(v0[q]); vx[2 * q + 1] = bf_hi(v0[q]); vx[8 + 2 * q] = bf_lo(v1[q]); vx[8 + 2 * q + 1] = bf_hi(v1[q]); }
#pragma unroll
    for (int j = 0; j < 16; ++j) {
      const float lb = hg_lb(p, layer, d, hh * 64 + kq + j);
      const float sg = 1.f / (1.f + expf(-fx[j]));
      const float f = lb + (1.f - lb) * sg;
      cumT[(kq + j) * 68 + pp] = logf(f) * LOG2E;
      wk[pp * 64 + kq + j] = 1.f - f;
      vv[pp * 64 + kq + j] = vx[j];
    }
  }
  __syncthreads();
  { float c[16]; prefix64(cumT, psum, tid, c); }
  __syncthreads();
#pragma unroll
  for (int j = 0; j < 16; ++j) {
    const int k = kq + j;
    wk[pp * 64 + k] *= fexp2(cumT[k * 68 + 63] - cumT[k * 68 + pp]);
  }
  __syncthreads();
  {
    const int kg = tid >> 6, v = tid & 63;
    float acc[16];
#pragma unroll
    for (int j = 0; j < 16; ++j) acc[j] = 0.f;
    for (int q = 0; q < 64; ++q) {
      const float vq = vv[q * 64 + v];
#pragma unroll
      for (int j4 = 0; j4 < 4; ++j4) {
        const f32x4 w4 = *(const f32x4*)(wk + q * 64 + kg * 16 + 4 * j4);
#pragma unroll
        for (int a = 0; a < 4; ++a) acc[4 * j4 + a] += w4[a] * vq;
      }
    }
    float* L = p.HL + ((size_t)(chain * NCHUNK + n)) * 4096;
#pragma unroll
    for (int j = 0; j < 16; ++j) L[(kg * 16 + j) * 64 + v] = acc[j];
    if (tid < 64) p.Hdec[(chain * NCHUNK + n) * 64 + tid] = fexp2(cumT[tid * 68 + 63]);
  }
  __syncthreads();
}

DI void prep_phase(const Params& p, int layer, unsigned char* smem, int bid, int nb) {
  constexpr int n_hg = 16 * NCHUNK;
  constexpr int n_vt = 2 * NCHUNK * 10;
  constexpr int n_p32 = TA * 16 / 256;
  constexpr int n_p64 = TA * 14 / 256;
  constexpr int total = n_hg + n_vt + n_p32 + n_p64;
  for (int it = bid; it < total; it += nb) {
    if (it < n_hg) hgsum_item(p, layer, it, smem);
    else if (it < n_hg + n_vt) vt_item(p, it - n_hg, smem);
    else if (it < n_hg + n_vt + n_p32) prep32_item(p, layer, it - n_hg - n_vt);
    else prep64_item(p, layer, it - n_hg - n_vt - n_p32);
  }
}

DI void scan_item(const Params& p, int it) {
  const int chain = it >> 4, e = (it & 15) * 256 + ltid(), k = e >> 6;
  float* L = p.HL + (size_t)chain * NCHUNK * 4096 + e;
  const float* dc = p.Hdec + chain * NCHUNK * 64 + k;
  float S = 0.f;
  for (int n0 = 0; n0 < NCHUNK; n0 += 10) {
    float l[10], dd[10];
#pragma unroll
    for (int j = 0; j < 10; ++j) { l[j] = L[(size_t)(n0 + j) * 4096]; dd[j] = dc[(n0 + j) * 64]; }
#pragma unroll
    for (int j = 0; j < 10; ++j) { L[(size_t)(n0 + j) * 4096] = S; S = dd[j] * S + l[j]; }
  }
}

DI void attnA_block(const Params& p, int layer, unsigned char* smem, int b, int h, int qrow_blk, int ubeg, int uend) {
  const int tid = ltid512(), wave = tid >> 6;
  const int lane = tid & 63, qi = lane & 31, hh = lane >> 5;
  const int qrow0 = qrow_blk + wave * 32;
  const int pr = (qi & 19) | ((qi & 4) << 1) | ((qi & 8) >> 1);
  const float lam_init = layer == 0 ? 0.2f : 0.35550906759096f;
  float gq = lane < 32 ? fabsf(p.da_q_gain[layer * 32 + lane]) : 0.f, gk = lane < 32 ? fabsf(p.da_k_gain[layer * 32 + lane]) : 0.f;
  gq = wave_max(gq); gk = wave_max(gk);
  const float negM2 = -(0.17677669529663687f * LOG2E * 32.f * 1.02f) * gq * gk;
  float la = 0.f, lb_ = 0.f;
  if (lane < 32) { const float* lv = p.da_lambda + layer * 128; la = lv[lane] * lv[32 + lane]; lb_ = lv[64 + lane] * lv[96 + lane]; }
  la = wave_sum(la); lb_ = wave_sum(lb_);
  const float lam = expf(la) - expf(lb_) + lam_init;

  const bf16_t* qp = p.P + (size_t)(qrow0 + qi) * NP + h * 64 + 8 * hh;
  bf16x8 qf[2][2];
#pragma unroll
  for (int m = 0; m < 2; ++m)
#pragma unroll
    for (int ks = 0; ks < 2; ++ks) qf[m][ks] = *(const bf16x8*)(qp + m * 32 + ks * 16);
  f32x16 o[2][2];
#pragma unroll
  for (int m = 0; m < 2; ++m)
#pragma unroll
    for (int dh = 0; dh < 2; ++dh)
#pragma unroll
      for (int i = 0; i < 16; ++i) o[m][dh][i] = 0.f;
  float ls[2] = {0.f, 0.f};
  constexpr int VSTR = 272, KBYTES = 128 * LDS_STRIDE, STG = KBYTES + 64 * VSTR;
  const int krow = tid >> 3, kch = tid & 7;
  const int vrow = tid >> 4, vch = tid & 15;
  const bf16_t* kg = p.P + 256 + h * 64 + kch * 8;
  const bf16_t* vg = p.VtA + ((size_t)((b * 4 + h) * 64 + vrow)) * UA + vch * 8;
  u32x4 rk0, rk1, rv0, rv1;
  rk0 = *(const u32x4*)(kg + (size_t)rowOfU(b, ubeg + krow) * NP);
  rk1 = *(const u32x4*)(kg + (size_t)rowOfU(b, ubeg + krow + 64) * NP);
  rv0 = *(const u32x4*)(vg + ubeg);
  rv1 = *(const u32x4*)(vg + (size_t)32 * UA + ubeg);
  __syncthreads();
  asm volatile("" :: "v"(qf[0][0]), "v"(qf[0][1]), "v"(qf[1][0]), "v"(qf[1][1]));
  {
    unsigned char* Ks = smem; unsigned char* Vs = smem + KBYTES;
    *(u32x4*)(Ks + krow * LDS_STRIDE + kch * 16) = rk0; *(u32x4*)(Ks + (krow + 64) * LDS_STRIDE + kch * 16) = rk1;
    *(u32x4*)(Vs + vrow * VSTR + vch * 16) = rv0; *(u32x4*)(Vs + (vrow + 32) * VSTR + vch * 16) = rv1;
  }
  __syncthreads();
  int buf = 0;
  for (int u0 = ubeg; u0 < uend; u0 += 128) {
    const int un = u0 + 128 < uend ? u0 + 128 : ubeg;
    rk0 = *(const u32x4*)(kg + (size_t)rowOfU(b, un + krow) * NP);
    rk1 = *(const u32x4*)(kg + (size_t)rowOfU(b, un + krow + 64) * NP);
    rv0 = *(const u32x4*)(vg + un);
    rv1 = *(const u32x4*)(vg + (size_t)32 * UA + un);
    const unsigned char* Ks = smem + buf * STG;
    const unsigned char* Vs = Ks + KBYTES;
#pragma unroll 2
    for (int sub = 0; sub < 4; ++sub) {
      bf16x8 vf[2][2];
#pragma unroll
      for (int dh = 0; dh < 2; ++dh)
#pragma unroll
        for (int s2 = 0; s2 < 2; ++s2) vf[dh][s2] = *(const bf16x8*)(Vs + (32 * dh + qi) * VSTR + (32 * sub + 16 * s2 + 8 * hh) * 2);
#pragma unroll
      for (int m = 0; m < 2; ++m) {
        const unsigned char* kr = Ks + (32 * sub + pr) * LDS_STRIDE + (m * 32 + 8 * hh) * 2;
        const bf16x8 kf0 = *(const bf16x8*)kr, kf1 = *(const bf16x8*)(kr + 32);
        f32x16 s;
#pragma unroll
        for (int i = 0; i < 16; ++i) s[i] = negM2;
        s = MFMA32(kf0, qf[m][0], s);
        s = MFMA32(kf1, qf[m][1], s);
        float pe[16];
#pragma unroll
        for (int i = 0; i < 16; ++i) pe[i] = fexp2(s[i]);
        sum16_nopk(ls[m], pe);
#pragma unroll
        for (int s2 = 0; s2 < 2; ++s2) {
          u32x4 pw;
#pragma unroll
          for (int q = 0; q < 4; ++q) pw[q] = pk2(pe[8 * s2 + 2 * q], pe[8 * s2 + 2 * q + 1]);
          const bf16x8 pf = __builtin_bit_cast(bf16x8, pw);
#pragma unroll
          for (int dh = 0; dh < 2; ++dh) o[m][dh] = MFMA32(vf[dh][s2], pf, o[m][dh]);
        }
      }
    }
    {
      unsigned char* Kw = smem + (buf ^ 1) * STG; unsigned char* Vw = Kw + KBYTES;
      *(u32x4*)(Kw + krow * LDS_STRIDE + kch * 16) = rk0; *(u32x4*)(Kw + (krow + 64) * LDS_STRIDE + kch * 16) = rk1;
      *(u32x4*)(Vw + vrow * VSTR + vch * 16) = rv0; *(u32x4*)(Vw + (vrow + 32) * VSTR + vch * 16) = rv1;
    }
    __syncthreads();
    buf ^= 1;
  }
  const float l0 = ls[0] + __shfl_xor(ls[0], 32), l1 = ls[1] + __shfl_xor(ls[1], 32);
  const float i0 = 1.f / l0, c1 = lam / l1;
  float ss = 0.f;
#pragma unroll
  for (int dh = 0; dh < 2; ++dh)
#pragma unroll
    for (int i = 0; i < 16; ++i) { const float v = o[0][dh][i] * i0 - o[1][dh][i] * c1; o[0][dh][i] = v; ss += v * v; }
  ss += __shfl_xor(ss, 32);
  const float r = rsqrtf(ss * (1.f / 64.f) + EPS) * (1.f - lam_init);
  bf16_t* op = p.MO + (size_t)(qrow0 + qi) * DM + h * 64;
  const float* sg = p.da_sub_gain + layer * 64;
#pragma unroll
  for (int dh = 0; dh < 2; ++dh)
#pragma unroll
    for (int g = 0; g < 4; ++g) {
      const int dv = 32 * dh + 8 * g + 4 * hh;
      const f32x4 g4 = *(const f32x4*)(sg + dv);
      u32x2 w;
      w[0] = pk2(o[0][dh][4 * g] * r * g4[0], o[0][dh][4 * g + 1] * r * g4[1]);
      w[1] = pk2(o[0][dh][4 * g + 2] * r * g4[2], o[0][dh][4 * g + 3] * r * g4[3]);
      *(u32x2*)(op + dv) = w;
    }
}

template <class MaskF>
DI void attn64_step(const bf16_t* kp  , const bf16_t* vp  ,
                    const bf16x8 (&qf)[4], f32x16 (&o)[2], float& ls, float negM2, int hh, MaskF maskf) {
  bf16x8 kf[4], vf[2][2];
#pragma unroll
  for (int ks = 0; ks < 4; ++ks) kf[ks] = *(const bf16x8*)(kp + ks * 16);
#pragma unroll
  for (int dh = 0; dh < 2; ++dh)
#pragma unroll
    for (int s2 = 0; s2 < 2; ++s2) vf[dh][s2] = *(const bf16x8*)(vp + (size_t)dh * 32 * UA + s2 * 16);
  f32x16 s;
#pragma unroll
  for (int i = 0; i < 16; ++i) s[i] = negM2;
#pragma unroll
  for (int ks = 0; ks < 4; ++ks) s = MFMA32(kf[ks], qf[ks], s);
  float pe[16];
#pragma unroll
  for (int i = 0; i < 16; ++i) { const int kslot = 16 * (i >> 3) + 8 * hh + (i & 7); pe[i] = fexp2(maskf(kslot, s[i])); }
  sum16_nopk(ls, pe);
#pragma unroll
  for (int s2 = 0; s2 < 2; ++s2) {
    u32x4 pw;
#pragma unroll
    for (int q = 0; q < 4; ++q) pw[q] = pk2(pe[8 * s2 + 2 * q], pe[8 * s2 + 2 * q + 1]);
    const bf16x8 pf = __builtin_bit_cast(bf16x8, pw);
#pragma unroll
    for (int dh = 0; dh < 2; ++dh) o[dh] = MFMA32(vf[dh][s2], pf, o[dh]);
  }
}

template <int MODE>
DI void attn64_wave(const Params& p, int layer, int b, int hq, int qrow0, int t0) {
  constexpr bool isC = (MODE == 0 || MODE == 2);
  const int lane = ltid() & 63, qi = lane & 31, hh = lane >> 5;
  const int pr = (qi & 19) | ((qi & 4) << 1) | ((qi & 8) >> 1);
  const float* gqp = (isC ? p.na_q_gain : p.sw_q_gain) + layer * 64;
  const float* gkp = (isC ? p.na_k_gain : p.sw_k_gain) + layer * 64;
  const float gq = wave_max(fabsf(gqp[lane])), gk = wave_max(fabsf(gkp[lane]));
  const float negM2 = -(0.125f * LOG2E * 64.f * 1.02f) * gq * gk;
  const int kvh = isC ? hq : (hq >> 1);
  const int qcol = isC ? 2048 + 64 * hq : 2816 + 64 * hq;
  const int kcol = isC ? 2304 + 64 * hq : 3072 + 64 * kvh;
  const bf16_t* vt = isC ? p.VtC + (size_t)(b * 4 + hq) * 64 * UA : p.VtD + (size_t)(b * 2 + kvh) * 64 * UA;
  const bf16_t* vbase = vt + (size_t)qi * UA + 8 * hh;
  const bf16_t* kbase = p.P + kcol + 8 * hh;
  const bf16_t* qp = p.P + (size_t)(qrow0 + qi) * NP + qcol + 8 * hh;
  bf16x8 qf[4];
#pragma unroll
  for (int ks = 0; ks < 4; ++ks) qf[ks] = *(const bf16x8*)(qp + ks * 16);
  f32x16 o[2];
#pragma unroll
  for (int dh = 0; dh < 2; ++dh)
#pragma unroll
    for (int i = 0; i < 16; ++i) o[dh][i] = 0.f;
  float ls = 0.f;
  for (int u0 = 0; u0 < CTX; u0 += 32) {
    const bf16_t* kp = kbase + (size_t)(TL + b * CTX + u0 + pr) * NP;
    attn64_step(kp, vbase + u0, qf, o, ls, negM2, hh, [](int, float s) { return s; });
  }
  if (MODE == 0) {
    const int r = t0 >> 6, c = (t0 & 63) + qi;
    const int rs = min(max(r - 4, 0), 248);
    const int ws = min(max(c - 8, 0), 48);
    const float* rpb = p.na_rpb + (size_t)(layer * 4 + hq) * 15 * 31;
    for (int kr = rs; kr < rs + 8; ++kr) {
      const float* rrow = rpb + (kr - r + 7) * 31 + 15 - c;
#pragma unroll 1
      for (int hf = 0; hf < 2; ++hf) {
        const int kt0 = kr * 64 + hf * 32;
        const bf16_t* kp = kbase + (size_t)(b * SEQ + kt0 + pr) * NP;
        attn64_step(kp, vbase + CTX + kt0, qf, o, ls, negM2, hh, [&](int kslot, float s) {
          const int kc = hf * 32 + kslot;
          const bool valid = (kc >= ws) && (kc < ws + 16);
          const int kcc = min(max(kc, ws), ws + 15);
          return valid ? s + rrow[kcc] * LOG2E : -1e30f;
        });
      }
    }
  } else if (MODE == 1) {
    const int qt = t0 + qi;
    for (int jt = 0; jt < 9; ++jt) {
      const int kt0 = t0 - 128 + 32 * jt;
      if (kt0 < 0 || kt0 >= SEQ) continue;
      const bf16_t* kp = kbase + (size_t)(b * SEQ + kt0 + pr) * NP;
      if (jt == 0 || jt == 8) {
        attn64_step(kp, vbase + CTX + kt0, qf, o, ls, negM2, hh, [&](int kslot, float s) {
          const int dd = kt0 + kslot - qt;
          return (dd <= 128 && dd >= -128) ? s : -1e30f;
        });
      } else {
        attn64_step(kp, vbase + CTX + kt0, qf, o, ls, negM2, hh, [](int, float s) { return s; });
      }
    }
  }
  float l = ls + __shfl_xor(ls, 32);
  if (!isC) l += fexp2(p.sw_sink[layer * 4 + hq] * LOG2E + negM2);
  const float il = 1.f / l;
  bf16_t* op = p.MO + (size_t)(qrow0 + qi) * DM + (isC ? 512 : 768) + hq * 64;
#pragma unroll
  for (int dh = 0; dh < 2; ++dh)
#pragma unroll
    for (int g = 0; g < 4; ++g) {
      const int dv = 32 * dh + 8 * g + 4 * hh;
      u32x2 w;
      w[0] = pk2(o[dh][4 * g] * il, o[dh][4 * g + 1] * il);
      w[1] = pk2(o[dh][4 * g + 2] * il, o[dh][4 * g + 3] * il);
      *(u32x2*)(op + dv) = w;
    }
}

DI void mix_phase(const Params& p, int layer, unsigned char* smem, unsigned char* smem_all, int bid, int nb, int rrank) {
  const int wave = ltid() >> 6;
  const int n_scan = 256, n_lat = 1024, n_ctx = layer == 0 ? 16 : 0;
  const int e0 = n_scan, e1 = e0 + n_lat, e2 = e1 + n_ctx, e3 = e2 + n_lat, e4 = e3 + n_lat, e5 = e4 + n_ctx, e6 = e5 + n_ctx;
  {
    const int rnb_ = nb >> 1, per_r = (rnb_ >> 3) > 0 ? (rnb_ >> 3) : 1;
    const int bh = rrank / per_r, jj = rrank - bh * per_r;
    if (bh < 8)
      for (int qb = jj; qb < 64; qb += per_r) attnA_block(p, layer, smem_all, bh >> 2, bh & 3, (bh >> 2) * SEQ + qb * 256, 0, UA);
    if (layer == 0)
      for (int j = rrank; j < 8; j += rnb_) attnA_block(p, layer, smem_all, j >> 2, j & 3, TL + (j >> 2) * CTX, 0, CTX);
    __syncthreads();
  }
  for (int it = bid; it < e6; it += nb) {
    if (it < e0) scan_item(p, it);
    else if (it < e1) {
    } else if (it < e2) {
    } else if (it < e3) {
      const int j = it - e2, qb = j & 127, hq = (j >> 7) & 3, b = j >> 9;
      const int t0 = qb * 128 + wave * 32;
      attn64_wave<1>(p, layer, b, hq, b * SEQ + t0, t0);
    } else if (it < e4) {
      const int j = it - e3, qb = j & 127, hq = (j >> 7) & 3, b = j >> 9;
      const int t0 = qb * 128 + wave * 32;
      attn64_wave<0>(p, layer, b, hq, b * SEQ + t0, t0);
    } else if (it < e5) {
      const int j = it - e4, qb = j & 1, hq = (j >> 1) & 3, b = j >> 3;
      attn64_wave<3>(p, layer, b, hq, TL + b * CTX + qb * 128 + wave * 32, 0);
    } else {
      const int j = it - e5, qb = j & 1, hq = (j >> 1) & 3, b = j >> 3;
      attn64_wave<2>(p, layer, b, hq, TL + b * CTX + qb * 128 + wave * 32, 0);
    }
  }
}

template <int D>
DI void hgrn_dir(const Params& p, int layer, unsigned char* smem, int b, int hh, int n, float (&o)[16]) {
  const int tid = ltid();
  const int chain = (b * 4 + hh) * 2 + D;
  float* cumT = (float*)smem;
  float* qT = cumT + 64 * 68;
  float* kT = qT + 64 * 68;
  float* vv = kT + 64 * 68;
  float* psum = vv + 64 * 64;
  float kreg[16], qreg[16];
  {
    const int pp = tid >> 2, kq = (tid & 3) * 16;
    const int row = hg_row(b, D, n, pp);
    const bf16_t* pr = p.P + (size_t)row * NP;
    const bf16_t* qp = pr + 768 + hh * 64 + kq;
    const bf16_t* fp = pr + 1536 + D * 256 + hh * 64 + kq;
    const bf16_t* vp = pr + 1024 + hh * 64 + kq;
    const u32x4 q0 = *(const u32x4*)qp, q1 = *(const u32x4*)(qp + 8), f0 = *(const u32x4*)fp, f1 = *(const u32x4*)(fp + 8),
                v0 = *(const u32x4*)vp, v1 = *(const u32x4*)(vp + 8);
    float qx[16], fx[16], vx[16];
#pragma unroll
    for (int q = 0; q < 4; ++q) {
      qx[2 * q] = bf_lo(q0[q]); qx[2 * q + 1] = bf_hi(q0[q]); qx[8 + 2 * q] = bf_lo(q1[q]); qx[8 + 2 * q + 1] = bf_hi(q1[q]);
      fx[2 * q] = bf_lo(f0[q]); fx[2 * q + 1] = bf_hi(f0[q]); fx[8 + 2 * q] = bf_lo(f1[q]); fx[8 + 2 * q + 1] = bf_hi(f1[q]);
      vx[2 * q] = bf_lo(v0[q]); vx[2 * q + 1] = bf_hi(v0[q]); vx[8 + 2 * q] = bf_lo(v1[q]); vx[8 + 2 * q + 1] = bf_hi(v1[q]);
    }
#pragma unroll
    for (int j = 0; j < 16; ++j) {
      const float lb = hg_lb(p, layer, D, hh * 64 + kq + j);
      const float sg = 1.f / (1.f + expf(-fx[j]));
      const float f = lb + (1.f - lb) * sg;
      cumT[(kq + j) * 68 + pp] = logf(f) * LOG2E;
      qT[(kq + j) * 68 + pp] = qx[j];
      qreg[j] = qx[j];
      kreg[j] = 1.f - f;
      vv[pp * 64 + kq + j] = vx[j];
    }
    const float* Sg = p.HL + ((size_t)(chain * NCHUNK + n)) * 4096 + tid * 16;
#pragma unroll
    for (int i = 0; i < 4; ++i) *(f32x4*)(kT + tid * 16 + 4 * i) = *(const f32x4*)(Sg + 4 * i);
  }
  __syncthreads();
  {
    float c[16];
    prefix64(cumT, psum, tid, c);
    float* qrow = qT + (tid & 63) * 68 + 16 * (tid >> 6);
#pragma unroll
    for (int i4 = 0; i4 < 4; ++i4) {
      f32x4 t = *(const f32x4*)(qrow + 4 * i4);
#pragma unroll
      for (int a = 0; a < 4; ++a) t[a] *= fexp2(c[4 * i4 + a]);
      *(f32x4*)(qrow + 4 * i4) = t;
    }
  }
  __syncthreads();
  const int tg = tid >> 6, v = tid & 63, tgp = D ? 3 - tg : tg;
  {
#pragma unroll 2
    for (int k = 0; k < 64; ++k) {
      const float Sv = kT[k * 64 + v];
#pragma unroll
      for (int j4 = 0; j4 < 4; ++j4) {
        const f32x4 q4 = *(const f32x4*)(qT + k * 68 + 16 * tgp + 4 * j4);
#pragma unroll
        for (int a = 0; a < 4; ++a) { const int j = 4 * j4 + a; o[D ? 15 - j : j] += q4[a] * Sv; }
      }
    }
  }
  __syncthreads();
  {
    const int pp = tid >> 2, kq = (tid & 3) * 16;
#pragma unroll
    for (int j = 0; j < 16; ++j) { kT[(kq + j) * 68 + pp] = kreg[j]; qT[(kq + j) * 68 + pp] = qreg[j]; }
  }
  __syncthreads();
  const int bt = tid >> 4, bs = tid & 15;
  float sc[4][4];
#pragma unroll
  for (int a = 0; a < 4; ++a)
#pragma unroll
    for (int c = 0; c < 4; ++c) sc[a][c] = 0.f;
  if (bs <= bt) {
    for (int k = 0; k < 64; ++k) {
      const f32x4 ct = *(const f32x4*)(cumT + k * 68 + 4 * bt), qt = *(const f32x4*)(qT + k * 68 + 4 * bt);
      const f32x4 cs = *(const f32x4*)(cumT + k * 68 + 4 * bs), ks = *(const f32x4*)(kT + k * 68 + 4 * bs);
      const float ref = ct[0];
      float et[4], es[4];
#pragma unroll
      for (int a = 0; a < 4; ++a) { et[a] = qt[a] * fexp2(ct[a] - ref); es[a] = ks[a] * fexp2(ref - cs[a]); }
#pragma unroll
      for (int a = 0; a < 4; ++a)
#pragma unroll
        for (int c = 0; c < 4; ++c) sc[a][c] += et[a] * es[c];
    }
  }
  __syncthreads();
#pragma unroll
  for (int a = 0; a < 4; ++a) {
    f32x4 w;
#pragma unroll
    for (int c = 0; c < 4; ++c) w[c] = (bs <= bt && (4 * bs + c) <= (4 * bt + a)) ? sc[a][c] : 0.f;
    *(f32x4*)(kT + (4 * bt + a) * 68 + 4 * bs) = w;
  }
  __syncthreads();
  {
    const int send = 4 * (tgp + 1);
    for (int s4 = 0; s4 < send; ++s4) {
      float vq[4];
#pragma unroll
      for (int c = 0; c < 4; ++c) vq[c] = vv[(4 * s4 + c) * 64 + v];
#pragma unroll
      for (int j = 0; j < 16; ++j) {
        const f32x4 w = *(const f32x4*)(kT + (16 * tgp + j) * 68 + 4 * s4);
        o[D ? 15 - j : j] += w[0] * vq[0] + w[1] * vq[1] + w[2] * vq[2] + w[3] * vq[3];
      }
    }
  }
  __syncthreads();
}

DI void hgout_phase(const Params& p, int layer, unsigned char* smem, int bid, int nb) {
  const int tid = ltid();
  const int n_lat = 2 * 4 * 256, n_ctx = layer == 0 ? 2 * 4 * 4 : 0;
  for (int it = bid; it < n_lat + n_ctx; it += nb) {
    int b, hh, n0, n1, rowbase;
    if (it < n_lat) { const int m = it & 255; hh = (it >> 8) & 3; b = it >> 10; n0 = 4 + m; n1 = 4 + 255 - m; rowbase = b * SEQ + 64 * m; }
    else { const int j = it - n_lat, mc = j & 3; hh = (j >> 2) & 3; b = j >> 4; n0 = mc; n1 = 3 - mc; rowbase = TL + b * CTX + 64 * mc; }
    float o[16];
#pragma unroll
    for (int j = 0; j < 16; ++j) o[j] = 0.f;
    hgrn_dir<0>(p, layer, smem, b, hh, n0, o);
    hgrn_dir<1>(p, layer, smem, b, hh, n1, o);
    const int tg = tid >> 6, v = tid & 63;
    const float og = p.hg_out_gain[layer * 64 + v];
#pragma unroll
    for (int j = 0; j < 16; ++j) {
      const int row = rowbase + 16 * tg + j;
      const float ss = wave_sum(o[j] * o[j]);
      const float r = rsqrtf(ss * (1.f / 64.f) + EPS);
      const unsigned short gb = p.P[(size_t)row * NP + 1280 + hh * 64 + v];
      const float gx = __uint_as_float(((unsigned)gb) << 16);
      const float y = o[j] * r * og * (gx / (1.f + expf(-gx)));
      p.MO[(size_t)row * DM + 256 + hh * 64 + v] = tobf(y);
    }
  }
}

#if MULTI_LAUNCH
#define SYNC_OR_RETURN(ph) do { if (phase_sel == (ph)) return; } while (0)
#define RUN(ph) (phase_sel == (ph))
#else
#define RUN(ph) (true)
#endif

__global__ void __launch_bounds__(512) fwd_kernel(Params p, int phase_sel) {
  __shared__ __attribute__((aligned(16))) unsigned char smem_all[2 * SMEM_BYTES];
  const int rbid = blockIdx.x, rnb = gridDim.x;
  const int vb = __builtin_amdgcn_readfirstlane((int)(threadIdx.x >> 8));
  const int bid = rbid * 2 + vb, nb = rnb * 2;
  unsigned char* smem = smem_all + vb * SMEM_BYTES;
#if !MULTI_LAUNCH
  cg::grid_group grid = cg::this_grid();
#define GSYNC() grid.sync()
#else
#define GSYNC() do {} while (0)
#endif
  __shared__ int s_rank[2];
  if (threadIdx.x == 0) { const unsigned x = xcc_id(); s_rank[0] = (int)x; s_rank[1] = (int)atomicAdd(&p.xcnt[x], 1u); }
  int ph = 0;
  if (RUN(ph)) phase0(p, smem, bid, nb);
  GSYNC(); ++ph;
  if (threadIdx.x == 0) {
    int r = s_rank[1];
    for (int y = 0; y < s_rank[0]; ++y) r += (int)__hip_atomic_load(&p.xcnt[y], __ATOMIC_RELAXED, __HIP_MEMORY_SCOPE_AGENT);
    s_rank[0] = r;
  }
  __syncthreads();
  const int rrank = __builtin_amdgcn_readfirstlane(s_rank[0]);
  for (int layer = 0; layer < 2; ++layer) {
    const float* modl = p.mod + layer * 3 * 6144;
    const float* rl = layer == 0 ? p.x : p.out;
    const float* rc = layer == 0 ? p.ctx : p.Xc;
    if (RUN(ph)) norm_phase(rl, rc, TA, p.norm1_g + layer * DM, modl, 0, 1024, p.H, bid, nb);
    GSYNC(); ++ph;
    if (RUN(ph)) { EpiBf16 e{p.P, NP}; gemm_phase512(p.H, p.WinT + (size_t)layer * NP * 1024, TA / 256, NP / 256, 1024, 1024, 1, e, smem_all, rrank, rnb); }
    GSYNC(); ++ph;
    if (RUN(ph)) prep_phase(p, layer, smem, bid, nb);
    GSYNC(); ++ph;
    if (RUN(ph)) mix_phase(p, layer, smem, smem_all, bid, nb, rrank);
    GSYNC(); ++ph;
    if (RUN(ph)) hgout_phase(p, layer, smem, bid, nb);
    GSYNC(); ++ph;
    const int mrows = layer == 0 ? TA : TL;
    if (RUN(ph)) { EpiResid e{rl, rc, p.out, p.Xc, modl + 2048, 0}; gemm_phase512(p.MO, p.WoutT + (size_t)layer * 1024 * 1024, mrows / 256, 4, 1024, 1024, 1, e, smem_all, rrank, rnb); }
    GSYNC(); ++ph;
    if (RUN(ph)) norm_phase(p.out, p.Xc, mrows, p.norm2_g + layer * DM, modl, 3072, 4096, p.H, bid, nb);
    GSYNC(); ++ph;
    const int nchunks = layer == 0 ? 3 : 2;
    for (int ch = 0; ch < nchunks; ++ch) {
      const int row0 = ch * 16384, rows = ch < 2 ? 16384 : TC;
      if (RUN(ph)) { EpiRelu2 e{p.P, DFF}; gemm_phase512(p.H + (size_t)row0 * DM, p.W1T + (size_t)layer * DFF * 1024, rows / 256, DFF / 256, 1024, 1024, 1, e, smem_all, rrank, rnb); }
      GSYNC(); ++ph;
      if (RUN(ph)) {
        if (ch < 2) { EpiResid e{p.out, p.Xc, p.out, p.Xc, modl + 5 * 1024, row0}; gemm_phase512(p.P, p.W2T + (size_t)layer * 1024 * DFF, rows / 256, 4, DFF, DFF, 1, e, smem_all, rrank, rnb); }
        else { EpiResidAtomic e{p.out, p.Xc, modl + 5 * 1024, row0}; gemm_phase512(p.P, p.W2T + (size_t)layer * 1024 * DFF, rows / 256, 4, DFF, 256, 16, e, smem_all, rrank, rnb); }
      }
      GSYNC(); ++ph;
    }
  }
}

static size_t align_up(size_t v) { return (v + 255) & ~(size_t)255; }

extern "C" void kernel_launch(void* const* d_in, const int* in_sizes, int n_in, void* d_out, int out_size, void* d_ws, size_t ws_size,
                              hipStream_t stream) {
  Params p{};
  const float** f = (const float**)&p;
  for (int i = 0; i < 24; ++i) f[i] = (const float*)d_in[i];
  p.out = (float*)d_out;
  unsigned char* w = (unsigned char*)d_ws; size_t off = 0;
  auto take = [&](size_t bytes) { void* r = w + off; off = align_up(off + bytes); return r; };
  p.Xc = (float*)take((size_t)TC * DM * 4);
  p.mod = (float*)take((size_t)2 * 3 * 6144 * 4);
  p.Hdec = (float*)take((size_t)16 * NCHUNK * 64 * 4);
  p.WinT = (bf16_t*)take((size_t)2 * NP * 1024 * 2);
  p.WoutT = (bf16_t*)take((size_t)2 * 1024 * 1024 * 2);
  p.W1T = (bf16_t*)take((size_t)2 * DFF * 1024 * 2);
  p.W2T = (bf16_t*)take((size_t)2 * DFF * 1024 * 2);
  p.H = (bf16_t*)take((size_t)TA * DM * 2);
  p.HL = (float*)p.H;
  p.P = (bf16_t*)take((size_t)TA * NP * 2);
  p.MO = (bf16_t*)take((size_t)TA * DM * 2);
  p.VtA = (bf16_t*)take((size_t)2 * 4 * 64 * UA * 2);
  p.VtC = (bf16_t*)take((size_t)2 * 4 * 64 * UA * 2);
  p.VtD = (bf16_t*)take((size_t)2 * 2 * 64 * UA * 2);
  p.xcnt = (unsigned*)take(256);
  if (off > ws_size) { fprintf(stderr, "workspace too small: need %zu have %zu\n", off, ws_size); return; }
#if MULTI_LAUNCH
  const int nphase = 1 + 7 + 6 + 7 + 4;
  for (int ph = 0; ph < nphase; ++ph) hipLaunchKernelGGL(fwd_kernel, dim3(256), dim3(512), 0, stream, p, ph);
#else
  static int grid_blocks = 0;
  int phase_sel = -1;
  void* args[] = {&p, &phase_sel};
  if (!grid_blocks) {
    int dev = 0, cus = 0, per_cu = 0;
    (void)hipGetDevice(&dev);
    (void)hipDeviceGetAttribute(&cus, hipDeviceAttributeMultiprocessorCount, dev);
    (void)hipOccupancyMaxActiveBlocksPerMultiprocessor(&per_cu, fwd_kernel, 512, 0);
    if (per_cu < 1) per_cu = 1;
    grid_blocks = cus;
  }
  (void)hipMemsetAsync(p.xcnt, 0, 256, stream);
  hipError_t e = hipLaunchCooperativeKernel((void*)fwd_kernel, dim3(grid_blocks), dim3(512), args, 0, stream);
  if (e != hipSuccess) fprintf(stderr, "cooperative launch failed: %s (grid %d)\n", hipGetErrorString(e), grid_blocks);
#endif
}
```

```cpp
#include <hip/hip_runtime.h>
#include <hip/hip_cooperative_groups.h>
#include <cstdio>
#include <cstdint>
namespace cg = cooperative_groups;

#ifndef MULTI_LAUNCH
#define MULTI_LAUNCH 0
#endif

#define DI __device__ __forceinline__
typedef unsigned short bf16_t;
typedef short bf16x8 __attribute__((ext_vector_type(8)));
typedef float f32x16 __attribute__((ext_vector_type(16)));
typedef float f32x4 __attribute__((ext_vector_type(4)));
typedef float f32x2 __attribute__((ext_vector_type(2)));
typedef unsigned u32x4 __attribute__((ext_vector_type(4)));
typedef unsigned u32x2 __attribute__((ext_vector_type(2)));
typedef __bf16 bf16x2_t __attribute__((ext_vector_type(2)));

constexpr int SEQ = 16384, CTX = 256, DM = 1024, TL = 32768, TC = 512, TA = 33280, NP = 3328, DFF = 4096, UA = 16640;
constexpr int NCHUNK = 260;
constexpr float EPS = 1e-6f, LOG2E = 1.4426950408889634f;
constexpr int SMEM_BYTES = 73728;
constexpr int LDS_STRIDE = 144;

#define MFMA32(a, b, c) __builtin_amdgcn_mfma_f32_32x32x16_bf16((a), (b), (c), 0, 0, 0)

DI unsigned pk2(float a, float b) { f32x2 v = {a, b}; return __builtin_bit_cast(unsigned, __builtin_convertvector(v, bf16x2_t)); }
DI float bf_lo(unsigned u) { return __uint_as_float(u << 16); }
DI float bf_hi(unsigned u) { return __uint_as_float(u & 0xffff0000u); }
DI bf16_t tobf(float a) { return (bf16_t)(pk2(a, 0.f) & 0xffffu); }
DI float fexp2(float x) { return __builtin_amdgcn_exp2f(x); }
DI void sum16_nopk(float& acc, const float (&pe)[16]) {
  asm volatile("s_nop 0\n\tv_add_f32 %0, %1, %0\n\tv_add_f32 %0, %2, %0\n\tv_add_f32 %0, %3, %0\n\tv_add_f32 %0, %4, %0\n\t"
               "v_add_f32 %0, %5, %0\n\tv_add_f32 %0, %6, %0\n\tv_add_f32 %0, %7, %0\n\tv_add_f32 %0, %8, %0\n\t"
               "v_add_f32 %0, %9, %0\n\tv_add_f32 %0, %10, %0\n\tv_add_f32 %0, %11, %0\n\tv_add_f32 %0, %12, %0\n\t"
               "v_add_f32 %0, %13, %0\n\tv_add_f32 %0, %14, %0\n\tv_add_f32 %0, %15, %0\n\tv_add_f32 %0, %16, %0"
               : "+v"(acc)
               : "v"(pe[0]), "v"(pe[1]), "v"(pe[2]), "v"(pe[3]), "v"(pe[4]), "v"(pe[5]), "v"(pe[6]), "v"(pe[7]),
                 "v"(pe[8]), "v"(pe[9]), "v"(pe[10]), "v"(pe[11]), "v"(pe[12]), "v"(pe[13]), "v"(pe[14]), "v"(pe[15]));
}
DI float wave_sum(float v) {
#pragma unroll
  for (int o = 32; o > 0; o >>= 1) v += __shfl_xor(v, o);
  return v;
}
DI float wave_max(float v) {
#pragma unroll
  for (int o = 32; o > 0; o >>= 1) v = fmaxf(v, __shfl_xor(v, o));
  return v;
}
DI int ltid() { int t = threadIdx.x & 255; asm volatile("" : "+v"(t)); return t; }
DI int ltid512() { int t = threadIdx.x; asm volatile("" : "+v"(t)); return t; }
DI unsigned xcc_id() { return (unsigned)__builtin_amdgcn_s_getreg((3 << 11) | 20) & 0xFu; }
DI int rowOfU(int b, int u) { return u < CTX ? TL + b * CTX + u : b * SEQ + (u - CTX); }

struct Params {
  const float *x, *c, *ctx, *c_ctx, *w_mod, *b_mod, *norm1_g, *norm2_g, *w_in, *w_out;
  const float *da_q_gain, *da_k_gain, *da_lambda, *da_sub_gain, *hg_lb_logits, *hg_out_gain;
  const float *na_q_gain, *na_k_gain, *na_rpb, *sw_q_gain, *sw_k_gain, *sw_sink, *w_ff1, *w_ff2;
  float* out;
  float* Xc;
  float* mod;
  float* Hdec;
  bf16_t* WinT;
  bf16_t* WoutT;
  bf16_t* W1T;
  bf16_t* W2T;
  bf16_t* H;
  float* HL;
  bf16_t* P;
  bf16_t* MO;
  bf16_t* VtA;
  bf16_t* VtC;
  bf16_t* VtD;
  unsigned* xcnt;
};

DI void phase0(const Params& p, unsigned char* smem, int bid, int nb) {
  const int tid = ltid();
  constexpr int n_mod = 2 * 96;
  constexpr int t_in = 16 * 52, t_out = 16 * 16, t_f1 = 16 * 64, t_f2 = 64 * 16;
  constexpr int per_layer = t_in + t_out + t_f1 + t_f2;
  constexpr int total = n_mod + 2 * per_layer;
  float* fs = (float*)smem;
  for (int it = bid; it < total; it += nb) {
    if (it < n_mod) {
      const int l = it / 96, col0 = (it % 96) * 64;
      float* sc = fs;
      float* red = fs + 3072;
      for (int i = tid; i < 3072; i += 256) {
        const int cond = i >> 10, k = i & 1023;
        const float v = cond == 0 ? p.c[k] : (cond == 1 ? p.c[1024 + k] : p.c_ctx[k]);
        sc[i] = v / (1.f + expf(-v));
      }
      __syncthreads();
      const int kg = tid >> 6, j = tid & 63;
      float a0 = 0.f, a1 = 0.f, a2 = 0.f;
      const float* wp = p.w_mod + ((size_t)l * 1024 + kg * 256) * 6144 + col0 + j;
#pragma unroll 8
      for (int k = 0; k < 256; ++k) {
        const float w = wp[(size_t)k * 6144];
        a0 += sc[kg * 256 + k] * w; a1 += sc[1024 + kg * 256 + k] * w; a2 += sc[2048 + kg * 256 + k] * w;
      }
      red[(kg * 3 + 0) * 64 + j] = a0; red[(kg * 3 + 1) * 64 + j] = a1; red[(kg * 3 + 2) * 64 + j] = a2;
      __syncthreads();
      if (tid < 192) {
        const int cond = tid >> 6, jj = tid & 63;
        float s = p.b_mod[l * 6144 + col0 + jj];
#pragma unroll
        for (int g = 0; g < 4; ++g) s += red[(g * 3 + cond) * 64 + jj];
        p.mod[(l * 3 + cond) * 6144 + col0 + jj] = s;
      }
    } else {
      int idx = it - n_mod;
      const int l = idx / per_layer; idx -= l * per_layer;
      const float* src; bf16_t* dst; int K, N;
      if (idx < t_in) { src = p.w_in + (size_t)l * 1024 * NP; dst = p.WinT + (size_t)l * NP * 1024; K = 1024; N = NP; }
      else if (idx < t_in + t_out) { idx -= t_in; src = p.w_out + (size_t)l * 1024 * 1024; dst = p.WoutT + (size_t)l * 1024 * 1024; K = 1024; N = 1024; }
      else if (idx < t_in + t_out + t_f1) { idx -= t_in + t_out; src = p.w_ff1 + (size_t)l * 1024 * DFF; dst = p.W1T + (size_t)l * DFF * 1024; K = 1024; N = DFF; }
      else { idx -= t_in + t_out + t_f1; src = p.w_ff2 + (size_t)l * DFF * 1024; dst = p.W2T + (size_t)l * 1024 * DFF; K = DFF; N = 1024; }
      const int ntn = N >> 6, kt = idx / ntn, nt = idx % ntn, k0 = kt * 64, n0 = nt * 64;
#pragma unroll
      for (int i = 0; i < 4; ++i) {
        const int r = (tid >> 4) + 16 * i, c4 = (tid & 15) * 4;
        const f32x4 v = *(const f32x4*)(src + (size_t)(k0 + r) * N + n0 + c4);
        fs[r * 65 + c4] = v[0]; fs[r * 65 + c4 + 1] = v[1]; fs[r * 65 + c4 + 2] = v[2]; fs[r * 65 + c4 + 3] = v[3];
      }
      __syncthreads();
      const int n = tid >> 2, kq = (tid & 3) * 16;
      u32x4 w0, w1;
#pragma unroll
      for (int i = 0; i < 4; ++i) {
        w0[i] = pk2(fs[(kq + 2 * i) * 65 + n], fs[(kq + 2 * i + 1) * 65 + n]);
        w1[i] = pk2(fs[(kq + 8 + 2 * i) * 65 + n], fs[(kq + 8 + 2 * i + 1) * 65 + n]);
      }
      bf16_t* dp = dst + (size_t)(n0 + n) * K + k0 + kq;
      *(u32x4*)dp = w0; *(u32x4*)(dp + 8) = w1;
    }
    __syncthreads();
  }
}

DI void norm_phase(const float* lat, const float* ctxp, int nrows, const float* g, const float* modl, int shift_off, int scale_off,
                   bf16_t* H, int bid, int nb) {
  const int wave = ltid() >> 6, lane = ltid() & 63;
  for (int r4 = bid; r4 < nrows / 4; r4 += nb) {
    const int row = r4 * 4 + wave;
    const float* src = row < TL ? lat + (size_t)row * DM : ctxp + (size_t)(row - TL) * DM;
    const int mi = row < TL ? (row >> 14) : 2;
    const float* sh = modl + mi * 6144 + shift_off;
    const float* sc = modl + mi * 6144 + scale_off;
    f32x4 v[4]; float ss = 0.f;
#pragma unroll
    for (int i = 0; i < 4; ++i) { v[i] = *(const f32x4*)(src + lane * 4 + 256 * i); ss += v[i][0] * v[i][0] + v[i][1] * v[i][1] + v[i][2] * v[i][2] + v[i][3] * v[i][3]; }
    ss = wave_sum(ss);
    const float rs = rsqrtf(ss * (1.f / 1024.f) + EPS);
#pragma unroll
    for (int i = 0; i < 4; ++i) {
      const int col = lane * 4 + 256 * i;
      const f32x4 gg = *(const f32x4*)(g + col), s4 = *(const f32x4*)(sc + col), h4 = *(const f32x4*)(sh + col);
      float y[4];
#pragma unroll
      for (int j = 0; j < 4; ++j) y[j] = (v[i][j] * rs * gg[j]) * (1.f + s4[j]) + h4[j];
      u32x2 w; w[0] = pk2(y[0], y[1]); w[1] = pk2(y[2], y[3]);
      *(u32x2*)(H + (size_t)row * DM + col) = w;
    }
  }
}

struct EpiBf16 {
  static constexpr bool kBf16 = true;
  DI static float act(float v) { return v; }
  bf16_t* O; int ldc;
  DI void operator()(int m, int n, f32x4 v) const {
    u32x2 w; w[0] = pk2(v[0], v[1]); w[1] = pk2(v[2], v[3]);
    *(u32x2*)(O + (size_t)m * ldc + n) = w;
  }
};
struct EpiRelu2 {
  static constexpr bool kBf16 = true;
  DI static float act(float v) { const float t = fmaxf(v, 0.f); return t * t; }
  bf16_t* O; int ldc;
  DI void operator()(int m, int n, f32x4 v) const {
    float y[4];
#pragma unroll
    for (int j = 0; j < 4; ++j) { const float t = fmaxf(v[j], 0.f); y[j] = t * t; }
    u32x2 w; w[0] = pk2(y[0], y[1]); w[1] = pk2(y[2], y[3]);
    *(u32x2*)(O + (size_t)m * ldc + n) = w;
  }
};
struct EpiResid {
  static constexpr bool kBf16 = false;
  const float* sl; const float* sc; float* dl; float* dc; const float* gate; int row0;
  DI void operator()(int m, int n, f32x4 v) const {
    const int row = m + row0;
    const float* s = row < TL ? sl + (size_t)row * DM : sc + (size_t)(row - TL) * DM;
    float* d = row < TL ? dl + (size_t)row * DM : dc + (size_t)(row - TL) * DM;
    const int mi = row < TL ? (row >> 14) : 2;
    const f32x4 g = *(const f32x4*)(gate + mi * 6144 + n);
    const f32x4 r = *(const f32x4*)(s + n);
    f32x4 o;
#pragma unroll
    for (int j = 0; j < 4; ++j) o[j] = r[j] + g[j] * v[j];
    *(f32x4*)(d + n) = o;
  }
};

template <class Epi>
DI void gemm_phase(const bf16_t* A, const bf16_t* Bt, int mtiles, int ntiles, int K, const Epi& epi, unsigned char* smem, int bid, int nb) {
  const int tid = ltid(), lane = tid & 63, wave = tid >> 6;
  const int wm = wave & 1, wn = wave >> 1, l31 = lane & 31, hh = lane >> 5;
  unsigned char* As0 = smem;
  unsigned char* Bs0 = smem + 2 * 128 * LDS_STRIDE;
  const int nk = K >> 6;
  const int ldrow = tid >> 3, ldcol = (tid & 7) * 8;
  const int total = mtiles * ntiles;
  const int xper = (nb >> 3) > 0 ? (nb >> 3) : 1;
  const int xcd = nb >= 8 ? (bid & 7) : 0, xj = nb >= 8 ? (bid >> 3) : bid, xstep = nb >= 8 ? 8 : 1;
  if (nb >= 8 && bid >= xper * 8) return;
  for (int ch = xcd; ch * xper + xj < total; ch += xstep) {
    const int it = ch * xper + xj;
    const int band = it / (8 * ntiles), rr = it - band * 8 * ntiles;
    const int rib = (mtiles - 8 * band) < 8 ? (mtiles - 8 * band) : 8;
    const int pn = rr / rib, pm = 8 * band + rr % rib;
    const bf16_t* Ap = A + (size_t)(pm * 128 + ldrow) * K + ldcol;
    const bf16_t* Bp = Bt + (size_t)(pn * 128 + ldrow) * K + ldcol;
    f32x16 acc[2][2];
#pragma unroll
    for (int a = 0; a < 2; ++a)
#pragma unroll
      for (int b = 0; b < 2; ++b)
#pragma unroll
        for (int i = 0; i < 16; ++i) acc[a][b][i] = 0.f;
    u32x4 ra0[4], rb0[4], ra1[4], rb1[4];
#define G_LOAD(RA, RB, KT) do { _Pragma("unroll") for (int i = 0; i < 4; ++i) { RA[i] = *(const u32x4*)(Ap + (size_t)i * 32 * K + (KT) * 64); RB[i] = *(const u32x4*)(Bp + (size_t)i * 32 * K + (KT) * 64); } } while (0)
#define G_STORE(RA, RB, BUF) do { unsigned char* Aw = As0 + (BUF) * 128 * LDS_STRIDE; unsigned char* Bw = Bs0 + (BUF) * 128 * LDS_STRIDE; \
      _Pragma("unroll") for (int i = 0; i < 4; ++i) { *(u32x4*)(Aw + (ldrow + 32 * i) * LDS_STRIDE + ldcol * 2) = RA[i]; *(u32x4*)(Bw + (ldrow + 32 * i) * LDS_STRIDE + ldcol * 2) = RB[i]; } } while (0)
#define G_COMPUTE(BUF) do { const unsigned char* As = As0 + (BUF) * 128 * LDS_STRIDE; const unsigned char* Bs = Bs0 + (BUF) * 128 * LDS_STRIDE; \
      _Pragma("unroll") for (int ks = 0; ks < 4; ++ks) { bf16x8 wf[2], af[2]; \
        _Pragma("unroll") for (int i = 0; i < 2; ++i) { \
          wf[i] = *(const bf16x8*)(Bs + (wn * 64 + i * 32 + l31) * LDS_STRIDE + (ks * 16 + 8 * hh) * 2); \
          af[i] = *(const bf16x8*)(As + (wm * 64 + i * 32 + l31) * LDS_STRIDE + (ks * 16 + 8 * hh) * 2); } \
        _Pragma("unroll") for (int ni = 0; ni < 2; ++ni) _Pragma("unroll") for (int mi = 0; mi < 2; ++mi) acc[ni][mi] = MFMA32(wf[ni], af[mi], acc[ni][mi]); } } while (0)
    G_LOAD(ra0, rb0, 0);
    G_LOAD(ra1, rb1, 1);
    G_STORE(ra0, rb0, 0);
    __syncthreads();
#pragma unroll 1
    for (int kt = 0; kt < nk; kt += 2) {
      const int k2 = kt + 2 < nk ? kt + 2 : 0, k3 = kt + 3 < nk ? kt + 3 : 1;
      G_LOAD(ra0, rb0, k2);
      G_COMPUTE(0);
      G_STORE(ra1, rb1, 1);
      __syncthreads();
      G_LOAD(ra1, rb1, k3);
      G_COMPUTE(1);
      G_STORE(ra0, rb0, 0);
      __syncthreads();
    }
#pragma unroll
    for (int ni = 0; ni < 2; ++ni)
#pragma unroll
      for (int mi = 0; mi < 2; ++mi) {
        const int m = pm * 128 + wm * 64 + mi * 32 + l31;
#pragma unroll
        for (int g = 0; g < 4; ++g) {
          const int n = pn * 128 + wn * 64 + ni * 32 + 8 * g + 4 * hh;
          f32x4 v = {acc[ni][mi][4 * g], acc[ni][mi][4 * g + 1], acc[ni][mi][4 * g + 2], acc[ni][mi][4 * g + 3]};
          epi(m, n, v);
        }
      }
  }
}

struct EpiResidAtomic {
  static constexpr bool kBf16 = false;
  float* dl; float* dc; const float* gate; int row0;
  DI void operator()(int m, int n, f32x4 v) const {
    const int row = m + row0;
    float* d = row < TL ? dl + (size_t)row * DM : dc + (size_t)(row - TL) * DM;
    const int mi = row < TL ? (row >> 14) : 2;
    const f32x4 g = *(const f32x4*)(gate + mi * 6144 + n);
#pragma unroll
    for (int j = 0; j < 4; ++j) unsafeAtomicAdd(d + n + j, g[j] * v[j]);
  }
};

template <class Epi>
DI void gemm_phase512(const bf16_t* A, const bf16_t* Bt, int mtiles, int ntiles, int K, int Kper, int ksplit, const Epi& epi,
                      unsigned char* smem, int bid, int nb) {
  const int tid = ltid512(), lane = tid & 63, wave = tid >> 6;
  const int wm = wave & 1, wn = wave >> 1, l31 = lane & 31, hh = lane >> 5;
  constexpr int OPB = 256 * LDS_STRIDE;
  unsigned char* As0 = smem;
  unsigned char* Bs0 = smem + 2 * OPB;
  const int nk = Kper >> 6;
  const int ldrow = tid >> 3, ldcol = (tid & 7) * 8;
  const int ntile = mtiles * ntiles, total = ntile * ksplit;
  for (int it = bid; it < total; it += nb) {
    const int tile = it / ksplit, ks = it - tile * ksplit;
    const int band = tile / (8 * ntiles), rr = tile - band * 8 * ntiles;
    const int rib = (mtiles - 8 * band) < 8 ? (mtiles - 8 * band) : 8;
    const int pn = rr / rib, pm = 8 * band + rr % rib;
    const bf16_t* Ap = A + (size_t)(pm * 256 + ldrow) * K + ks * Kper + ldcol;
    const bf16_t* Bp = Bt + (size_t)(pn * 256 + ldrow) * K + ks * Kper + ldcol;
    f32x16 acc[2][4];
#pragma unroll
    for (int a = 0; a < 2; ++a)
#pragma unroll
      for (int b = 0; b < 4; ++b)
#pragma unroll
        for (int i = 0; i < 16; ++i) acc[a][b][i] = 0.f;
    u32x4 ra[4], rb[4];
#define H_LOAD(KT) do { _Pragma("unroll") for (int i = 0; i < 4; ++i) { ra[i] = *(const u32x4*)(Ap + (size_t)i * 64 * K + (KT) * 64); rb[i] = *(const u32x4*)(Bp + (size_t)i * 64 * K + (KT) * 64); } } while (0)
#define H_STORE(BUF) do { unsigned char* Aw = As0 + (BUF) * OPB; unsigned char* Bw = Bs0 + (BUF) * OPB; \
      _Pragma("unroll") for (int i = 0; i < 4; ++i) { *(u32x4*)(Aw + (ldrow + 64 * i) * LDS_STRIDE + ldcol * 2) = ra[i]; *(u32x4*)(Bw + (ldrow + 64 * i) * LDS_STRIDE + ldcol * 2) = rb[i]; } } while (0)
    H_LOAD(0);
    H_STORE(0);
    H_LOAD(1);
    __syncthreads();
#pragma unroll 1
    for (int kt = 0; kt < nk; ++kt) {
      const int buf = kt & 1;
      const int kn = kt + 2 < nk ? kt + 2 : 0;
      const unsigned char* As = As0 + buf * OPB;
      const unsigned char* Bs = Bs0 + buf * OPB;
      unsigned char* Aw = As0 + (buf ^ 1) * OPB;
      unsigned char* Bw = Bs0 + (buf ^ 1) * OPB;
#pragma unroll
      for (int k16 = 0; k16 < 4; ++k16) {
        bf16x8 wf[2], af[4];
#pragma unroll
        for (int i = 0; i < 2; ++i) wf[i] = *(const bf16x8*)(Bs + (wn * 64 + i * 32 + l31) * LDS_STRIDE + (k16 * 16 + 8 * hh) * 2);
#pragma unroll
        for (int i = 0; i < 4; ++i) af[i] = *(const bf16x8*)(As + (wm * 128 + i * 32 + l31) * LDS_STRIDE + (k16 * 16 + 8 * hh) * 2);
#pragma unroll
        for (int ni = 0; ni < 2; ++ni)
#pragma unroll
          for (int mi = 0; mi < 4; ++mi) acc[ni][mi] = MFMA32(wf[ni], af[mi], acc[ni][mi]);
        *(u32x4*)(Aw + (ldrow + 64 * k16) * LDS_STRIDE + ldcol * 2) = ra[k16];
        *(u32x4*)(Bw + (ldrow + 64 * k16) * LDS_STRIDE + ldcol * 2) = rb[k16];
        ra[k16] = *(const u32x4*)(Ap + (size_t)k16 * 64 * K + kn * 64);
        rb[k16] = *(const u32x4*)(Bp + (size_t)k16 * 64 * K + kn * 64);
        __builtin_amdgcn_sched_barrier(0);
      }
      __syncthreads();
    }
    {
      unsigned char* wl = smem + wave * 18432;
      const int m0 = pm * 256 + wm * 128, n0 = pn * 256 + wn * 64;
      if constexpr (Epi::kBf16) {
#pragma unroll
        for (int ni = 0; ni < 2; ++ni)
#pragma unroll
          for (int mi = 0; mi < 4; ++mi)
#pragma unroll
            for (int g = 0; g < 4; ++g) {
              u32x2 w;
              w[0] = pk2(Epi::act(acc[ni][mi][4 * g]), Epi::act(acc[ni][mi][4 * g + 1]));
              w[1] = pk2(Epi::act(acc[ni][mi][4 * g + 2]), Epi::act(acc[ni][mi][4 * g + 3]));
              *(u32x2*)(wl + (mi * 32 + l31) * LDS_STRIDE + (ni * 32 + 8 * g + 4 * hh) * 2) = w;
            }
        asm volatile("" ::: "memory");
#pragma unroll
        for (int i = 0; i < 16; ++i) {
          const int row = (lane >> 3) + 8 * i, ch = lane & 7;
          const u32x4 w = *(const u32x4*)(wl + row * LDS_STRIDE + ch * 16);
          *(u32x4*)(epi.O + (size_t)(m0 + row) * epi.ldc + n0 + ch * 8) = w;
        }
      } else {
#pragma unroll
        for (int half = 0; half < 2; ++half) {
          if (half) asm volatile("" ::: "memory");
#pragma unroll
          for (int ni = 0; ni < 2; ++ni)
#pragma unroll
            for (int mh = 0; mh < 2; ++mh)
#pragma unroll
              for (int g = 0; g < 4; ++g) {
                const int mi = 2 * half + mh;
                f32x4 v = {acc[ni][mi][4 * g], acc[ni][mi][4 * g + 1], acc[ni][mi][4 * g + 2], acc[ni][mi][4 * g + 3]};
                *(f32x4*)(wl + (mh * 32 + l31) * 272 + (ni * 32 + 8 * g + 4 * hh) * 4) = v;
              }
          asm volatile("" ::: "memory");
#pragma unroll
          for (int i = 0; i < 16; ++i) {
            const int row = (lane >> 4) + 4 * i, ch = lane & 15;
            const f32x4 v = *(const f32x4*)(wl + row * 272 + ch * 16);
            epi(m0 + half * 64 + row, n0 + ch * 4, v);
          }
        }
      }
    }
    __syncthreads();
  }
}

DI float hg_lb(const Params& p, int layer, int d, int j) {
  if (layer == 0) return 0.f;
  const float l0 = p.hg_lb_logits[d * 256 + j], l1 = p.hg_lb_logits[512 + d * 256 + j];
  return 1.f / (1.f + expf(l0 - l1));
}

DI void prep32_item(const Params& p, int layer, int it) {
  const int idx = it * 256 + ltid();
  const int row = idx >> 4, j = idx & 15, isk = j >> 3, sub = j & 7;
  bf16_t* ptr = p.P + (size_t)row * NP + isk * 256 + sub * 32;
  const float* gain = (isk ? p.da_k_gain : p.da_q_gain) + layer * 32;
  float v[32];
#pragma unroll
  for (int i = 0; i < 4; ++i) {
    const u32x4 w = *(const u32x4*)(ptr + 8 * i);
#pragma unroll
    for (int q = 0; q < 4; ++q) { v[8 * i + 2 * q] = bf_lo(w[q]); v[8 * i + 2 * q + 1] = bf_hi(w[q]); }
  }
  float ss = 0.f;
#pragma unroll
  for (int i = 0; i < 32; ++i) ss += v[i] * v[i];
  const float r = rsqrtf(ss * (1.f / 32.f) + EPS);
#pragma unroll
  for (int i = 0; i < 32; ++i) v[i] = v[i] * r * gain[i];
  if (row < TL) {
    const int t = row & (SEQ - 1);
    const float gr = (float)(t >> 6), gc = (float)(t & 63);
#pragma unroll
    for (int i = 0; i < 8; ++i) {
      constexpr float FRA[8] = {1.f, 0.31622776601683794f, 0.1f, 0.031622776601683794f, 0.01f, 0.0031622776601683794f, 0.001f, 0.00031622776601683794f};
      const float fr = FRA[i];
      const float ar = gr * fr, ac = gc * fr;
      const float cr = __cosf(ar), sr = __sinf(ar), cc = __cosf(ac), sc = __sinf(ac);
      const float x1 = v[i], x2 = v[8 + i];
      v[i] = x1 * cr - x2 * sr; v[8 + i] = x1 * sr + x2 * cr;
      const float y1 = v[16 + i], y2 = v[24 + i];
      v[16 + i] = y1 * cc - y2 * sc; v[24 + i] = y1 * sc + y2 * cc;
    }
  }
  const float qs = isk ? 1.f : (0.17677669529663687f * LOG2E);
#pragma unroll
  for (int i = 0; i < 4; ++i) {
    u32x4 w;
#pragma unroll
    for (int q = 0; q < 4; ++q) w[q] = pk2(v[8 * i + 2 * q] * qs, v[8 * i + 2 * q + 1] * qs);
    *(u32x4*)(ptr + 8 * i) = w;
  }
}

DI void prep64_item(const Params& p, int layer, int it) {
  const int idx = it * 256 + ltid();
  const int row = idx / 14, j = idx % 14;
  int col; const float* gain; bool rope, isq;
  if (j < 4) { col = 2048 + 64 * j; gain = p.na_q_gain; rope = false; isq = true; }
  else if (j < 8) { col = 2304 + 64 * (j - 4); gain = p.na_k_gain; rope = false; isq = false; }
  else if (j < 12) { col = 2816 + 64 * (j - 8); gain = p.sw_q_gain; rope = true; isq = true; }
  else { col = 3072 + 64 * (j - 12); gain = p.sw_k_gain; rope = true; isq = false; }
  gain += layer * 64;
  bf16_t* ptr = p.P + (size_t)row * NP + col;
  float v[64];
#pragma unroll
  for (int i = 0; i < 8; ++i) {
    const u32x4 w = *(const u32x4*)(ptr + 8 * i);
#pragma unroll
    for (int q = 0; q < 4; ++q) { v[8 * i + 2 * q] = bf_lo(w[q]); v[8 * i + 2 * q + 1] = bf_hi(w[q]); }
  }
  float ss = 0.f;
#pragma unroll
  for (int i = 0; i < 64; ++i) ss += v[i] * v[i];
  const float r = rsqrtf(ss * (1.f / 64.f) + EPS);
#pragma unroll
  for (int i = 0; i < 64; ++i) v[i] = v[i] * r * gain[i];
  if (rope && row < TL) {
    const int t = row & (SEQ - 1);
    const float gr = (float)(t >> 6), gc = (float)(t & 63);
#pragma unroll
    for (int i = 0; i < 16; ++i) {
      constexpr float FRD[16] = {1.f, 0.5623413251903491f, 0.31622776601683794f, 0.1778279410038923f, 0.1f, 0.05623413251903491f, 0.031622776601683794f, 0.01778279410038923f, 0.01f, 0.005623413251903491f, 0.0031622776601683794f, 0.001778279410038923f, 0.001f, 0.0005623413251903491f, 0.00031622776601683794f, 0.0001778279410038923f};
      const float fr = FRD[i];
      const float ar = gr * fr, ac = gc * fr;
      const float cr = __cosf(ar), sr = __sinf(ar), cc = __cosf(ac), sc = __sinf(ac);
      const float x1 = v[i], x2 = v[16 + i];
      v[i] = x1 * cr - x2 * sr; v[16 + i] = x1 * sr + x2 * cr;
      const float y1 = v[32 + i], y2 = v[48 + i];
      v[32 + i] = y1 * cc - y2 * sc; v[48 + i] = y1 * sc + y2 * cc;
    }
  }
  const float qs = isq ? (0.125f * LOG2E) : 1.f;
#pragma unroll
  for (int i = 0; i < 8; ++i) {
    u32x4 w;
#pragma unroll
    for (int q = 0; q < 4; ++q) w[q] = pk2(v[8 * i + 2 * q] * qs, v[8 * i + 2 * q + 1] * qs);
    *(u32x4*)(ptr + 8 * i) = w;
  }
}

DI void vt_item(const Params& p, int it, unsigned char* smem) {
  const int tid = ltid();
  const int hv = it % 10, ug = (it / 10) % NCHUNK, b = it / (10 * NCHUNK);
  int vcol; bf16_t* dst;
  if (hv < 4) { vcol = 512 + 64 * hv; dst = p.VtA + (size_t)(b * 4 + hv) * 64 * UA; }
  else if (hv < 8) { vcol = 2560 + 64 * (hv - 4); dst = p.VtC + (size_t)(b * 4 + hv - 4) * 64 * UA; }
  else { vcol = 3200 + 64 * (hv - 8); dst = p.VtD + (size_t)(b * 2 + hv - 8) * 64 * UA; }
  const int u0 = ug * 64;
  bf16_t* tile = (bf16_t*)smem;
  {
    const int tk = tid >> 2, seg = (tid & 3) * 16;
    const int row = rowOfU(b, u0 + tk);
    const bf16_t* src = p.P + (size_t)row * NP + vcol + seg;
    const u32x4 w0 = *(const u32x4*)src, w1 = *(const u32x4*)(src + 8);
    unsigned* tp = (unsigned*)(tile + tk * 66 + seg);
#pragma unroll
    for (int q = 0; q < 4; ++q) { tp[q] = w0[q]; tp[4 + q] = w1[q]; }
  }
  __syncthreads();
  {
    const int dv = tid >> 2, tq = (tid & 3) * 16;
    u32x4 w0, w1;
#pragma unroll
    for (int q = 0; q < 4; ++q) {
      w0[q] = (unsigned)tile[(tq + 2 * q) * 66 + dv] | ((unsigned)tile[(tq + 2 * q + 1) * 66 + dv] << 16);
      w1[q] = (unsigned)tile[(tq + 8 + 2 * q) * 66 + dv] | ((unsigned)tile[(tq + 8 + 2 * q + 1) * 66 + dv] << 16);
    }
    bf16_t* dp = dst + (size_t)dv * UA + u0 + tq;
    *(u32x4*)dp = w0; *(u32x4*)(dp + 8) = w1;
  }
  __syncthreads();
}

DI int hg_row(int b, int d, int n, int pp) {
  if (n < 4) { const int c = d ? 255 - (64 * n + pp) : 64 * n + pp; return TL + b * CTX + c; }
  const int t = d ? SEQ - 1 - (64 * (n - 4) + pp) : 64 * (n - 4) + pp;
  return b * SEQ + t;
}

DI void prefix64(float* cumT, float* psum, int tid, float (&c)[16]) {
  const int k = tid & 63, qd = tid >> 6;
  float* row = cumT + k * 68 + 16 * qd;
#pragma unroll
  for (int i4 = 0; i4 < 4; ++i4) { const f32x4 t = *(const f32x4*)(row + 4 * i4); c[4 * i4] = t[0]; c[4 * i4 + 1] = t[1]; c[4 * i4 + 2] = t[2]; c[4 * i4 + 3] = t[3]; }
#pragma unroll
  for (int i = 1; i < 16; ++i) c[i] += c[i - 1];
  psum[qd * 64 + k] = c[15];
  __syncthreads();
  float off = 0.f;
#pragma unroll
  for (int q = 0; q < 3; ++q) off += (q < qd) ? psum[q * 64 + k] : 0.f;
#pragma unroll
  for (int i = 0; i < 16; ++i) c[i] += off;
#pragma unroll
  for (int i4 = 0; i4 < 4; ++i4) { f32x4 t = {c[4 * i4], c[4 * i4 + 1], c[4 * i4 + 2], c[4 * i4 + 3]}; *(f32x4*)(row + 4 * i4) = t; }
}

DI void hgsum_item(const Params& p, int layer, int it, unsigned char* smem) {
  const int tid = ltid();
  const int n = it % NCHUNK, chain = it / NCHUNK, d = chain & 1, hh = (chain >> 1) & 3, b = chain >> 3;
  float* cumT = (float*)smem;
  float* wk = cumT + 64 * 68;
  float* vv = wk + 64 * 64;
  float* psum = vv + 64 * 64;
  const int pp = tid >> 2, kq = (tid & 3) * 16;
  {
    const int row = hg_row(b, d, n, pp);
    const bf16_t* pr = p.P + (size_t)row * NP;
    const bf16_t* fp = pr + 1536 + d * 256 + hh * 64 + kq;
    const bf16_t* vp = pr + 1024 + hh * 64 + kq;
    const u32x4 f0 = *(const u32x4*)fp, f1 = *(const u32x4*)(fp + 8), v0 = *(const u32x4*)vp, v1 = *(const u32x4*)(vp + 8);
    float fx[16], vx[16];
#pragma unroll
    for (int q = 0; q < 4; ++q) { fx[2 * q] = bf_lo(f0[q]); fx[2 * q + 1] = bf_hi(f0[q]); fx[8 + 2 * q] = bf_lo(f1[q]); fx[8 + 2 * q + 1] = bf_hi(f1[q]);
                                  vx[2 * q] = bf_lo(v0[q]); vx[2 * q + 1] = bf_hi(v0[q]); vx[8 + 2 * q] = bf_lo(v1[q]); vx[8 + 2 * q + 1] = bf_hi(v1[q]); }
#pragma unroll
    for (int j = 0; j < 16; ++j) {
      const float lb = hg_lb(p, layer, d, hh * 64 + kq + j);
      const float sg = 1.f / (1.f + expf(-fx[j]));
      const float f = lb + (1.f - lb) * sg;
      cumT[(kq + j) * 68 + pp] = logf(f) * LOG2E;
      wk[pp * 64 + kq + j] = 1.f - f;
      vv[pp * 64 + kq + j] = vx[j];
    }
  }
  __syncthreads();
  { float c[16]; prefix64(cumT, psum, tid, c); }
  __syncthreads();
#pragma unroll
  for (int j = 0; j < 16; ++j) {
    const int k = kq + j;
    wk[pp * 64 + k] *= fexp2(cumT[k * 68 + 63] - cumT[k * 68 + pp]);
  }
  __syncthreads();
  {
    const int kg = tid >> 6, v = tid & 63;
    float acc[16];
#pragma unroll
    for (int j = 0; j < 16; ++j) acc[j] = 0.f;
    for (int q = 0; q < 64; ++q) {
      const float vq = vv[q * 64 + v];
#pragma unroll
      for (int j4 = 0; j4 < 4; ++j4) {
        const f32x4 w4 = *(const f32x4*)(wk + q * 64 + kg * 16 + 4 * j4);
#pragma unroll
        for (int a = 0; a < 4; ++a) acc[4 * j4 + a] += w4[a] * vq;
      }
    }
    float* L = p.HL + ((size_t)(chain * NCHUNK + n)) * 4096;
#pragma unroll
    for (int j = 0; j < 16; ++j) L[(kg * 16 + j) * 64 + v] = acc[j];
    if (tid < 64) p.Hdec[(chain * NCHUNK + n) * 64 + tid] = fexp2(cumT[tid * 68 + 63]);
  }
  __syncthreads();
}

DI void prep_phase(const Params& p, int layer, unsigned char* smem, int bid, int nb) {
  constexpr int n_hg = 16 * NCHUNK;
  constexpr int n_vt = 2 * NCHUNK * 10;
  constexpr int n_p32 = TA * 16 / 256;
  constexpr int n_p64 = TA * 14 / 256;
  constexpr int total = n_hg + n_vt + n_p32 + n_p64;
  for (int it = bid; it < total; it += nb) {
    if (it < n_hg) hgsum_item(p, layer, it, smem);
    else if (it < n_hg + n_vt) vt_item(p, it - n_hg, smem);
    else if (it < n_hg + n_vt + n_p32) prep32_item(p, layer, it - n_hg - n_vt);
    else prep64_item(p, layer, it - n_hg - n_vt - n_p32);
  }
}

DI void scan_item(const Params& p, int it) {
  const int chain = it >> 4, e = (it & 15) * 256 + ltid(), k = e >> 6;
  float* L = p.HL + (size_t)chain * NCHUNK * 4096 + e;
  const float* dc = p.Hdec + chain * NCHUNK * 64 + k;
  float S = 0.f;
  for (int n0 = 0; n0 < NCHUNK; n0 += 10) {
    float l[10], dd[10];
#pragma unroll
    for (int j = 0; j < 10; ++j) { l[j] = L[(size_t)(n0 + j) * 4096]; dd[j] = dc[(n0 + j) * 64]; }
#pragma unroll
    for (int j = 0; j < 10; ++j) { L[(size_t)(n0 + j) * 4096] = S; S = dd[j] * S + l[j]; }
  }
}

DI void attnA_block(const Params& p, int layer, unsigned char* smem, int b, int h, int qrow_blk, int ubeg, int uend) {
  const int tid = ltid512(), wave = tid >> 6;
  const int lane = tid & 63, qi = lane & 31, hh = lane >> 5;
  const int qrow0 = qrow_blk + wave * 32;
  const int pr = (qi & 19) | ((qi & 4) << 1) | ((qi & 8) >> 1);
  const float lam_init = layer == 0 ? 0.2f : 0.35550906759096f;
  float gq = lane < 32 ? fabsf(p.da_q_gain[layer * 32 + lane]) : 0.f, gk = lane < 32 ? fabsf(p.da_k_gain[layer * 32 + lane]) : 0.f;
  gq = wave_max(gq); gk = wave_max(gk);
  const float negM2 = -(0.17677669529663687f * LOG2E * 32.f * 1.02f) * gq * gk;
  float la = 0.f, lb_ = 0.f;
  if (lane < 32) { const float* lv = p.da_lambda + layer * 128; la = lv[lane] * lv[32 + lane]; lb_ = lv[64 + lane] * lv[96 + lane]; }
  la = wave_sum(la); lb_ = wave_sum(lb_);
  const float lam = expf(la) - expf(lb_) + lam_init;

  const bf16_t* qp = p.P + (size_t)(qrow0 + qi) * NP + h * 64 + 8 * hh;
  bf16x8 qf[2][2];
#pragma unroll
  for (int m = 0; m < 2; ++m)
#pragma unroll
    for (int ks = 0; ks < 2; ++ks) qf[m][ks] = *(const bf16x8*)(qp + m * 32 + ks * 16);
  f32x16 o[2][2];
#pragma unroll
  for (int m = 0; m < 2; ++m)
#pragma unroll
    for (int dh = 0; dh < 2; ++dh)
#pragma unroll
      for (int i = 0; i < 16; ++i) o[m][dh][i] = 0.f;
  float ls[2] = {0.f, 0.f};
  constexpr int VSTR = 272, KBYTES = 128 * LDS_STRIDE, STG = KBYTES + 64 * VSTR;
  const int krow = tid >> 3, kch = tid & 7;
  const int vrow = tid >> 4, vch = tid & 15;
  const bf16_t* kg = p.P + 256 + h * 64 + kch * 8;
  const bf16_t* vg = p.VtA + ((size_t)((b * 4 + h) * 64 + vrow)) * UA + vch * 8;
  u32x4 rk0, rk1, rv0, rv1;
  rk0 = *(const u32x4*)(kg + (size_t)rowOfU(b, ubeg + krow) * NP);
  rk1 = *(const u32x4*)(kg + (size_t)rowOfU(b, ubeg + krow + 64) * NP);
  rv0 = *(const u32x4*)(vg + ubeg);
  rv1 = *(const u32x4*)(vg + (size_t)32 * UA + ubeg);
  __syncthreads();
  asm volatile("" :: "v"(qf[0][0]), "v"(qf[0][1]), "v"(qf[1][0]), "v"(qf[1][1]));
  {
    unsigned char* Ks = smem; unsigned char* Vs = smem + KBYTES;
    *(u32x4*)(Ks + krow * LDS_STRIDE + kch * 16) = rk0; *(u32x4*)(Ks + (krow + 64) * LDS_STRIDE + kch * 16) = rk1;
    *(u32x4*)(Vs + vrow * VSTR + vch * 16) = rv0; *(u32x4*)(Vs + (vrow + 32) * VSTR + vch * 16) = rv1;
  }
  __syncthreads();
  int buf = 0;
  for (int u0 = ubeg; u0 < uend; u0 += 128) {
    const int un = u0 + 128 < uend ? u0 + 128 : ubeg;
    rk0 = *(const u32x4*)(kg + (size_t)rowOfU(b, un + krow) * NP);
    rk1 = *(const u32x4*)(kg + (size_t)rowOfU(b, un + krow + 64) * NP);
    rv0 = *(const u32x4*)(vg + un);
    rv1 = *(const u32x4*)(vg + (size_t)32 * UA + un);
    const unsigned char* Ks = smem + buf * STG;
    const unsigned char* Vs = Ks + KBYTES;
    f32x16 sc[2], sn[2];
#define A_QK(SUB, DST) do { _Pragma("unroll") for (int m = 0; m < 2; ++m) { \
      const unsigned char* kr = Ks + (32 * (SUB) + pr) * LDS_STRIDE + (m * 32 + 8 * hh) * 2; \
      const bf16x8 kf0 = *(const bf16x8*)kr, kf1 = *(const bf16x8*)(kr + 32); \
      f32x16 t_; _Pragma("unroll") for (int i = 0; i < 16; ++i) t_[i] = negM2; \
      t_ = MFMA32(kf0, qf[m][0], t_); DST[m] = MFMA32(kf1, qf[m][1], t_); } } while (0)
    A_QK(0, sc);
#pragma unroll
    for (int sub = 0; sub < 4; ++sub) {
      if (sub < 3) A_QK(sub + 1, sn);
      bf16x8 vf[2][2];
#pragma unroll
      for (int dh = 0; dh < 2; ++dh)
#pragma unroll
        for (int s2 = 0; s2 < 2; ++s2) vf[dh][s2] = *(const bf16x8*)(Vs + (32 * dh + qi) * VSTR + (32 * sub + 16 * s2 + 8 * hh) * 2);
#pragma unroll
      for (int m = 0; m < 2; ++m) {
        float pe[16];
#pragma unroll
        for (int i = 0; i < 16; ++i) pe[i] = fexp2(sc[m][i]);
        sum16_nopk(ls[m], pe);
#pragma unroll
        for (int s2 = 0; s2 < 2; ++s2) {
          u32x4 pw;
#pragma unroll
          for (int q = 0; q < 4; ++q) pw[q] = pk2(pe[8 * s2 + 2 * q], pe[8 * s2 + 2 * q + 1]);
          const bf16x8 pf = __builtin_bit_cast(bf16x8, pw);
#pragma unroll
          for (int dh = 0; dh < 2; ++dh) o[m][dh] = MFMA32(vf[dh][s2], pf, o[m][dh]);
        }
      }
      if (sub < 3) { sc[0] = sn[0]; sc[1] = sn[1]; }
    }
    {
      unsigned char* Kw = smem + (buf ^ 1) * STG; unsigned char* Vw = Kw + KBYTES;
      *(u32x4*)(Kw + krow * LDS_STRIDE + kch * 16) = rk0; *(u32x4*)(Kw + (krow + 64) * LDS_STRIDE + kch * 16) = rk1;
      *(u32x4*)(Vw + vrow * VSTR + vch * 16) = rv0; *(u32x4*)(Vw + (vrow + 32) * VSTR + vch * 16) = rv1;
    }
    __syncthreads();
    buf ^= 1;
  }
  const float l0 = ls[0] + __shfl_xor(ls[0], 32), l1 = ls[1] + __shfl_xor(ls[1], 32);
  const float i0 = 1.f / l0, c1 = lam / l1;
  float ss = 0.f;
#pragma unroll
  for (int dh = 0; dh < 2; ++dh)
#pragma unroll
    for (int i = 0; i < 16; ++i) { const float v = o[0][dh][i] * i0 - o[1][dh][i] * c1; o[0][dh][i] = v; ss += v * v; }
  ss += __shfl_xor(ss, 32);
  const float r = rsqrtf(ss * (1.f / 64.f) + EPS) * (1.f - lam_init);
  bf16_t* op = p.MO + (size_t)(qrow0 + qi) * DM + h * 64;
  const float* sg = p.da_sub_gain + layer * 64;
#pragma unroll
  for (int dh = 0; dh < 2; ++dh)
#pragma unroll
    for (int g = 0; g < 4; ++g) {
      const int dv = 32 * dh + 8 * g + 4 * hh;
      const f32x4 g4 = *(const f32x4*)(sg + dv);
      u32x2 w;
      w[0] = pk2(o[0][dh][4 * g] * r * g4[0], o[0][dh][4 * g + 1] * r * g4[1]);
      w[1] = pk2(o[0][dh][4 * g + 2] * r * g4[2], o[0][dh][4 * g + 3] * r * g4[3]);
      *(u32x2*)(op + dv) = w;
    }
}

struct Frag64 { u32x4 k[4]; u32x4 v[4]; };
constexpr int W64_KB = 32 * LDS_STRIDE, W64_VSTR = 80, W64_BYTES = W64_KB + 64 * W64_VSTR;
DI void frag64_load(Frag64& f, const bf16_t* P, const bf16_t* vt, int b, int u, int kcol, int lane) {
#pragma unroll
  for (int i = 0; i < 4; ++i) {
    f.k[i] = *(const u32x4*)(P + (size_t)rowOfU(b, u + (lane >> 3) + 8 * i) * NP + kcol + (lane & 7) * 8);
    f.v[i] = *(const u32x4*)(vt + (size_t)((lane >> 2) + 16 * i) * UA + u + (lane & 3) * 8);
  }
}

template <int MODE>
DI void attn64_wave(const Params& p, int layer, int b, int hq, int qrow0, int t0, const float* rpb_lds, unsigned char* wlds) {
  constexpr bool isC = (MODE == 0 || MODE == 2);
  const int lane = ltid() & 63, qi = lane & 31, hh = lane >> 5;
  const int pr = (qi & 19) | ((qi & 4) << 1) | ((qi & 8) >> 1);
  const float* gqp = (isC ? p.na_q_gain : p.sw_q_gain) + layer * 64;
  const float* gkp = (isC ? p.na_k_gain : p.sw_k_gain) + layer * 64;
  const float gq = wave_max(fabsf(gqp[lane])), gk = wave_max(fabsf(gkp[lane]));
  const float negM2 = -(0.125f * LOG2E * 64.f * 1.02f) * gq * gk;
  const int kvh = isC ? hq : (hq >> 1);
  const int qcol = isC ? 2048 + 64 * hq : 2816 + 64 * hq;
  const int kcol = isC ? 2304 + 64 * hq : 3072 + 64 * kvh;
  const bf16_t* vt = isC ? p.VtC + (size_t)(b * 4 + hq) * 64 * UA : p.VtD + (size_t)(b * 2 + kvh) * 64 * UA;
  const bf16_t* qp = p.P + (size_t)(qrow0 + qi) * NP + qcol + 8 * hh;
  bf16x8 qf[4];
#pragma unroll
  for (int ks = 0; ks < 4; ++ks) qf[ks] = *(const bf16x8*)(qp + ks * 16);
  f32x16 o[2];
#pragma unroll
  for (int dh = 0; dh < 2; ++dh)
#pragma unroll
    for (int i = 0; i < 16; ++i) o[dh][i] = 0.f;
  float ls = 0.f;
  constexpr int NT = MODE == 0 ? 24 : (MODE == 1 ? 18 : 8);
  const int r = t0 >> 6, c = (t0 & 63) + qi;
  const int rs = min(max(r - 4, 0), 248), ws = min(max(c - 8, 0), 48);
  const float* rpb = rpb_lds + hq * 465;
  const int qt = t0 + qi;
  auto tile_u = [&](int t) -> int {
    if (t < 8) return 32 * t;
    if (MODE == 0) return CTX + (rs + ((t - 8) >> 1)) * 64 + ((t - 8) & 1) * 32;
    const int kt0 = t0 - 128 + 32 * (t - 8);
    return CTX + min(max(kt0, 0), SEQ - 32);
  };
  auto load_tile = [&](Frag64& f, int t) { frag64_load(f, p.P, vt, b, tile_u(t), kcol, lane); };
  unsigned char* Kw = wlds; unsigned char* Vw = wlds + W64_KB;
  auto compute_tile = [&](const Frag64& f, int t) {
#pragma unroll
    for (int i = 0; i < 4; ++i) {
      *(u32x4*)(Kw + ((lane >> 3) + 8 * i) * LDS_STRIDE + (lane & 7) * 16) = f.k[i];
      *(u32x4*)(Vw + ((lane >> 2) + 16 * i) * W64_VSTR + (lane & 3) * 16) = f.v[i];
    }
    bf16x8 kf[4], vf[2][2];
#pragma unroll
    for (int ks = 0; ks < 4; ++ks) kf[ks] = __builtin_bit_cast(bf16x8, *(const u32x4*)(Kw + pr * LDS_STRIDE + (16 * ks + 8 * hh) * 2));
#pragma unroll
    for (int dh = 0; dh < 2; ++dh)
#pragma unroll
      for (int s2 = 0; s2 < 2; ++s2) vf[dh][s2] = __builtin_bit_cast(bf16x8, *(const u32x4*)(Vw + (32 * dh + qi) * W64_VSTR + (16 * s2 + 8 * hh) * 2));
    f32x16 s;
#pragma unroll
    for (int i = 0; i < 16; ++i) s[i] = negM2;
#pragma unroll
    for (int ks = 0; ks < 4; ++ks) s = MFMA32(kf[ks], qf[ks], s);
    float pe[16];
    if (t < 8) {
#pragma unroll
      for (int i = 0; i < 16; ++i) pe[i] = fexp2(s[i]);
    } else if (MODE == 0) {
      const int kr = rs + ((t - 8) >> 1), hf = (t - 8) & 1;
      const float* rrow = rpb + (kr - r + 7) * 31 + 15 - c;
#pragma unroll
      for (int i = 0; i < 16; ++i) {
        const int kc = hf * 32 + 16 * (i >> 3) + 8 * hh + (i & 7);
        const bool valid = (kc >= ws) && (kc < ws + 16);
        const int kcc = min(max(kc, ws), ws + 15);
        pe[i] = fexp2(valid ? s[i] + rrow[kcc] : -1e30f);
      }
    } else {
      const int jt = t - 8, kt0 = t0 - 128 + 32 * jt;
      const bool tile_ok = (jt < 9) && (kt0 >= 0) && (kt0 < SEQ);
#pragma unroll
      for (int i = 0; i < 16; ++i) {
        const int dd = kt0 + 16 * (i >> 3) + 8 * hh + (i & 7) - qt;
        pe[i] = fexp2((tile_ok && dd <= 128 && dd >= -128) ? s[i] : -1e30f);
      }
    }
    sum16_nopk(ls, pe);
#pragma unroll
    for (int s2 = 0; s2 < 2; ++s2) {
      u32x4 pw;
#pragma unroll
      for (int q = 0; q < 4; ++q) pw[q] = pk2(pe[8 * s2 + 2 * q], pe[8 * s2 + 2 * q + 1]);
      const bf16x8 pf = __builtin_bit_cast(bf16x8, pw);
#pragma unroll
      for (int dh = 0; dh < 2; ++dh) o[dh] = MFMA32(vf[dh][s2], pf, o[dh]);
    }
  };
  Frag64 fa, fb;
  load_tile(fa, 0);
#pragma unroll 1
  for (int t = 0; t < NT; t += 2) {
    load_tile(fb, t + 1);
    compute_tile(fa, t);
    load_tile(fa, t + 2 < NT ? t + 2 : 0);
    compute_tile(fb, t + 1);
  }
  float l = ls + __shfl_xor(ls, 32);
  if (!isC) l += fexp2(p.sw_sink[layer * 4 + hq] * LOG2E + negM2);
  const float il = 1.f / l;
  bf16_t* op = p.MO + (size_t)(qrow0 + qi) * DM + (isC ? 512 : 768) + hq * 64;
#pragma unroll
  for (int dh = 0; dh < 2; ++dh)
#pragma unroll
    for (int g = 0; g < 4; ++g) {
      const int dv = 32 * dh + 8 * g + 4 * hh;
      u32x2 w;
      w[0] = pk2(o[dh][4 * g] * il, o[dh][4 * g + 1] * il);
      w[1] = pk2(o[dh][4 * g + 2] * il, o[dh][4 * g + 3] * il);
      *(u32x2*)(op + dv) = w;
    }
}

DI void mix_phase(const Params& p, int layer, unsigned char* smem, unsigned char* smem_all, int bid, int nb, int rrank) {
  const int wave = ltid() >> 6;
  const int n_scan = 256, n_lat = 1024, n_ctx = layer == 0 ? 16 : 0;
  const int e0 = n_scan, e1 = e0 + n_lat, e2 = e1 + n_ctx, e3 = e2 + n_lat, e4 = e3 + n_lat, e5 = e4 + n_ctx, e6 = e5 + n_ctx;
  {
    const int rnb_ = nb >> 1, per_r = (rnb_ >> 3) > 0 ? (rnb_ >> 3) : 1;
    const int bh = rrank / per_r, jj = rrank - bh * per_r;
    if (bh < 8)
      for (int qb = jj; qb < 64; qb += per_r) attnA_block(p, layer, smem_all, bh >> 2, bh & 3, (bh >> 2) * SEQ + qb * 256, 0, UA);
    if (layer == 0)
      for (int j = rrank; j < 8; j += rnb_) attnA_block(p, layer, smem_all, j >> 2, j & 3, TL + (j >> 2) * CTX, 0, CTX);
    __syncthreads();
  }
  float* rpb_lds = (float*)smem;
  for (int i = ltid(); i < 4 * 465; i += 256) rpb_lds[i] = p.na_rpb[layer * 4 * 465 + i] * LOG2E;
  __syncthreads();
  for (int it = 2 * rrank + (bid & 1); it < e6; it += nb) {
    if (it < e0) scan_item(p, it);
    else if (it < e1) {
    } else if (it < e2) {
    } else if (it < e3) {
      const int j = it - e2, qb = j & 127, hq = (j >> 7) & 3, b = j >> 9;
      const int t0 = qb * 128 + wave * 32;
      attn64_wave<1>(p, layer, b, hq, b * SEQ + t0, t0, rpb_lds, smem + 8192 + wave * W64_BYTES);
    } else if (it < e4) {
      const int j = it - e3, qb = j & 127, hq = (j >> 7) & 3, b = j >> 9;
      const int t0 = qb * 128 + wave * 32;
      attn64_wave<0>(p, layer, b, hq, b * SEQ + t0, t0, rpb_lds, smem + 8192 + wave * W64_BYTES);
    } else if (it < e5) {
      const int j = it - e4, qb = j & 1, hq = (j >> 1) & 3, b = j >> 3;
      attn64_wave<3>(p, layer, b, hq, TL + b * CTX + qb * 128 + wave * 32, 0, rpb_lds, smem + 8192 + wave * W64_BYTES);
    } else {
      const int j = it - e5, qb = j & 1, hq = (j >> 1) & 3, b = j >> 3;
      attn64_wave<2>(p, layer, b, hq, TL + b * CTX + qb * 128 + wave * 32, 0, rpb_lds, smem + 8192 + wave * W64_BYTES);
    }
  }
}

template <int D>
DI void hgrn_dir(const Params& p, int layer, unsigned char* smem, int b, int hh, int n, float (&o)[16]) {
  const int tid = ltid();
  const int chain = (b * 4 + hh) * 2 + D;
  float* cumT = (float*)smem;
  float* qT = cumT + 64 * 68;
  float* kT = qT + 64 * 68;
  float* vv = kT + 64 * 68;
  float* psum = vv + 64 * 64;
  float kreg[16], qreg[16];
  {
    const int pp = tid >> 2, kq = (tid & 3) * 16;
    const int row = hg_row(b, D, n, pp);
    const bf16_t* pr = p.P + (size_t)row * NP;
    const bf16_t* qp = pr + 768 + hh * 64 + kq;
    const bf16_t* fp = pr + 1536 + D * 256 + hh * 64 + kq;
    const bf16_t* vp = pr + 1024 + hh * 64 + kq;
    const u32x4 q0 = *(const u32x4*)qp, q1 = *(const u32x4*)(qp + 8), f0 = *(const u32x4*)fp, f1 = *(const u32x4*)(fp + 8),
                v0 = *(const u32x4*)vp, v1 = *(const u32x4*)(vp + 8);
    float qx[16], fx[16], vx[16];
#pragma unroll
    for (int q = 0; q < 4; ++q) {
      qx[2 * q] = bf_lo(q0[q]); qx[2 * q + 1] = bf_hi(q0[q]); qx[8 + 2 * q] = bf_lo(q1[q]); qx[8 + 2 * q + 1] = bf_hi(q1[q]);
      fx[2 * q] = bf_lo(f0[q]); fx[2 * q + 1] = bf_hi(f0[q]); fx[8 + 2 * q] = bf_lo(f1[q]); fx[8 + 2 * q + 1] = bf_hi(f1[q]);
      vx[2 * q] = bf_lo(v0[q]); vx[2 * q + 1] = bf_hi(v0[q]); vx[8 + 2 * q] = bf_lo(v1[q]); vx[8 + 2 * q + 1] = bf_hi(v1[q]);
    }
#pragma unroll
    for (int j = 0; j < 16; ++j) {
      const float lb = hg_lb(p, layer, D, hh * 64 + kq + j);
      const float sg = 1.f / (1.f + expf(-fx[j]));
      const float f = lb + (1.f - lb) * sg;
      cumT[(kq + j) * 68 + pp] = logf(f) * LOG2E;
      qT[(kq + j) * 68 + pp] = qx[j];
      qreg[j] = qx[j];
      kreg[j] = 1.f - f;
      vv[pp * 64 + kq + j] = vx[j];
    }
    const float* Sg = p.HL + ((size_t)(chain * NCHUNK + n)) * 4096 + tid * 16;
#pragma unroll
    for (int i = 0; i < 4; ++i) *(f32x4*)(kT + tid * 16 + 4 * i) = *(const f32x4*)(Sg + 4 * i);
  }
  __syncthreads();
  {
    float c[16];
    prefix64(cumT, psum, tid, c);
    float* qrow = qT + (tid & 63) * 68 + 16 * (tid >> 6);
#pragma unroll
    for (int i4 = 0; i4 < 4; ++i4) {
      f32x4 t = *(const f32x4*)(qrow + 4 * i4);
#pragma unroll
      for (int a = 0; a < 4; ++a) t[a] *= fexp2(c[4 * i4 + a]);
      *(f32x4*)(qrow + 4 * i4) = t;
    }
  }
  __syncthreads();
  const int tg = tid >> 6, v = tid & 63, tgp = D ? 3 - tg : tg;
  {
#pragma unroll 2
    for (int k = 0; k < 64; ++k) {
      const float Sv = kT[k * 64 + v];
#pragma unroll
      for (int j4 = 0; j4 < 4; ++j4) {
        const f32x4 q4 = *(const f32x4*)(qT + k * 68 + 16 * tgp + 4 * j4);
#pragma unroll
        for (int a = 0; a < 4; ++a) { const int j = 4 * j4 + a; o[D ? 15 - j : j] += q4[a] * Sv; }
      }
    }
  }
  __syncthreads();
  {
    const int pp = tid >> 2, kq = (tid & 3) * 16;
#pragma unroll
    for (int j = 0; j < 16; ++j) { kT[(kq + j) * 68 + pp] = kreg[j]; qT[(kq + j) * 68 + pp] = qreg[j]; }
  }
  __syncthreads();
  const int bt = tid >> 4, bs = tid & 15;
  float sc[4][4];
#pragma unroll
  for (int a = 0; a < 4; ++a)
#pragma unroll
    for (int c = 0; c < 4; ++c) sc[a][c] = 0.f;
  if (bs <= bt) {
    for (int k = 0; k < 64; ++k) {
      const f32x4 ct = *(const f32x4*)(cumT + k * 68 + 4 * bt), qt = *(const f32x4*)(qT + k * 68 + 4 * bt);
      const f32x4 cs = *(const f32x4*)(cumT + k * 68 + 4 * bs), ks = *(const f32x4*)(kT + k * 68 + 4 * bs);
      const float ref = ct[0];
      float et[4], es[4];
#pragma unroll
      for (int a = 0; a < 4; ++a) { et[a] = qt[a] * fexp2(ct[a] - ref); es[a] = ks[a] * fexp2(ref - cs[a]); }
#pragma unroll
      for (int a = 0; a < 4; ++a)
#pragma unroll
        for (int c = 0; c < 4; ++c) sc[a][c] += et[a] * es[c];
    }
  }
  __syncthreads();
#pragma unroll
  for (int a = 0; a < 4; ++a) {
    f32x4 w;
#pragma unroll
    for (int c = 0; c < 4; ++c) w[c] = (bs <= bt && (4 * bs + c) <= (4 * bt + a)) ? sc[a][c] : 0.f;
    *(f32x4*)(kT + (4 * bt + a) * 68 + 4 * bs) = w;
  }
  __syncthreads();
  {
    const int send = 4 * (tgp + 1);
    for (int s4 = 0; s4 < send; ++s4) {
      float vq[4];
#pragma unroll
      for (int c = 0; c < 4; ++c) vq[c] = vv[(4 * s4 + c) * 64 + v];
#pragma unroll
      for (int j = 0; j < 16; ++j) {
        const f32x4 w = *(const f32x4*)(kT + (16 * tgp + j) * 68 + 4 * s4);
        o[D ? 15 - j : j] += w[0] * vq[0] + w[1] * vq[1] + w[2] * vq[2] + w[3] * vq[3];
      }
    }
  }
  __syncthreads();
}

DI void hgout_phase(const Params& p, int layer, unsigned char* smem, int bid, int nb) {
  const int tid = ltid();
  const int n_lat = 2 * 4 * 256, n_ctx = layer == 0 ? 2 * 4 * 4 : 0;
  for (int it = bid; it < n_lat + n_ctx; it += nb) {
    int b, hh, n0, n1, rowbase;
    if (it < n_lat) { const int m = it & 255; hh = (it >> 8) & 3; b = it >> 10; n0 = 4 + m; n1 = 4 + 255 - m; rowbase = b * SEQ + 64 * m; }
    else { const int j = it - n_lat, mc = j & 3; hh = (j >> 2) & 3; b = j >> 4; n0 = mc; n1 = 3 - mc; rowbase = TL + b * CTX + 64 * mc; }
    float o[16];
#pragma unroll
    for (int j = 0; j < 16; ++j) o[j] = 0.f;
    hgrn_dir<0>(p, layer, smem, b, hh, n0, o);
    hgrn_dir<1>(p, layer, smem, b, hh, n1, o);
    const int tg = tid >> 6, v = tid & 63;
    const float og = p.hg_out_gain[layer * 64 + v];
#pragma unroll
    for (int j = 0; j < 16; ++j) {
      const int row = rowbase + 16 * tg + j;
      const float ss = wave_sum(o[j] * o[j]);
      const float r = rsqrtf(ss * (1.f / 64.f) + EPS);
      const unsigned short gb = p.P[(size_t)row * NP + 1280 + hh * 64 + v];
      const float gx = __uint_as_float(((unsigned)gb) << 16);
      const float y = o[j] * r * og * (gx / (1.f + expf(-gx)));
      p.MO[(size_t)row * DM + 256 + hh * 64 + v] = tobf(y);
    }
  }
}

#if MULTI_LAUNCH
#define SYNC_OR_RETURN(ph) do { if (phase_sel == (ph)) return; } while (0)
#define RUN(ph) (phase_sel == (ph))
#else
#define RUN(ph) (true)
#endif

__global__ void __launch_bounds__(512) fwd_kernel(Params p, int phase_sel) {
  __shared__ __attribute__((aligned(16))) unsigned char smem_all[2 * SMEM_BYTES];
  const int rbid = blockIdx.x, rnb = gridDim.x;
  const int vb = __builtin_amdgcn_readfirstlane((int)(threadIdx.x >> 8));
  const int bid = rbid * 2 + vb, nb = rnb * 2;
  unsigned char* smem = smem_all + vb * SMEM_BYTES;
#if !MULTI_LAUNCH
  cg::grid_group grid = cg::this_grid();
#define GSYNC() grid.sync()
#else
#define GSYNC() do {} while (0)
#endif
  __shared__ int s_rank[2];
  if (threadIdx.x == 0) { const unsigned x = xcc_id(); s_rank[0] = (int)x; s_rank[1] = (int)atomicAdd(&p.xcnt[x], 1u); }
  int ph = 0;
  if (RUN(ph)) phase0(p, smem, bid, nb);
  GSYNC(); ++ph;
  if (threadIdx.x == 0) {
    int r = s_rank[1];
    for (int y = 0; y < s_rank[0]; ++y) r += (int)__hip_atomic_load(&p.xcnt[y], __ATOMIC_RELAXED, __HIP_MEMORY_SCOPE_AGENT);
    s_rank[0] = r;
  }
  __syncthreads();
  const int rrank = __builtin_amdgcn_readfirstlane(s_rank[0]);
  for (int layer = 0; layer < 2; ++layer) {
    const float* modl = p.mod + layer * 3 * 6144;
    const float* rl = layer == 0 ? p.x : p.out;
    const float* rc = layer == 0 ? p.ctx : p.Xc;
    if (RUN(ph)) norm_phase(rl, rc, TA, p.norm1_g + layer * DM, modl, 0, 1024, p.H, bid, nb);
    GSYNC(); ++ph;
    if (RUN(ph)) { EpiBf16 e{p.P, NP}; gemm_phase512(p.H, p.WinT + (size_t)layer * NP * 1024, TA / 256, NP / 256, 1024, 1024, 1, e, smem_all, rrank, rnb); }
    GSYNC(); ++ph;
    if (RUN(ph)) prep_phase(p, layer, smem, bid, nb);
    GSYNC(); ++ph;
    if (RUN(ph)) mix_phase(p, layer, smem, smem_all, bid, nb, rrank);
    GSYNC(); ++ph;
    if (RUN(ph)) hgout_phase(p, layer, smem, bid, nb);
    GSYNC(); ++ph;
    const int mrows = layer == 0 ? TA : TL;
    if (RUN(ph)) { EpiResid e{rl, rc, p.out, p.Xc, modl + 2048, 0}; gemm_phase512(p.MO, p.WoutT + (size_t)layer * 1024 * 1024, mrows / 256, 4, 1024, 1024, 1, e, smem_all, rrank, rnb); }
    GSYNC(); ++ph;
    if (RUN(ph)) norm_phase(p.out, p.Xc, mrows, p.norm2_g + layer * DM, modl, 3072, 4096, p.H, bid, nb);
    GSYNC(); ++ph;
    const int nchunks = layer == 0 ? 3 : 2;
    for (int ch = 0; ch < nchunks; ++ch) {
      const int row0 = ch * 16384, rows = ch < 2 ? 16384 : TC;
      if (RUN(ph)) { EpiRelu2 e{p.P, DFF}; gemm_phase512(p.H + (size_t)row0 * DM, p.W1T + (size_t)layer * DFF * 1024, rows / 256, DFF / 256, 1024, 1024, 1, e, smem_all, rrank, rnb); }
      GSYNC(); ++ph;
      if (RUN(ph)) {
        if (ch < 2) { EpiResid e{p.out, p.Xc, p.out, p.Xc, modl + 5 * 1024, row0}; gemm_phase512(p.P, p.W2T + (size_t)layer * 1024 * DFF, rows / 256, 4, DFF, DFF, 1, e, smem_all, rrank, rnb); }
        else { EpiResidAtomic e{p.out, p.Xc, modl + 5 * 1024, row0}; gemm_phase512(p.P, p.W2T + (size_t)layer * 1024 * DFF, rows / 256, 4, DFF, 256, 16, e, smem_all, rrank, rnb); }
      }
      GSYNC(); ++ph;
    }
  }
}

static size_t align_up(size_t v) { return (v + 255) & ~(size_t)255; }

extern "C" void kernel_launch(void* const* d_in, const int* in_sizes, int n_in, void* d_out, int out_size, void* d_ws, size_t ws_size,
                              hipStream_t stream) {
  Params p{};
  const float** f = (const float**)&p;
  for (int i = 0; i < 24; ++i) f[i] = (const float*)d_in[i];
  p.out = (float*)d_out;
  unsigned char* w = (unsigned char*)d_ws; size_t off = 0;
  auto take = [&](size_t bytes) { void* r = w + off; off = align_up(off + bytes); return r; };
  p.Xc = (float*)take((size_t)TC * DM * 4);
  p.mod = (float*)take((size_t)2 * 3 * 6144 * 4);
  p.Hdec = (float*)take((size_t)16 * NCHUNK * 64 * 4);
  p.WinT = (bf16_t*)take((size_t)2 * NP * 1024 * 2);
  p.WoutT = (bf16_t*)take((size_t)2 * 1024 * 1024 * 2);
  p.W1T = (bf16_t*)take((size_t)2 * DFF * 1024 * 2);
  p.W2T = (bf16_t*)take((size_t)2 * DFF * 1024 * 2);
  p.H = (bf16_t*)take((size_t)TA * DM * 2);
  p.HL = (float*)p.H;
  p.P = (bf16_t*)take((size_t)TA * NP * 2);
  p.MO = (bf16_t*)take((size_t)TA * DM * 2);
  p.VtA = (bf16_t*)take((size_t)2 * 4 * 64 * UA * 2);
  p.VtC = (bf16_t*)take((size_t)2 * 4 * 64 * UA * 2);
  p.VtD = (bf16_t*)take((size_t)2 * 2 * 64 * UA * 2);
  p.xcnt = (unsigned*)take(256);
  if (off > ws_size) { fprintf(stderr, "workspace too small: need %zu have %zu\n", off, ws_size); return; }
#if MULTI_LAUNCH
  const int nphase = 1 + 7 + 6 + 7 + 4;
  for (int ph = 0; ph < nphase; ++ph) hipLaunchKernelGGL(fwd_kernel, dim3(256), dim3(512), 0, stream, p, ph);
#else
  static int grid_blocks = 0;
  int phase_sel = -1;
  void* args[] = {&p, &phase_sel};
  if (!grid_blocks) {
    int dev = 0, cus = 0, per_cu = 0;
    (void)hipGetDevice(&dev);
    (void)hipDeviceGetAttribute(&cus, hipDeviceAttributeMultiprocessorCount, dev);
    (void)hipOccupancyMaxActiveBlocksPerMultiprocessor(&per_cu, fwd_kernel, 512, 0);
    if (per_cu < 1) per_cu = 1;
    grid_blocks = cus;
  }
  (void)hipMemsetAsync(p.xcnt, 0, 256, stream);
  hipError_t e = hipLaunchCooperativeKernel((void*)fwd_kernel, dim3(grid_blocks), dim3(512), args, 0, stream);
  if (e != hipSuccess) fprintf(stderr, "cooperative launch failed: %s (grid %d)\n", hipGetErrorString(e), grid_blocks);
#endif
}
```

```cpp
#include <hip/hip_runtime.h>
#include <hip/hip_cooperative_groups.h>
#include <cstdio>
#include <cstdint>
namespace cg = cooperative_groups;

#ifndef MULTI_LAUNCH
#define MULTI_LAUNCH 0
#endif

#define DI __device__ __forceinline__
typedef unsigned short bf16_t;
typedef short bf16x8 __attribute__((ext_vector_type(8)));
typedef float f32x16 __attribute__((ext_vector_type(16)));
typedef float f32x4 __attribute__((ext_vector_type(4)));
typedef float f32x2 __attribute__((ext_vector_type(2)));
typedef unsigned u32x4 __attribute__((ext_vector_type(4)));
typedef unsigned u32x2 __attribute__((ext_vector_type(2)));
typedef __bf16 bf16x2_t __attribute__((ext_vector_type(2)));

constexpr int SEQ = 16384, CTX = 256, DM = 1024, TL = 32768, TC = 512, TA = 33280, NP = 3328, DFF = 4096, UA = 16640;
constexpr int NCHUNK = 260;
constexpr float EPS = 1e-6f, LOG2E = 1.4426950408889634f;
constexpr int SMEM_BYTES = 73728;
constexpr int LDS_STRIDE = 144;

#define MFMA32(a, b, c) __builtin_amdgcn_mfma_f32_32x32x16_bf16((a), (b), (c), 0, 0, 0)

DI unsigned pk2(float a, float b) { f32x2 v = {a, b}; return __builtin_bit_cast(unsigned, __builtin_convertvector(v, bf16x2_t)); }
DI float bf_lo(unsigned u) { return __uint_as_float(u << 16); }
DI float bf_hi(unsigned u) { return __uint_as_float(u & 0xffff0000u); }
DI bf16_t tobf(float a) { return (bf16_t)(pk2(a, 0.f) & 0xffffu); }
DI float fexp2(float x) { return __builtin_amdgcn_exp2f(x); }
DI void sum16_nopk(float& acc, const float (&pe)[16]) {
  asm volatile("s_nop 0\n\tv_add_f32 %0, %1, %0\n\tv_add_f32 %0, %2, %0\n\tv_add_f32 %0, %3, %0\n\tv_add_f32 %0, %4, %0\n\t"
               "v_add_f32 %0, %5, %0\n\tv_add_f32 %0, %6, %0\n\tv_add_f32 %0, %7, %0\n\tv_add_f32 %0, %8, %0\n\t"
               "v_add_f32 %0, %9, %0\n\tv_add_f32 %0, %10, %0\n\tv_add_f32 %0, %11, %0\n\tv_add_f32 %0, %12, %0\n\t"
               "v_add_f32 %0, %13, %0\n\tv_add_f32 %0, %14, %0\n\tv_add_f32 %0, %15, %0\n\tv_add_f32 %0, %16, %0"
               : "+v"(acc)
               : "v"(pe[0]), "v"(pe[1]), "v"(pe[2]), "v"(pe[3]), "v"(pe[4]), "v"(pe[5]), "v"(pe[6]), "v"(pe[7]),
                 "v"(pe[8]), "v"(pe[9]), "v"(pe[10]), "v"(pe[11]), "v"(pe[12]), "v"(pe[13]), "v"(pe[14]), "v"(pe[15]));
}
DI float wave_sum(float v) {
#pragma unroll
  for (int o = 32; o > 0; o >>= 1) v += __shfl_xor(v, o);
  return v;
}
DI float wave_max(float v) {
#pragma unroll
  for (int o = 32; o > 0; o >>= 1) v = fmaxf(v, __shfl_xor(v, o));
  return v;
}
DI int ltid() { int t = threadIdx.x & 255; asm volatile("" : "+v"(t)); return t; }
DI int ltid512() { int t = threadIdx.x; asm volatile("" : "+v"(t)); return t; }
DI unsigned xcc_id() { return (unsigned)__builtin_amdgcn_s_getreg((3 << 11) | 20) & 0xFu; }
DI int rowOfU(int b, int u) { return u < CTX ? TL + b * CTX + u : b * SEQ + (u - CTX); }

struct Params {
  const float *x, *c, *ctx, *c_ctx, *w_mod, *b_mod, *norm1_g, *norm2_g, *w_in, *w_out;
  const float *da_q_gain, *da_k_gain, *da_lambda, *da_sub_gain, *hg_lb_logits, *hg_out_gain;
  const float *na_q_gain, *na_k_gain, *na_rpb, *sw_q_gain, *sw_k_gain, *sw_sink, *w_ff1, *w_ff2;
  float* out;
  float* Xc;
  float* mod;
  float* Hdec;
  bf16_t* WinT;
  bf16_t* WoutT;
  bf16_t* W1T;
  bf16_t* W2T;
  bf16_t* H;
  float* HL;
  bf16_t* P;
  bf16_t* MO;
  bf16_t* VtA;
  bf16_t* VtC;
  bf16_t* VtD;
  unsigned* xcnt;
};

DI void phase0(const Params& p, unsigned char* smem, int bid, int nb) {
  const int tid = ltid();
  constexpr int n_mod = 2 * 96;
  constexpr int t_in = 16 * 52, t_out = 16 * 16, t_f1 = 16 * 64, t_f2 = 64 * 16;
  constexpr int per_layer = t_in + t_out + t_f1 + t_f2;
  constexpr int total = n_mod + 2 * per_layer;
  float* fs = (float*)smem;
  for (int it = bid; it < total; it += nb) {
    if (it < n_mod) {
      const int l = it / 96, col0 = (it % 96) * 64;
      float* sc = fs;
      float* red = fs + 3072;
      for (int i = tid; i < 3072; i += 256) {
        const int cond = i >> 10, k = i & 1023;
        const float v = cond == 0 ? p.c[k] : (cond == 1 ? p.c[1024 + k] : p.c_ctx[k]);
        sc[i] = v / (1.f + expf(-v));
      }
      __syncthreads();
      const int kg = tid >> 6, j = tid & 63;
      float a0 = 0.f, a1 = 0.f, a2 = 0.f;
      const float* wp = p.w_mod + ((size_t)l * 1024 + kg * 256) * 6144 + col0 + j;
#pragma unroll 8
      for (int k = 0; k < 256; ++k) {
        const float w = wp[(size_t)k * 6144];
        a0 += sc[kg * 256 + k] * w; a1 += sc[1024 + kg * 256 + k] * w; a2 += sc[2048 + kg * 256 + k] * w;
      }
      red[(kg * 3 + 0) * 64 + j] = a0; red[(kg * 3 + 1) * 64 + j] = a1; red[(kg * 3 + 2) * 64 + j] = a2;
      __syncthreads();
      if (tid < 192) {
        const int cond = tid >> 6, jj = tid & 63;
        float s = p.b_mod[l * 6144 + col0 + jj];
#pragma unroll
        for (int g = 0; g < 4; ++g) s += red[(g * 3 + cond) * 64 + jj];
        p.mod[(l * 3 + cond) * 6144 + col0 + jj] = s;
      }
    } else {
      int idx = it - n_mod;
      const int l = idx / per_layer; idx -= l * per_layer;
      const float* src; bf16_t* dst; int K, N;
      if (idx < t_in) { src = p.w_in + (size_t)l * 1024 * NP; dst = p.WinT + (size_t)l * NP * 1024; K = 1024; N = NP; }
      else if (idx < t_in + t_out) { idx -= t_in; src = p.w_out + (size_t)l * 1024 * 1024; dst = p.WoutT + (size_t)l * 1024 * 1024; K = 1024; N = 1024; }
      else if (idx < t_in + t_out + t_f1) { idx -= t_in + t_out; src = p.w_ff1 + (size_t)l * 1024 * DFF; dst = p.W1T + (size_t)l * DFF * 1024; K = 1024; N = DFF; }
      else { idx -= t_in + t_out + t_f1; src = p.w_ff2 + (size_t)l * DFF * 1024; dst = p.W2T + (size_t)l * 1024 * DFF; K = DFF; N = 1024; }
      const int ntn = N >> 6, kt = idx / ntn, nt = idx % ntn, k0 = kt * 64, n0 = nt * 64;
#pragma unroll
      for (int i = 0; i < 4; ++i) {
        const int r = (tid >> 4) + 16 * i, c4 = (tid & 15) * 4;
        const f32x4 v = *(const f32x4*)(src + (size_t)(k0 + r) * N + n0 + c4);
        fs[r * 65 + c4] = v[0]; fs[r * 65 + c4 + 1] = v[1]; fs[r * 65 + c4 + 2] = v[2]; fs[r * 65 + c4 + 3] = v[3];
      }
      __syncthreads();
      const int n = tid >> 2, kq = (tid & 3) * 16;
      u32x4 w0, w1;
#pragma unroll
      for (int i = 0; i < 4; ++i) {
        w0[i] = pk2(fs[(kq + 2 * i) * 65 + n], fs[(kq + 2 * i + 1) * 65 + n]);
        w1[i] = pk2(fs[(kq + 8 + 2 * i) * 65 + n], fs[(kq + 8 + 2 * i + 1) * 65 + n]);
      }
      bf16_t* dp = dst + (size_t)(n0 + n) * K + k0 + kq;
      *(u32x4*)dp = w0; *(u32x4*)(dp + 8) = w1;
    }
    __syncthreads();
  }
}

DI void norm_phase(const float* lat, const float* ctxp, int nrows, const float* g, const float* modl, int shift_off, int scale_off,
                   bf16_t* H, int bid, int nb) {
  const int wave = ltid() >> 6, lane = ltid() & 63;
  for (int r8 = bid; r8 < nrows / 8; r8 += nb) {
    f32x4 v[2][4]; float ss[2] = {0.f, 0.f};
#pragma unroll
    for (int h = 0; h < 2; ++h) {
      const int row = r8 * 8 + wave + 4 * h;
      const float* src = row < TL ? lat + (size_t)row * DM : ctxp + (size_t)(row - TL) * DM;
#pragma unroll
      for (int i = 0; i < 4; ++i) v[h][i] = *(const f32x4*)(src + lane * 4 + 256 * i);
    }
#pragma unroll
    for (int h = 0; h < 2; ++h) {
#pragma unroll
      for (int i = 0; i < 4; ++i) ss[h] += v[h][i][0] * v[h][i][0] + v[h][i][1] * v[h][i][1] + v[h][i][2] * v[h][i][2] + v[h][i][3] * v[h][i][3];
      ss[h] = wave_sum(ss[h]);
    }
#pragma unroll
    for (int h = 0; h < 2; ++h) {
      const int row = r8 * 8 + wave + 4 * h;
      const int mi = row < TL ? (row >> 14) : 2;
      const float* sh = modl + mi * 6144 + shift_off;
      const float* sc = modl + mi * 6144 + scale_off;
      const float rs = rsqrtf(ss[h] * (1.f / 1024.f) + EPS);
#pragma unroll
      for (int i = 0; i < 4; ++i) {
        const int col = lane * 4 + 256 * i;
        const f32x4 gg = *(const f32x4*)(g + col), s4 = *(const f32x4*)(sc + col), h4 = *(const f32x4*)(sh + col);
        float y[4];
#pragma unroll
        for (int j = 0; j < 4; ++j) y[j] = (v[h][i][j] * rs * gg[j]) * (1.f + s4[j]) + h4[j];
        u32x2 w; w[0] = pk2(y[0], y[1]); w[1] = pk2(y[2], y[3]);
        *(u32x2*)(H + (size_t)row * DM + col) = w;
      }
    }
  }
}

struct EpiBf16 {
  static constexpr bool kBf16 = true;
  DI static float act(float v) { return v; }
  bf16_t* O; int ldc;
  DI void operator()(int m, int n, f32x4 v) const {
    u32x2 w; w[0] = pk2(v[0], v[1]); w[1] = pk2(v[2], v[3]);
    *(u32x2*)(O + (size_t)m * ldc + n) = w;
  }
};
struct EpiRelu2 {
  static constexpr bool kBf16 = true;
  DI static float act(float v) { const float t = fmaxf(v, 0.f); return t * t; }
  bf16_t* O; int ldc;
  DI void operator()(int m, int n, f32x4 v) const {
    float y[4];
#pragma unroll
    for (int j = 0; j < 4; ++j) { const float t = fmaxf(v[j], 0.f); y[j] = t * t; }
    u32x2 w; w[0] = pk2(y[0], y[1]); w[1] = pk2(y[2], y[3]);
    *(u32x2*)(O + (size_t)m * ldc + n) = w;
  }
};
struct EpiResid {
  static constexpr bool kBf16 = false;
  const float* sl; const float* sc; float* dl; float* dc; const float* gate; int row0;
  DI void operator()(int m, int n, f32x4 v) const {
    const int row = m + row0;
    const float* s = row < TL ? sl + (size_t)row * DM : sc + (size_t)(row - TL) * DM;
    float* d = row < TL ? dl + (size_t)row * DM : dc + (size_t)(row - TL) * DM;
    const int mi = row < TL ? (row >> 14) : 2;
    const f32x4 g = *(const f32x4*)(gate + mi * 6144 + n);
    const f32x4 r = *(const f32x4*)(s + n);
    f32x4 o;
#pragma unroll
    for (int j = 0; j < 4; ++j) o[j] = r[j] + g[j] * v[j];
    *(f32x4*)(d + n) = o;
  }
};

template <class Epi>
DI void gemm_phase(const bf16_t* A, const bf16_t* Bt, int mtiles, int ntiles, int K, const Epi& epi, unsigned char* smem, int bid, int nb) {
  const int tid = ltid(), lane = tid & 63, wave = tid >> 6;
  const int wm = wave & 1, wn = wave >> 1, l31 = lane & 31, hh = lane >> 5;
  unsigned char* As0 = smem;
  unsigned char* Bs0 = smem + 2 * 128 * LDS_STRIDE;
  const int nk = K >> 6;
  const int ldrow = tid >> 3, ldcol = (tid & 7) * 8;
  const int total = mtiles * ntiles;
  const int xper = (nb >> 3) > 0 ? (nb >> 3) : 1;
  const int xcd = nb >= 8 ? (bid & 7) : 0, xj = nb >= 8 ? (bid >> 3) : bid, xstep = nb >= 8 ? 8 : 1;
  if (nb >= 8 && bid >= xper * 8) return;
  for (int ch = xcd; ch * xper + xj < total; ch += xstep) {
    const int it = ch * xper + xj;
    const int band = it / (8 * ntiles), rr = it - band * 8 * ntiles;
    const int rib = (mtiles - 8 * band) < 8 ? (mtiles - 8 * band) : 8;
    const int pn = rr / rib, pm = 8 * band + rr % rib;
    const bf16_t* Ap = A + (size_t)(pm * 128 + ldrow) * K + ldcol;
    const bf16_t* Bp = Bt + (size_t)(pn * 128 + ldrow) * K + ldcol;
    f32x16 acc[2][2];
#pragma unroll
    for (int a = 0; a < 2; ++a)
#pragma unroll
      for (int b = 0; b < 2; ++b)
#pragma unroll
        for (int i = 0; i < 16; ++i) acc[a][b][i] = 0.f;
    u32x4 ra0[4], rb0[4], ra1[4], rb1[4];
#define G_LOAD(RA, RB, KT) do { _Pragma("unroll") for (int i = 0; i < 4; ++i) { RA[i] = *(const u32x4*)(Ap + (size_t)i * 32 * K + (KT) * 64); RB[i] = *(const u32x4*)(Bp + (size_t)i * 32 * K + (KT) * 64); } } while (0)
#define G_STORE(RA, RB, BUF) do { unsigned char* Aw = As0 + (BUF) * 128 * LDS_STRIDE; unsigned char* Bw = Bs0 + (BUF) * 128 * LDS_STRIDE; \
      _Pragma("unroll") for (int i = 0; i < 4; ++i) { *(u32x4*)(Aw + (ldrow + 32 * i) * LDS_STRIDE + ldcol * 2) = RA[i]; *(u32x4*)(Bw + (ldrow + 32 * i) * LDS_STRIDE + ldcol * 2) = RB[i]; } } while (0)
#define G_COMPUTE(BUF) do { const unsigned char* As = As0 + (BUF) * 128 * LDS_STRIDE; const unsigned char* Bs = Bs0 + (BUF) * 128 * LDS_STRIDE; \
      _Pragma("unroll") for (int ks = 0; ks < 4; ++ks) { bf16x8 wf[2], af[2]; \
        _Pragma("unroll") for (int i = 0; i < 2; ++i) { \
          wf[i] = *(const bf16x8*)(Bs + (wn * 64 + i * 32 + l31) * LDS_STRIDE + (ks * 16 + 8 * hh) * 2); \
          af[i] = *(const bf16x8*)(As + (wm * 64 + i * 32 + l31) * LDS_STRIDE + (ks * 16 + 8 * hh) * 2); } \
        _Pragma("unroll") for (int ni = 0; ni < 2; ++ni) _Pragma("unroll") for (int mi = 0; mi < 2; ++mi) acc[ni][mi] = MFMA32(wf[ni], af[mi], acc[ni][mi]); } } while (0)
    G_LOAD(ra0, rb0, 0);
    G_LOAD(ra1, rb1, 1);
    G_STORE(ra0, rb0, 0);
    __syncthreads();
#pragma unroll 1
    for (int kt = 0; kt < nk; kt += 2) {
      const int k2 = kt + 2 < nk ? kt + 2 : 0, k3 = kt + 3 < nk ? kt + 3 : 1;
      G_LOAD(ra0, rb0, k2);
      G_COMPUTE(0);
      G_STORE(ra1, rb1, 1);
      __syncthreads();
      G_LOAD(ra1, rb1, k3);
      G_COMPUTE(1);
      G_STORE(ra0, rb0, 0);
      __syncthreads();
    }
#pragma unroll
    for (int ni = 0; ni < 2; ++ni)
#pragma unroll
      for (int mi = 0; mi < 2; ++mi) {
        const int m = pm * 128 + wm * 64 + mi * 32 + l31;
#pragma unroll
        for (int g = 0; g < 4; ++g) {
          const int n = pn * 128 + wn * 64 + ni * 32 + 8 * g + 4 * hh;
          f32x4 v = {acc[ni][mi][4 * g], acc[ni][mi][4 * g + 1], acc[ni][mi][4 * g + 2], acc[ni][mi][4 * g + 3]};
          epi(m, n, v);
        }
      }
  }
}

struct EpiResidAtomic {
  static constexpr bool kBf16 = false;
  float* dl; float* dc; const float* gate; int row0;
  DI void operator()(int m, int n, f32x4 v) const {
    const int row = m + row0;
    float* d = row < TL ? dl + (size_t)row * DM : dc + (size_t)(row - TL) * DM;
    const int mi = row < TL ? (row >> 14) : 2;
    const f32x4 g = *(const f32x4*)(gate + mi * 6144 + n);
#pragma unroll
    for (int j = 0; j < 4; ++j) unsafeAtomicAdd(d + n + j, g[j] * v[j]);
  }
};

template <class Epi>
DI void gemm_phase512(const bf16_t* A, const bf16_t* Bt, int mtiles, int ntiles, int K, int Kper, int ksplit, const Epi& epi,
                      unsigned char* smem, int bid, int nb) {
  const int tid = ltid512(), lane = tid & 63, wave = tid >> 6;
  const int wm = wave & 1, wn = wave >> 1, l31 = lane & 31, hh = lane >> 5;
  constexpr int OPB = 256 * LDS_STRIDE;
  unsigned char* As0 = smem;
  unsigned char* Bs0 = smem + 2 * OPB;
  const int nk = Kper >> 6;
  const int ldrow = tid >> 3, ldcol = (tid & 7) * 8;
  const int ntile = mtiles * ntiles, total = ntile * ksplit;
  for (int it = bid; it < total; it += nb) {
    const int tile = it / ksplit, ks = it - tile * ksplit;
    const int band = tile / (8 * ntiles), rr = tile - band * 8 * ntiles;
    const int rib = (mtiles - 8 * band) < 8 ? (mtiles - 8 * band) : 8;
    const int pn = rr / rib, pm = 8 * band + rr % rib;
    const bf16_t* Ap = A + (size_t)(pm * 256 + ldrow) * K + ks * Kper + ldcol;
    const bf16_t* Bp = Bt + (size_t)(pn * 256 + ldrow) * K + ks * Kper + ldcol;
    f32x16 acc[2][4];
#pragma unroll
    for (int a = 0; a < 2; ++a)
#pragma unroll
      for (int b = 0; b < 4; ++b)
#pragma unroll
        for (int i = 0; i < 16; ++i) acc[a][b][i] = 0.f;
    u32x4 ra[4], rb[4];
#define H_LOAD(KT) do { _Pragma("unroll") for (int i = 0; i < 4; ++i) { ra[i] = *(const u32x4*)(Ap + (size_t)i * 64 * K + (KT) * 64); rb[i] = *(const u32x4*)(Bp + (size_t)i * 64 * K + (KT) * 64); } } while (0)
#define H_STORE(BUF) do { unsigned char* Aw = As0 + (BUF) * OPB; unsigned char* Bw = Bs0 + (BUF) * OPB; \
      _Pragma("unroll") for (int i = 0; i < 4; ++i) { *(u32x4*)(Aw + (ldrow + 64 * i) * LDS_STRIDE + ldcol * 2) = ra[i]; *(u32x4*)(Bw + (ldrow + 64 * i) * LDS_STRIDE + ldcol * 2) = rb[i]; } } while (0)
    H_LOAD(0);
    H_STORE(0);
    H_LOAD(1);
    __syncthreads();
#pragma unroll 1
    for (int kt = 0; kt < nk; ++kt) {
      const int buf = kt & 1;
      const int kn = kt + 2 < nk ? kt + 2 : 0;
      const unsigned char* As = As0 + buf * OPB;
      const unsigned char* Bs = Bs0 + buf * OPB;
      unsigned char* Aw = As0 + (buf ^ 1) * OPB;
      unsigned char* Bw = Bs0 + (buf ^ 1) * OPB;
#pragma unroll
      for (int k16 = 0; k16 < 4; ++k16) {
        bf16x8 wf[2], af[4];
#pragma unroll
        for (int i = 0; i < 2; ++i) wf[i] = *(const bf16x8*)(Bs + (wn * 64 + i * 32 + l31) * LDS_STRIDE + (k16 * 16 + 8 * hh) * 2);
#pragma unroll
        for (int i = 0; i < 4; ++i) af[i] = *(const bf16x8*)(As + (wm * 128 + i * 32 + l31) * LDS_STRIDE + (k16 * 16 + 8 * hh) * 2);
#pragma unroll
        for (int ni = 0; ni < 2; ++ni)
#pragma unroll
          for (int mi = 0; mi < 4; ++mi) acc[ni][mi] = MFMA32(wf[ni], af[mi], acc[ni][mi]);
        *(u32x4*)(Aw + (ldrow + 64 * k16) * LDS_STRIDE + ldcol * 2) = ra[k16];
        *(u32x4*)(Bw + (ldrow + 64 * k16) * LDS_STRIDE + ldcol * 2) = rb[k16];
        ra[k16] = *(const u32x4*)(Ap + (size_t)k16 * 64 * K + kn * 64);
        rb[k16] = *(const u32x4*)(Bp + (size_t)k16 * 64 * K + kn * 64);
        __builtin_amdgcn_sched_barrier(0);
      }
      __syncthreads();
    }
    {
      unsigned char* wl = smem + wave * 18432;
      const int m0 = pm * 256 + wm * 128, n0 = pn * 256 + wn * 64;
      if constexpr (Epi::kBf16) {
#pragma unroll
        for (int ni = 0; ni < 2; ++ni)
#pragma unroll
          for (int mi = 0; mi < 4; ++mi)
#pragma unroll
            for (int g = 0; g < 4; ++g) {
              u32x2 w;
              w[0] = pk2(Epi::act(acc[ni][mi][4 * g]), Epi::act(acc[ni][mi][4 * g + 1]));
              w[1] = pk2(Epi::act(acc[ni][mi][4 * g + 2]), Epi::act(acc[ni][mi][4 * g + 3]));
              *(u32x2*)(wl + (mi * 32 + l31) * LDS_STRIDE + (ni * 32 + 8 * g + 4 * hh) * 2) = w;
            }
        asm volatile("" ::: "memory");
#pragma unroll
        for (int i = 0; i < 16; ++i) {
          const int row = (lane >> 3) + 8 * i, ch = lane & 7;
          const u32x4 w = *(const u32x4*)(wl + row * LDS_STRIDE + ch * 16);
          *(u32x4*)(epi.O + (size_t)(m0 + row) * epi.ldc + n0 + ch * 8) = w;
        }
      } else {
#pragma unroll
        for (int half = 0; half < 2; ++half) {
          if (half) asm volatile("" ::: "memory");
#pragma unroll
          for (int ni = 0; ni < 2; ++ni)
#pragma unroll
            for (int mh = 0; mh < 2; ++mh)
#pragma unroll
              for (int g = 0; g < 4; ++g) {
                const int mi = 2 * half + mh;
                f32x4 v = {acc[ni][mi][4 * g], acc[ni][mi][4 * g + 1], acc[ni][mi][4 * g + 2], acc[ni][mi][4 * g + 3]};
                *(f32x4*)(wl + (mh * 32 + l31) * 272 + (ni * 32 + 8 * g + 4 * hh) * 4) = v;
              }
          asm volatile("" ::: "memory");
#pragma unroll
          for (int i = 0; i < 16; ++i) {
            const int row = (lane >> 4) + 4 * i, ch = lane & 15;
            const f32x4 v = *(const f32x4*)(wl + row * 272 + ch * 16);
            epi(m0 + half * 64 + row, n0 + ch * 4, v);
          }
        }
      }
    }
    __syncthreads();
  }
}

DI float hg_lb(const Params& p, int layer, int d, int j) {
  if (layer == 0) return 0.f;
  const float l0 = p.hg_lb_logits[d * 256 + j], l1 = p.hg_lb_logits[512 + d * 256 + j];
  return 1.f / (1.f + expf(l0 - l1));
}

DI void prep32_item(const Params& p, int layer, int it) {
  const int idx = it * 256 + ltid();
  const int row = idx >> 4, j = idx & 15, isk = j >> 3, sub = j & 7;
  bf16_t* ptr = p.P + (size_t)row * NP + isk * 256 + sub * 32;
  const float* gain = (isk ? p.da_k_gain : p.da_q_gain) + layer * 32;
  float v[32];
#pragma unroll
  for (int i = 0; i < 4; ++i) {
    const u32x4 w = *(const u32x4*)(ptr + 8 * i);
#pragma unroll
    for (int q = 0; q < 4; ++q) { v[8 * i + 2 * q] = bf_lo(w[q]); v[8 * i + 2 * q + 1] = bf_hi(w[q]); }
  }
  float ss = 0.f;
#pragma unroll
  for (int i = 0; i < 32; ++i) ss += v[i] * v[i];
  const float r = rsqrtf(ss * (1.f / 32.f) + EPS);
#pragma unroll
  for (int i = 0; i < 32; ++i) v[i] = v[i] * r * gain[i];
  if (row < TL) {
    const int t = row & (SEQ - 1);
    const float gr = (float)(t >> 6), gc = (float)(t & 63);
#pragma unroll
    for (int i = 0; i < 8; ++i) {
      constexpr float FRA[8] = {1.f, 0.31622776601683794f, 0.1f, 0.031622776601683794f, 0.01f, 0.0031622776601683794f, 0.001f, 0.00031622776601683794f};
      const float fr = FRA[i];
      const float ar = gr * fr, ac = gc * fr;
      const float cr = __cosf(ar), sr = __sinf(ar), cc = __cosf(ac), sc = __sinf(ac);
      const float x1 = v[i], x2 = v[8 + i];
      v[i] = x1 * cr - x2 * sr; v[8 + i] = x1 * sr + x2 * cr;
      const float y1 = v[16 + i], y2 = v[24 + i];
      v[16 + i] = y1 * cc - y2 * sc; v[24 + i] = y1 * sc + y2 * cc;
    }
  }
  const float qs = isk ? 1.f : (0.17677669529663687f * LOG2E);
#pragma unroll
  for (int i = 0; i < 4; ++i) {
    u32x4 w;
#pragma unroll
    for (int q = 0; q < 4; ++q) w[q] = pk2(v[8 * i + 2 * q] * qs, v[8 * i + 2 * q + 1] * qs);
    *(u32x4*)(ptr + 8 * i) = w;
  }
}

DI void prep64_item(const Params& p, int layer, int it) {
  const int idx = it * 256 + ltid();
  const int row = idx / 14, j = idx % 14;
  int col; const float* gain; bool rope, isq;
  if (j < 4) { col = 2048 + 64 * j; gain = p.na_q_gain; rope = false; isq = true; }
  else if (j < 8) { col = 2304 + 64 * (j - 4); gain = p.na_k_gain; rope = false; isq = false; }
  else if (j < 12) { col = 2816 + 64 * (j - 8); gain = p.sw_q_gain; rope = true; isq = true; }
  else { col = 3072 + 64 * (j - 12); gain = p.sw_k_gain; rope = true; isq = false; }
  gain += layer * 64;
  bf16_t* ptr = p.P + (size_t)row * NP + col;
  float v[64];
#pragma unroll
  for (int i = 0; i < 8; ++i) {
    const u32x4 w = *(const u32x4*)(ptr + 8 * i);
#pragma unroll
    for (int q = 0; q < 4; ++q) { v[8 * i + 2 * q] = bf_lo(w[q]); v[8 * i + 2 * q + 1] = bf_hi(w[q]); }
  }
  float ss = 0.f;
#pragma unroll
  for (int i = 0; i < 64; ++i) ss += v[i] * v[i];
  const float r = rsqrtf(ss * (1.f / 64.f) + EPS);
#pragma unroll
  for (int i = 0; i < 64; ++i) v[i] = v[i] * r * gain[i];
  if (rope && row < TL) {
    const int t = row & (SEQ - 1);
    const float gr = (float)(t >> 6), gc = (float)(t & 63);
#pragma unroll
    for (int i = 0; i < 16; ++i) {
      constexpr float FRD[16] = {1.f, 0.5623413251903491f, 0.31622776601683794f, 0.1778279410038923f, 0.1f, 0.05623413251903491f, 0.031622776601683794f, 0.01778279410038923f, 0.01f, 0.005623413251903491f, 0.0031622776601683794f, 0.001778279410038923f, 0.001f, 0.0005623413251903491f, 0.00031622776601683794f, 0.0001778279410038923f};
      const float fr = FRD[i];
      const float ar = gr * fr, ac = gc * fr;
      const float cr = __cosf(ar), sr = __sinf(ar), cc = __cosf(ac), sc = __sinf(ac);
      const float x1 = v[i], x2 = v[16 + i];
      v[i] = x1 * cr - x2 * sr; v[16 + i] = x1 * sr + x2 * cr;
      const float y1 = v[32 + i], y2 = v[48 + i];
      v[32 + i] = y1 * cc - y2 * sc; v[48 + i] = y1 * sc + y2 * cc;
    }
  }
  const float qs = isq ? (0.125f * LOG2E) : 1.f;
#pragma unroll
  for (int i = 0; i < 8; ++i) {
    u32x4 w;
#pragma unroll
    for (int q = 0; q < 4; ++q) w[q] = pk2(v[8 * i + 2 * q] * qs, v[8 * i + 2 * q + 1] * qs);
    *(u32x4*)(ptr + 8 * i) = w;
  }
}

DI void vt_item(const Params& p, int it, unsigned char* smem) {
  const int tid = ltid();
  const int hv = it % 10, ug = (it / 10) % NCHUNK, b = it / (10 * NCHUNK);
  int vcol; bf16_t* dst;
  if (hv < 4) { vcol = 512 + 64 * hv; dst = p.VtA + (size_t)(b * 4 + hv) * 64 * UA; }
  else if (hv < 8) { vcol = 2560 + 64 * (hv - 4); dst = p.VtC + (size_t)(b * 4 + hv - 4) * 64 * UA; }
  else { vcol = 3200 + 64 * (hv - 8); dst = p.VtD + (size_t)(b * 2 + hv - 8) * 64 * UA; }
  const int u0 = ug * 64;
  bf16_t* tile = (bf16_t*)smem;
  {
    const int tk = tid >> 2, seg = (tid & 3) * 16;
    const int row = rowOfU(b, u0 + tk);
    const bf16_t* src = p.P + (size_t)row * NP + vcol + seg;
    const u32x4 w0 = *(const u32x4*)src, w1 = *(const u32x4*)(src + 8);
    unsigned* tp = (unsigned*)(tile + tk * 66 + seg);
#pragma unroll
    for (int q = 0; q < 4; ++q) { tp[q] = w0[q]; tp[4 + q] = w1[q]; }
  }
  __syncthreads();
  {
    const int dv = tid >> 2, tq = (tid & 3) * 16;
    u32x4 w0, w1;
#pragma unroll
    for (int q = 0; q < 4; ++q) {
      w0[q] = (unsigned)tile[(tq + 2 * q) * 66 + dv] | ((unsigned)tile[(tq + 2 * q + 1) * 66 + dv] << 16);
      w1[q] = (unsigned)tile[(tq + 8 + 2 * q) * 66 + dv] | ((unsigned)tile[(tq + 8 + 2 * q + 1) * 66 + dv] << 16);
    }
    bf16_t* dp = dst + (size_t)dv * UA + u0 + tq;
    *(u32x4*)dp = w0; *(u32x4*)(dp + 8) = w1;
  }
  __syncthreads();
}

DI int hg_row(int b, int d, int n, int pp) {
  if (n < 4) { const int c = d ? 255 - (64 * n + pp) : 64 * n + pp; return TL + b * CTX + c; }
  const int t = d ? SEQ - 1 - (64 * (n - 4) + pp) : 64 * (n - 4) + pp;
  return b * SEQ + t;
}

#define MFMA16(a, b, c) __builtin_amdgcn_mfma_f32_16x16x32_bf16((a), (b), (c), 0, 0, 0)
DI bf16x8 pack8(const f32x4& a, const f32x4& b) {
  u32x4 w; w[0] = pk2(a[0], a[1]); w[1] = pk2(a[2], a[3]); w[2] = pk2(b[0], b[1]); w[3] = pk2(b[2], b[3]);
  return __builtin_bit_cast(bf16x8, w);
}

DI void prefix64(float* cumT, float* psum, int tid, float (&c)[16]) {
  const int k = tid & 63, qd = tid >> 6;
  float* row = cumT + k * 68 + 16 * qd;
#pragma unroll
  for (int i4 = 0; i4 < 4; ++i4) { const f32x4 t = *(const f32x4*)(row + 4 * i4); c[4 * i4] = t[0]; c[4 * i4 + 1] = t[1]; c[4 * i4 + 2] = t[2]; c[4 * i4 + 3] = t[3]; }
#pragma unroll
  for (int i = 1; i < 16; ++i) c[i] += c[i - 1];
  psum[qd * 64 + k] = c[15];
  __syncthreads();
  float off = 0.f;
#pragma unroll
  for (int q = 0; q < 3; ++q) off += (q < qd) ? psum[q * 64 + k] : 0.f;
#pragma unroll
  for (int i = 0; i < 16; ++i) c[i] += off;
#pragma unroll
  for (int i4 = 0; i4 < 4; ++i4) { f32x4 t = {c[4 * i4], c[4 * i4 + 1], c[4 * i4 + 2], c[4 * i4 + 3]}; *(f32x4*)(row + 4 * i4) = t; }
}

DI void hgsum_item(const Params& p, int layer, int it, unsigned char* smem) {
  const int tid = ltid();
  const int n = it % NCHUNK, chain = it / NCHUNK, d = chain & 1, hh = (chain >> 1) & 3, b = chain >> 3;
  float* cumT = (float*)smem;
  float* wT = cumT + 64 * 68;
  float* vT = wT + 64 * 68;
  float* psum = vT + 64 * 68;
  const int pp = tid >> 2, kq = (tid & 3) * 16;
  {
    const int row = hg_row(b, d, n, pp);
    const bf16_t* pr = p.P + (size_t)row * NP;
    const bf16_t* fp = pr + 1536 + d * 256 + hh * 64 + kq;
    const bf16_t* vp = pr + 1024 + hh * 64 + kq;
    const u32x4 f0 = *(const u32x4*)fp, f1 = *(const u32x4*)(fp + 8), v0 = *(const u32x4*)vp, v1 = *(const u32x4*)(vp + 8);
    float fx[16], vx[16];
#pragma unroll
    for (int q = 0; q < 4; ++q) { fx[2 * q] = bf_lo(f0[q]); fx[2 * q + 1] = bf_hi(f0[q]); fx[8 + 2 * q] = bf_lo(f1[q]); fx[8 + 2 * q + 1] = bf_hi(f1[q]);
                                  vx[2 * q] = bf_lo(v0[q]); vx[2 * q + 1] = bf_hi(v0[q]); vx[8 + 2 * q] = bf_lo(v1[q]); vx[8 + 2 * q + 1] = bf_hi(v1[q]); }
#pragma unroll
    for (int j = 0; j < 16; ++j) {
      const float lb = hg_lb(p, layer, d, hh * 64 + kq + j);
      const float sg = 1.f / (1.f + expf(-fx[j]));
      const float f = lb + (1.f - lb) * sg;
      cumT[(kq + j) * 68 + pp] = logf(f) * LOG2E;
      wT[(kq + j) * 68 + pp] = 1.f - f;
      vT[(kq + j) * 68 + pp] = vx[j];
    }
  }
  __syncthreads();
  { float c[16]; prefix64(cumT, psum, tid, c); }
  __syncthreads();
#pragma unroll
  for (int j = 0; j < 16; ++j) {
    const int k = kq + j;
    wT[k * 68 + pp] *= fexp2(cumT[k * 68 + 63] - cumT[k * 68 + pp]);
  }
  __syncthreads();
  {
    const int wv = tid >> 6, lane = tid & 63, lc = lane & 15, lq = lane >> 4;
    f32x4 acc[4];
#pragma unroll
    for (int vt = 0; vt < 4; ++vt) acc[vt] = (f32x4){0.f, 0.f, 0.f, 0.f};
#pragma unroll
    for (int ks = 0; ks < 2; ++ks) {
      const float* ar = wT + (16 * wv + lc) * 68 + 32 * ks + 8 * lq;
      const bf16x8 af = pack8(*(const f32x4*)ar, *(const f32x4*)(ar + 4));
#pragma unroll
      for (int vt = 0; vt < 4; ++vt) {
        const float* br = vT + (16 * vt + lc) * 68 + 32 * ks + 8 * lq;
        const bf16x8 bf = pack8(*(const f32x4*)br, *(const f32x4*)(br + 4));
        acc[vt] = MFMA16(af, bf, acc[vt]);
      }
    }
    float* L = p.HL + ((size_t)(chain * NCHUNK + n)) * 4096;
#pragma unroll
    for (int vt = 0; vt < 4; ++vt)
#pragma unroll
      for (int i = 0; i < 4; ++i) L[(16 * wv + 4 * lq + i) * 64 + 16 * vt + lc] = acc[vt][i];
    if (tid < 64) p.Hdec[(chain * NCHUNK + n) * 64 + tid] = fexp2(cumT[tid * 68 + 63]);
  }
  __syncthreads();
}

DI void prep_phase(const Params& p, int layer, unsigned char* smem, int bid, int nb) {
  constexpr int n_hg = 16 * NCHUNK;
  constexpr int n_vt = 2 * NCHUNK * 10;
  constexpr int n_p32 = TA * 16 / 256;
  constexpr int n_p64 = TA * 14 / 256;
  constexpr int total = n_hg + n_vt + n_p32 + n_p64;
  for (int it = bid; it < total; it += nb) {
    if (it < n_hg) hgsum_item(p, layer, it, smem);
    else if (it < n_hg + n_vt) vt_item(p, it - n_hg, smem);
    else if (it < n_hg + n_vt + n_p32) prep32_item(p, layer, it - n_hg - n_vt);
    else prep64_item(p, layer, it - n_hg - n_vt - n_p32);
  }
}

DI void scan_item(const Params& p, int it) {
  const int chain = it >> 4, e = (it & 15) * 256 + ltid(), k = e >> 6;
  float* L = p.HL + (size_t)chain * NCHUNK * 4096 + e;
  const float* dc = p.Hdec + chain * NCHUNK * 64 + k;
  float S = 0.f;
  for (int n0 = 0; n0 < NCHUNK; n0 += 26) {
    float l[26], dd[26];
#pragma unroll
    for (int j = 0; j < 26; ++j) { l[j] = L[(size_t)(n0 + j) * 4096]; dd[j] = dc[(n0 + j) * 64]; }
#pragma unroll
    for (int j = 0; j < 26; ++j) { L[(size_t)(n0 + j) * 4096] = S; S = dd[j] * S + l[j]; }
  }
}

DI void attnA_block(const Params& p, int layer, unsigned char* smem, int b, int h, int qrow_blk, int ubeg, int uend) {
  const int tid = ltid512(), wave = tid >> 6;
  const int lane = tid & 63, qi = lane & 31, hh = lane >> 5;
  const int qrow0 = qrow_blk + wave * 32;
  const int pr = (qi & 19) | ((qi & 4) << 1) | ((qi & 8) >> 1);
  const float lam_init = layer == 0 ? 0.2f : 0.35550906759096f;
  float gq = lane < 32 ? fabsf(p.da_q_gain[layer * 32 + lane]) : 0.f, gk = lane < 32 ? fabsf(p.da_k_gain[layer * 32 + lane]) : 0.f;
  gq = wave_max(gq); gk = wave_max(gk);
  const float negM2 = -(0.17677669529663687f * LOG2E * 32.f * 1.02f) * gq * gk;
  float la = 0.f, lb_ = 0.f;
  if (lane < 32) { const float* lv = p.da_lambda + layer * 128; la = lv[lane] * lv[32 + lane]; lb_ = lv[64 + lane] * lv[96 + lane]; }
  la = wave_sum(la); lb_ = wave_sum(lb_);
  const float lam = expf(la) - expf(lb_) + lam_init;

  const bf16_t* qp = p.P + (size_t)(qrow0 + qi) * NP + h * 64 + 8 * hh;
  bf16x8 qf[2][2];
#pragma unroll
  for (int m = 0; m < 2; ++m)
#pragma unroll
    for (int ks = 0; ks < 2; ++ks) qf[m][ks] = *(const bf16x8*)(qp + m * 32 + ks * 16);
  f32x16 o[2][2];
#pragma unroll
  for (int m = 0; m < 2; ++m)
#pragma unroll
    for (int dh = 0; dh < 2; ++dh)
#pragma unroll
      for (int i = 0; i < 16; ++i) o[m][dh][i] = 0.f;
  float ls[2] = {0.f, 0.f};
  constexpr int VSTR = 272, KBYTES = 128 * LDS_STRIDE, STG = KBYTES + 64 * VSTR;
  const int krow = tid >> 3, kch = tid & 7;
  const int vrow = tid >> 4, vch = tid & 15;
  const bf16_t* kg = p.P + 256 + h * 64 + kch * 8;
  const bf16_t* vg = p.VtA + ((size_t)((b * 4 + h) * 64 + vrow)) * UA + vch * 8;
  u32x4 rk0, rk1, rv0, rv1;
  rk0 = *(const u32x4*)(kg + (size_t)rowOfU(b, ubeg + krow) * NP);
  rk1 = *(const u32x4*)(kg + (size_t)rowOfU(b, ubeg + krow + 64) * NP);
  rv0 = *(const u32x4*)(vg + ubeg);
  rv1 = *(const u32x4*)(vg + (size_t)32 * UA + ubeg);
  __syncthreads();
  asm volatile("" :: "v"(qf[0][0]), "v"(qf[0][1]), "v"(qf[1][0]), "v"(qf[1][1]));
  {
    unsigned char* Ks = smem; unsigned char* Vs = smem + KBYTES;
    *(u32x4*)(Ks + krow * LDS_STRIDE + kch * 16) = rk0; *(u32x4*)(Ks + (krow + 64) * LDS_STRIDE + kch * 16) = rk1;
    *(u32x4*)(Vs + vrow * VSTR + vch * 16) = rv0; *(u32x4*)(Vs + (vrow + 32) * VSTR + vch * 16) = rv1;
  }
  __syncthreads();
  int buf = 0;
  for (int u0 = ubeg; u0 < uend; u0 += 128) {
    const int un = u0 + 128 < uend ? u0 + 128 : ubeg;
    rk0 = *(const u32x4*)(kg + (size_t)rowOfU(b, un + krow) * NP);
    rk1 = *(const u32x4*)(kg + (size_t)rowOfU(b, un + krow + 64) * NP);
    rv0 = *(const u32x4*)(vg + un);
    rv1 = *(const u32x4*)(vg + (size_t)32 * UA + un);
    const unsigned char* Ks = smem + buf * STG;
    const unsigned char* Vs = Ks + KBYTES;
    f32x16 sc[2], sn[2];
#define A_QK(SUB, DST) do { _Pragma("unroll") for (int m = 0; m < 2; ++m) { \
      const unsigned char* kr = Ks + (32 * (SUB) + pr) * LDS_STRIDE + (m * 32 + 8 * hh) * 2; \
      const bf16x8 kf0 = *(const bf16x8*)kr, kf1 = *(const bf16x8*)(kr + 32); \
      f32x16 t_; _Pragma("unroll") for (int i = 0; i < 16; ++i) t_[i] = negM2; \
      t_ = MFMA32(kf0, qf[m][0], t_); DST[m] = MFMA32(kf1, qf[m][1], t_); } } while (0)
    A_QK(0, sc);
#pragma unroll
    for (int sub = 0; sub < 4; ++sub) {
      if (sub < 3) A_QK(sub + 1, sn);
      bf16x8 vf[2][2];
#pragma unroll
      for (int dh = 0; dh < 2; ++dh)
#pragma unroll
        for (int s2 = 0; s2 < 2; ++s2) vf[dh][s2] = *(const bf16x8*)(Vs + (32 * dh + qi) * VSTR + (32 * sub + 16 * s2 + 8 * hh) * 2);
#pragma unroll
      for (int m = 0; m < 2; ++m) {
        float pe[16];
#pragma unroll
        for (int i = 0; i < 16; ++i) pe[i] = fexp2(sc[m][i]);
        sum16_nopk(ls[m], pe);
#pragma unroll
        for (int s2 = 0; s2 < 2; ++s2) {
          u32x4 pw;
#pragma unroll
          for (int q = 0; q < 4; ++q) pw[q] = pk2(pe[8 * s2 + 2 * q], pe[8 * s2 + 2 * q + 1]);
          const bf16x8 pf = __builtin_bit_cast(bf16x8, pw);
#pragma unroll
          for (int dh = 0; dh < 2; ++dh) o[m][dh] = MFMA32(vf[dh][s2], pf, o[m][dh]);
        }
      }
      if (sub < 3) { sc[0] = sn[0]; sc[1] = sn[1]; }
    }
    {
      unsigned char* Kw = smem + (buf ^ 1) * STG; unsigned char* Vw = Kw + KBYTES;
      *(u32x4*)(Kw + krow * LDS_STRIDE + kch * 16) = rk0; *(u32x4*)(Kw + (krow + 64) * LDS_STRIDE + kch * 16) = rk1;
      *(u32x4*)(Vw + vrow * VSTR + vch * 16) = rv0; *(u32x4*)(Vw + (vrow + 32) * VSTR + vch * 16) = rv1;
    }
    __syncthreads();
    buf ^= 1;
  }
  const float l0 = ls[0] + __shfl_xor(ls[0], 32), l1 = ls[1] + __shfl_xor(ls[1], 32);
  const float i0 = 1.f / l0, c1 = lam / l1;
  float ss = 0.f;
#pragma unroll
  for (int dh = 0; dh < 2; ++dh)
#pragma unroll
    for (int i = 0; i < 16; ++i) { const float v = o[0][dh][i] * i0 - o[1][dh][i] * c1; o[0][dh][i] = v; ss += v * v; }
  ss += __shfl_xor(ss, 32);
  const float r = rsqrtf(ss * (1.f / 64.f) + EPS) * (1.f - lam_init);
  bf16_t* op = p.MO + (size_t)(qrow0 + qi) * DM + h * 64;
  const float* sg = p.da_sub_gain + layer * 64;
#pragma unroll
  for (int dh = 0; dh < 2; ++dh)
#pragma unroll
    for (int g = 0; g < 4; ++g) {
      const int dv = 32 * dh + 8 * g + 4 * hh;
      const f32x4 g4 = *(const f32x4*)(sg + dv);
      u32x2 w;
      w[0] = pk2(o[0][dh][4 * g] * r * g4[0], o[0][dh][4 * g + 1] * r * g4[1]);
      w[1] = pk2(o[0][dh][4 * g + 2] * r * g4[2], o[0][dh][4 * g + 3] * r * g4[3]);
      *(u32x2*)(op + dv) = w;
    }
}

struct Frag64 { u32x4 k[4]; u32x4 v[4]; };
constexpr int W64_KB = 32 * LDS_STRIDE, W64_VSTR = 80, W64_BYTES = W64_KB + 64 * W64_VSTR;
DI void frag64_load(Frag64& f, const bf16_t* P, const bf16_t* vt, int b, int u, int kcol, int lane) {
#pragma unroll
  for (int i = 0; i < 4; ++i) {
    f.k[i] = *(const u32x4*)(P + (size_t)rowOfU(b, u + (lane >> 3) + 8 * i) * NP + kcol + (lane & 7) * 8);
    f.v[i] = *(const u32x4*)(vt + (size_t)((lane >> 2) + 16 * i) * UA + u + (lane & 3) * 8);
  }
}

template <int MODE>
DI void attn64_wave(const Params& p, int layer, int b, int hq, int qrow0, int t0, const float* rpb_lds, unsigned char* wlds) {
  constexpr bool isC = (MODE == 0 || MODE == 2);
  const int lane = ltid() & 63, qi = lane & 31, hh = lane >> 5;
  const int pr = (qi & 19) | ((qi & 4) << 1) | ((qi & 8) >> 1);
  const float* gqp = (isC ? p.na_q_gain : p.sw_q_gain) + layer * 64;
  const float* gkp = (isC ? p.na_k_gain : p.sw_k_gain) + layer * 64;
  const float gq = wave_max(fabsf(gqp[lane])), gk = wave_max(fabsf(gkp[lane]));
  const float negM2 = -(0.125f * LOG2E * 64.f * 1.02f) * gq * gk;
  const int kvh = isC ? hq : (hq >> 1);
  const int qcol = isC ? 2048 + 64 * hq : 2816 + 64 * hq;
  const int kcol = isC ? 2304 + 64 * hq : 3072 + 64 * kvh;
  const bf16_t* vt = isC ? p.VtC + (size_t)(b * 4 + hq) * 64 * UA : p.VtD + (size_t)(b * 2 + kvh) * 64 * UA;
  const bf16_t* qp = p.P + (size_t)(qrow0 + qi) * NP + qcol + 8 * hh;
  bf16x8 qf[4];
#pragma unroll
  for (int ks = 0; ks < 4; ++ks) qf[ks] = *(const bf16x8*)(qp + ks * 16);
  f32x16 o[2];
#pragma unroll
  for (int dh = 0; dh < 2; ++dh)
#pragma unroll
    for (int i = 0; i < 16; ++i) o[dh][i] = 0.f;
  float ls = 0.f;
  constexpr int NT = MODE == 0 ? 24 : (MODE == 1 ? 18 : 8);
  const int r = t0 >> 6, c = (t0 & 63) + qi;
  const int rs = min(max(r - 4, 0), 248), ws = min(max(c - 8, 0), 48);
  const float* rpb = rpb_lds + hq * 465;
  const int qt = t0 + qi;
  auto tile_u = [&](int t) -> int {
    if (t < 8) return 32 * t;
    if (MODE == 0) return CTX + (rs + ((t - 8) >> 1)) * 64 + ((t - 8) & 1) * 32;
    const int kt0 = t0 - 128 + 32 * (t - 8);
    return CTX + min(max(kt0, 0), SEQ - 32);
  };
  auto load_tile = [&](Frag64& f, int t) { frag64_load(f, p.P, vt, b, tile_u(t), kcol, lane); };
  unsigned char* Kw = wlds; unsigned char* Vw = wlds + W64_KB;
  auto compute_tile = [&](const Frag64& f, int t) {
#pragma unroll
    for (int i = 0; i < 4; ++i) {
      *(u32x4*)(Kw + ((lane >> 3) + 8 * i) * LDS_STRIDE + (lane & 7) * 16) = f.k[i];
      *(u32x4*)(Vw + ((lane >> 2) + 16 * i) * W64_VSTR + (lane & 3) * 16) = f.v[i];
    }
    bf16x8 kf[4], vf[2][2];
#pragma unroll
    for (int ks = 0; ks < 4; ++ks) kf[ks] = __builtin_bit_cast(bf16x8, *(const u32x4*)(Kw + pr * LDS_STRIDE + (16 * ks + 8 * hh) * 2));
#pragma unroll
    for (int dh = 0; dh < 2; ++dh)
#pragma unroll
      for (int s2 = 0; s2 < 2; ++s2) vf[dh][s2] = __builtin_bit_cast(bf16x8, *(const u32x4*)(Vw + (32 * dh + qi) * W64_VSTR + (16 * s2 + 8 * hh) * 2));
    f32x16 s;
#pragma unroll
    for (int i = 0; i < 16; ++i) s[i] = negM2;
#pragma unroll
    for (int ks = 0; ks < 4; ++ks) s = MFMA32(kf[ks], qf[ks], s);
    float pe[16];
    if (t < 8) {
#pragma unroll
      for (int i = 0; i < 16; ++i) pe[i] = fexp2(s[i]);
    } else if (MODE == 0) {
      const int kr = rs + ((t - 8) >> 1), hf = (t - 8) & 1;
      const float* rrow = rpb + (kr - r + 7) * 31 + 15 - c;
#pragma unroll
      for (int i = 0; i < 16; ++i) {
        const int kc = hf * 32 + 16 * (i >> 3) + 8 * hh + (i & 7);
        const bool valid = (kc >= ws) && (kc < ws + 16);
        const int kcc = min(max(kc, ws), ws + 15);
        pe[i] = fexp2(valid ? s[i] + rrow[kcc] : -1e30f);
      }
    } else {
      const int jt = t - 8, kt0 = t0 - 128 + 32 * jt;
      const bool tile_ok = (jt < 9) && (kt0 >= 0) && (kt0 < SEQ);
#pragma unroll
      for (int i = 0; i < 16; ++i) {
        const int dd = kt0 + 16 * (i >> 3) + 8 * hh + (i & 7) - qt;
        pe[i] = fexp2((tile_ok && dd <= 128 && dd >= -128) ? s[i] : -1e30f);
      }
    }
    sum16_nopk(ls, pe);
#pragma unroll
    for (int s2 = 0; s2 < 2; ++s2) {
      u32x4 pw;
#pragma unroll
      for (int q = 0; q < 4; ++q) pw[q] = pk2(pe[8 * s2 + 2 * q], pe[8 * s2 + 2 * q + 1]);
      const bf16x8 pf = __builtin_bit_cast(bf16x8, pw);
#pragma unroll
      for (int dh = 0; dh < 2; ++dh) o[dh] = MFMA32(vf[dh][s2], pf, o[dh]);
    }
  };
  Frag64 fa, fb;
  load_tile(fa, 0);
#pragma unroll 1
  for (int t = 0; t < NT; t += 2) {
    load_tile(fb, t + 1);
    compute_tile(fa, t);
    load_tile(fa, t + 2 < NT ? t + 2 : 0);
    compute_tile(fb, t + 1);
  }
  float l = ls + __shfl_xor(ls, 32);
  if (!isC) l += fexp2(p.sw_sink[layer * 4 + hq] * LOG2E + negM2);
  const float il = 1.f / l;
  bf16_t* op = p.MO + (size_t)(qrow0 + qi) * DM + (isC ? 512 : 768) + hq * 64;
#pragma unroll
  for (int dh = 0; dh < 2; ++dh)
#pragma unroll
    for (int g = 0; g < 4; ++g) {
      const int dv = 32 * dh + 8 * g + 4 * hh;
      u32x2 w;
      w[0] = pk2(o[dh][4 * g] * il, o[dh][4 * g + 1] * il);
      w[1] = pk2(o[dh][4 * g + 2] * il, o[dh][4 * g + 3] * il);
      *(u32x2*)(op + dv) = w;
    }
}

DI void mix_phase(const Params& p, int layer, unsigned char* smem, unsigned char* smem_all, int bid, int nb, int rrank) {
  const int wave = ltid() >> 6;
  const int n_scan = 256, n_lat = 1024, n_ctx = layer == 0 ? 16 : 0;
  const int e0 = n_scan, e1 = e0 + n_lat, e2 = e1 + n_ctx, e3 = e2 + n_lat, e4 = e3 + n_lat, e5 = e4 + n_ctx, e6 = e5 + n_ctx;
  {
    const int rnb_ = nb >> 1, per_r = (rnb_ >> 3) > 0 ? (rnb_ >> 3) : 1;
    const int bh = rrank / per_r, jj = rrank - bh * per_r;
    if (bh < 8)
      for (int qb = jj; qb < 64; qb += per_r) attnA_block(p, layer, smem_all, bh >> 2, bh & 3, (bh >> 2) * SEQ + qb * 256, 0, UA);
    if (layer == 0)
      for (int j = rrank; j < 8; j += rnb_) attnA_block(p, layer, smem_all, j >> 2, j & 3, TL + (j >> 2) * CTX, 0, CTX);
    __syncthreads();
  }
  float* rpb_lds = (float*)smem;
  for (int i = ltid(); i < 4 * 465; i += 256) rpb_lds[i] = p.na_rpb[layer * 4 * 465 + i] * LOG2E;
  __syncthreads();
  for (int it = 2 * rrank + (bid & 1); it < e6; it += nb) {
    if (it < e0) scan_item(p, it);
    else if (it < e1) {
    } else if (it < e2) {
    } else if (it < e3) {
      const int j = it - e2, qb = j & 127, hq = (j >> 7) & 3, b = j >> 9;
      const int t0 = qb * 128 + wave * 32;
      attn64_wave<1>(p, layer, b, hq, b * SEQ + t0, t0, rpb_lds, smem + 8192 + wave * W64_BYTES);
    } else if (it < e4) {
      const int j = it - e3, qb = j & 127, hq = (j >> 7) & 3, b = j >> 9;
      const int t0 = qb * 128 + wave * 32;
      attn64_wave<0>(p, layer, b, hq, b * SEQ + t0, t0, rpb_lds, smem + 8192 + wave * W64_BYTES);
    } else if (it < e5) {
      const int j = it - e4, qb = j & 1, hq = (j >> 1) & 3, b = j >> 3;
      attn64_wave<3>(p, layer, b, hq, TL + b * CTX + qb * 128 + wave * 32, 0, rpb_lds, smem + 8192 + wave * W64_BYTES);
    } else {
      const int j = it - e5, qb = j & 1, hq = (j >> 1) & 3, b = j >> 3;
      attn64_wave<2>(p, layer, b, hq, TL + b * CTX + qb * 128 + wave * 32, 0, rpb_lds, smem + 8192 + wave * W64_BYTES);
    }
  }
}


template <int D>
DI void hgrn_dir(const Params& p, int layer, unsigned char* smem, int b, int hh, int n, f32x4 (&acc)[4]) {
  const int tid = ltid();
  const int chain = (b * 4 + hh) * 2 + D;
  float* cumT = (float*)smem;
  float* qT = cumT + 64 * 68;
  float* kT = qT + 64 * 68;
  float* vT = kT + 64 * 68;
  float* psum = vT + 64 * 68;
  float kreg[16], qreg[16];
  {
    const int pp = tid >> 2, kq = (tid & 3) * 16;
    const int row = hg_row(b, D, n, pp);
    const bf16_t* pr = p.P + (size_t)row * NP;
    const bf16_t* qp = pr + 768 + hh * 64 + kq;
    const bf16_t* fp = pr + 1536 + D * 256 + hh * 64 + kq;
    const bf16_t* vp = pr + 1024 + hh * 64 + kq;
    const u32x4 q0 = *(const u32x4*)qp, q1 = *(const u32x4*)(qp + 8), f0 = *(const u32x4*)fp, f1 = *(const u32x4*)(fp + 8),
                v0 = *(const u32x4*)vp, v1 = *(const u32x4*)(vp + 8);
    const float* Sg = p.HL + ((size_t)(chain * NCHUNK + n)) * 4096 + tid * 16;
    f32x4 s4[4];
#pragma unroll
    for (int i = 0; i < 4; ++i) s4[i] = *(const f32x4*)(Sg + 4 * i);
    float qx[16], fx[16], vx[16];
#pragma unroll
    for (int q = 0; q < 4; ++q) {
      qx[2 * q] = bf_lo(q0[q]); qx[2 * q + 1] = bf_hi(q0[q]); qx[8 + 2 * q] = bf_lo(q1[q]); qx[8 + 2 * q + 1] = bf_hi(q1[q]);
      fx[2 * q] = bf_lo(f0[q]); fx[2 * q + 1] = bf_hi(f0[q]); fx[8 + 2 * q] = bf_lo(f1[q]); fx[8 + 2 * q + 1] = bf_hi(f1[q]);
      vx[2 * q] = bf_lo(v0[q]); vx[2 * q + 1] = bf_hi(v0[q]); vx[8 + 2 * q] = bf_lo(v1[q]); vx[8 + 2 * q + 1] = bf_hi(v1[q]);
    }
#pragma unroll
    for (int j = 0; j < 16; ++j) {
      const float lb = hg_lb(p, layer, D, hh * 64 + kq + j);
      const float sg = 1.f / (1.f + expf(-fx[j]));
      const float f = lb + (1.f - lb) * sg;
      cumT[(kq + j) * 68 + pp] = logf(f) * LOG2E;
      qT[(kq + j) * 68 + pp] = qx[j];
      qreg[j] = qx[j];
      kreg[j] = 1.f - f;
      vT[(kq + j) * 68 + pp] = vx[j];
      kT[(kq + j) * 68 + pp] = s4[j >> 2][j & 3];
    }
  }
  __syncthreads();
  {
    float c[16];
    prefix64(cumT, psum, tid, c);
    float* qrow = qT + (tid & 63) * 68 + 16 * (tid >> 6);
#pragma unroll
    for (int i4 = 0; i4 < 4; ++i4) {
      f32x4 t = *(const f32x4*)(qrow + 4 * i4);
#pragma unroll
      for (int a = 0; a < 4; ++a) t[a] *= fexp2(c[4 * i4 + a]);
      *(f32x4*)(qrow + 4 * i4) = t;
    }
  }
  __syncthreads();
  const int wv = tid >> 6, lane = tid & 63, lc = lane & 15, lq = lane >> 4;
  const int ppos = D ? 16 * (3 - wv) + 15 - lc : 16 * wv + lc;
  {
#pragma unroll
    for (int ks = 0; ks < 2; ++ks) {
      f32x4 b0, b1;
#pragma unroll
      for (int j = 0; j < 4; ++j) { b0[j] = qT[(32 * ks + 8 * lq + j) * 68 + ppos]; b1[j] = qT[(32 * ks + 8 * lq + 4 + j) * 68 + ppos]; }
      const bf16x8 bf = pack8(b0, b1);
#pragma unroll
      for (int vt = 0; vt < 4; ++vt) {
        const float* ar = kT + (16 * vt + lc) * 68 + 32 * ks + 8 * lq;
        const bf16x8 af = pack8(*(const f32x4*)ar, *(const f32x4*)(ar + 4));
        acc[vt] = MFMA16(af, bf, acc[vt]);
      }
    }
  }
  __syncthreads();
  {
    const int pp = tid >> 2, kq = (tid & 3) * 16;
#pragma unroll
    for (int j = 0; j < 16; ++j) { kT[(kq + j) * 68 + pp] = kreg[j]; qT[(kq + j) * 68 + pp] = qreg[j]; }
  }
  __syncthreads();
  const int bt = tid >> 4, bs = tid & 15;
  float sc[4][4];
#pragma unroll
  for (int a = 0; a < 4; ++a)
#pragma unroll
    for (int c = 0; c < 4; ++c) sc[a][c] = 0.f;
  if (bs <= bt) {
    for (int k = 0; k < 64; ++k) {
      const f32x4 ct = *(const f32x4*)(cumT + k * 68 + 4 * bt), qt = *(const f32x4*)(qT + k * 68 + 4 * bt);
      const f32x4 cs = *(const f32x4*)(cumT + k * 68 + 4 * bs), ks = *(const f32x4*)(kT + k * 68 + 4 * bs);
      const float ref = ct[0];
      float et[4], es[4];
#pragma unroll
      for (int a = 0; a < 4; ++a) { et[a] = qt[a] * fexp2(ct[a] - ref); es[a] = ks[a] * fexp2(ref - cs[a]); }
#pragma unroll
      for (int a = 0; a < 4; ++a)
#pragma unroll
        for (int c = 0; c < 4; ++c) sc[a][c] += et[a] * es[c];
    }
  }
  __syncthreads();
#pragma unroll
  for (int a = 0; a < 4; ++a) {
    f32x4 w;
#pragma unroll
    for (int c = 0; c < 4; ++c) w[c] = (bs <= bt && (4 * bs + c) <= (4 * bt + a)) ? sc[a][c] : 0.f;
    *(f32x4*)(kT + (4 * bt + a) * 68 + 4 * bs) = w;
  }
  __syncthreads();
  {
#pragma unroll
    for (int ks = 0; ks < 2; ++ks) {
      const float* br = kT + ppos * 68 + 32 * ks + 8 * lq;
      const bf16x8 bf = pack8(*(const f32x4*)br, *(const f32x4*)(br + 4));
#pragma unroll
      for (int vt = 0; vt < 4; ++vt) {
        const float* ar = vT + (16 * vt + lc) * 68 + 32 * ks + 8 * lq;
        const bf16x8 af = pack8(*(const f32x4*)ar, *(const f32x4*)(ar + 4));
        acc[vt] = MFMA16(af, bf, acc[vt]);
      }
    }
  }
  __syncthreads();
}

DI void hgout_phase(const Params& p, int layer, unsigned char* smem, int bid, int nb) {
  const int tid = ltid();
  const int n_lat = 2 * 4 * 256, n_ctx = layer == 0 ? 2 * 4 * 4 : 0;
  for (int it = bid; it < n_lat + n_ctx; it += nb) {
    int b, hh, n0, n1, rowbase;
    if (it < n_lat) { const int m = it & 255; hh = (it >> 8) & 3; b = it >> 10; n0 = 4 + m; n1 = 4 + 255 - m; rowbase = b * SEQ + 64 * m; }
    else { const int j = it - n_lat, mc = j & 3; hh = (j >> 2) & 3; b = j >> 4; n0 = mc; n1 = 3 - mc; rowbase = TL + b * CTX + 64 * mc; }
    f32x4 acc[4];
#pragma unroll
    for (int vt = 0; vt < 4; ++vt) acc[vt] = (f32x4){0.f, 0.f, 0.f, 0.f};
    hgrn_dir<0>(p, layer, smem, b, hh, n0, acc);
    hgrn_dir<1>(p, layer, smem, b, hh, n1, acc);
    const int wv = tid >> 6, lane = tid & 63, lc = lane & 15, lq = lane >> 4;
    const int row = rowbase + 16 * wv + lc;
    float ss = 0.f;
#pragma unroll
    for (int vt = 0; vt < 4; ++vt)
#pragma unroll
      for (int i = 0; i < 4; ++i) ss += acc[vt][i] * acc[vt][i];
    ss += __shfl_xor(ss, 16); ss += __shfl_xor(ss, 32);
    const float r = rsqrtf(ss * (1.f / 64.f) + EPS);
#pragma unroll
    for (int vt = 0; vt < 4; ++vt) {
      const int v0 = 16 * vt + 4 * lq;
      const f32x4 og = *(const f32x4*)(p.hg_out_gain + layer * 64 + v0);
      const u32x2 gw = *(const u32x2*)(p.P + (size_t)row * NP + 1280 + hh * 64 + v0);
      const float gx[4] = {bf_lo(gw[0]), bf_hi(gw[0]), bf_lo(gw[1]), bf_hi(gw[1])};
      float y[4];
#pragma unroll
      for (int i = 0; i < 4; ++i) y[i] = acc[vt][i] * r * og[i] * (gx[i] / (1.f + expf(-gx[i])));
      u32x2 w; w[0] = pk2(y[0], y[1]); w[1] = pk2(y[2], y[3]);
      *(u32x2*)(p.MO + (size_t)row * DM + 256 + hh * 64 + v0) = w;
    }
  }
}

#if MULTI_LAUNCH
#define SYNC_OR_RETURN(ph) do { if (phase_sel == (ph)) return; } while (0)
#define RUN(ph) (phase_sel == (ph))
#else
#define RUN(ph) (true)
#endif

__global__ void __launch_bounds__(512) fwd_kernel(Params p, int phase_sel) {
  __shared__ __attribute__((aligned(16))) unsigned char smem_all[2 * SMEM_BYTES];
  const int rbid = blockIdx.x, rnb = gridDim.x;
  const int vb = __builtin_amdgcn_readfirstlane((int)(threadIdx.x >> 8));
  const int bid = rbid * 2 + vb, nb = rnb * 2;
  unsigned char* smem = smem_all + vb * SMEM_BYTES;
#if !MULTI_LAUNCH
  cg::grid_group grid = cg::this_grid();
#define GSYNC() grid.sync()
#else
#define GSYNC() do {} while (0)
#endif
  __shared__ int s_rank[2];
  if (threadIdx.x == 0) { const unsigned x = xcc_id(); s_rank[0] = (int)x; s_rank[1] = (int)atomicAdd(&p.xcnt[x], 1u); }
  int ph = 0;
  if (RUN(ph)) phase0(p, smem, bid, nb);
  GSYNC(); ++ph;
  if (threadIdx.x == 0) {
    int r = s_rank[1];
    for (int y = 0; y < s_rank[0]; ++y) r += (int)__hip_atomic_load(&p.xcnt[y], __ATOMIC_RELAXED, __HIP_MEMORY_SCOPE_AGENT);
    s_rank[0] = r;
  }
  __syncthreads();
  const int rrank = __builtin_amdgcn_readfirstlane(s_rank[0]);
  for (int layer = 0; layer < 2; ++layer) {
    const float* modl = p.mod + layer * 3 * 6144;
    const float* rl = layer == 0 ? p.x : p.out;
    const float* rc = layer == 0 ? p.ctx : p.Xc;
    if (RUN(ph)) norm_phase(rl, rc, TA, p.norm1_g + layer * DM, modl, 0, 1024, p.H, bid, nb);
    GSYNC(); ++ph;
    if (RUN(ph)) { EpiBf16 e{p.P, NP}; gemm_phase512(p.H, p.WinT + (size_t)layer * NP * 1024, TA / 256, NP / 256, 1024, 1024, 1, e, smem_all, rrank, rnb); }
    GSYNC(); ++ph;
    if (RUN(ph)) prep_phase(p, layer, smem, bid, nb);
    GSYNC(); ++ph;
    if (RUN(ph)) mix_phase(p, layer, smem, smem_all, bid, nb, rrank);
    GSYNC(); ++ph;
    if (RUN(ph)) hgout_phase(p, layer, smem, bid, nb);
    GSYNC(); ++ph;
    const int mrows = layer == 0 ? TA : TL;
    if (RUN(ph)) { EpiResid e{rl, rc, p.out, p.Xc, modl + 2048, 0}; gemm_phase512(p.MO, p.WoutT + (size_t)layer * 1024 * 1024, mrows / 256, 4, 1024, 1024, 1, e, smem_all, rrank, rnb); }
    GSYNC(); ++ph;
    if (RUN(ph)) norm_phase(p.out, p.Xc, mrows, p.norm2_g + layer * DM, modl, 3072, 4096, p.H, bid, nb);
    GSYNC(); ++ph;
    const int nchunks = layer == 0 ? 3 : 2;
    for (int ch = 0; ch < nchunks; ++ch) {
      const int row0 = ch * 16384, rows = ch < 2 ? 16384 : TC;
      if (RUN(ph)) { EpiRelu2 e{p.P, DFF}; gemm_phase512(p.H + (size_t)row0 * DM, p.W1T + (size_t)layer * DFF * 1024, rows / 256, DFF / 256, 1024, 1024, 1, e, smem_all, rrank, rnb); }
      GSYNC(); ++ph;
      if (RUN(ph)) {
        if (ch < 2) { EpiResid e{p.out, p.Xc, p.out, p.Xc, modl + 5 * 1024, row0}; gemm_phase512(p.P, p.W2T + (size_t)layer * 1024 * DFF, rows / 256, 4, DFF, DFF, 1, e, smem_all, rrank, rnb); }
        else { EpiResidAtomic e{p.out, p.Xc, modl + 5 * 1024, row0}; gemm_phase512(p.P, p.W2T + (size_t)layer * 1024 * DFF, rows / 256, 4, DFF, 256, 16, e, smem_all, rrank, rnb); }
      }
      GSYNC(); ++ph;
    }
  }
}

static size_t align_up(size_t v) { return (v + 255) & ~(size_t)255; }

extern "C" void kernel_launch(void* const* d_in, const int* in_sizes, int n_in, void* d_out, int out_size, void* d_ws, size_t ws_size,
                              hipStream_t stream) {
  Params p{};
  const float** f = (const float**)&p;
  for (int i = 0; i < 24; ++i) f[i] = (const float*)d_in[i];
  p.out = (float*)d_out;
  unsigned char* w = (unsigned char*)d_ws; size_t off = 0;
  auto take = [&](size_t bytes) { void* r = w + off; off = align_up(off + bytes); return r; };
  p.Xc = (float*)take((size_t)TC * DM * 4);
  p.mod = (float*)take((size_t)2 * 3 * 6144 * 4);
  p.Hdec = (float*)take((size_t)16 * NCHUNK * 64 * 4);
  p.WinT = (bf16_t*)take((size_t)2 * NP * 1024 * 2);
  p.WoutT = (bf16_t*)take((size_t)2 * 1024 * 1024 * 2);
  p.W1T = (bf16_t*)take((size_t)2 * DFF * 1024 * 2);
  p.W2T = (bf16_t*)take((size_t)2 * DFF * 1024 * 2);
  p.H = (bf16_t*)take((size_t)TA * DM * 2);
  p.HL = (float*)p.H;
  p.P = (bf16_t*)take((size_t)TA * NP * 2);
  p.MO = (bf16_t*)take((size_t)TA * DM * 2);
  p.VtA = (bf16_t*)take((size_t)2 * 4 * 64 * UA * 2);
  p.VtC = (bf16_t*)take((size_t)2 * 4 * 64 * UA * 2);
  p.VtD = (bf16_t*)take((size_t)2 * 2 * 64 * UA * 2);
  p.xcnt = (unsigned*)take(256);
  if (off > ws_size) { fprintf(stderr, "workspace too small: need %zu have %zu\n", off, ws_size); return; }
#if MULTI_LAUNCH
  const int nphase = 1 + 7 + 6 + 7 + 4;
  for (int ph = 0; ph < nphase; ++ph) hipLaunchKernelGGL(fwd_kernel, dim3(256), dim3(512), 0, stream, p, ph);
#else
  static int grid_blocks = 0;
  int phase_sel = -1;
  void* args[] = {&p, &phase_sel};
  if (!grid_blocks) {
    int dev = 0, cus = 0, per_cu = 0;
    (void)hipGetDevice(&dev);
    (void)hipDeviceGetAttribute(&cus, hipDeviceAttributeMultiprocessorCount, dev);
    (void)hipOccupancyMaxActiveBlocksPerMultiprocessor(&per_cu, fwd_kernel, 512, 0);
    if (per_cu < 1) per_cu = 1;
    grid_blocks = cus;
  }
  (void)hipMemsetAsync(p.xcnt, 0, 256, stream);
  hipError_t e = hipLaunchCooperativeKernel((void*)fwd_kernel, dim3(grid_blocks), dim3(512), args, 0, stream);
  if (e != hipSuccess) fprintf(stderr, "cooperative launch failed: %s (grid %d)\n", hipGetErrorString(e), grid_blocks);
#endif
}
```

```cpp
#include <hip/hip_runtime.h>
#include <hip/hip_cooperative_groups.h>
#include <cstdio>
#include <cstdint>
namespace cg = cooperative_groups;

#ifndef MULTI_LAUNCH
#define MULTI_LAUNCH 0
#endif

#define DI __device__ __forceinline__
typedef unsigned short bf16_t;
typedef short bf16x8 __attribute__((ext_vector_type(8)));
typedef float f32x16 __attribute__((ext_vector_type(16)));
typedef float f32x4 __attribute__((ext_vector_type(4)));
typedef float f32x2 __attribute__((ext_vector_type(2)));
typedef unsigned u32x4 __attribute__((ext_vector_type(4)));
typedef unsigned u32x2 __attribute__((ext_vector_type(2)));
typedef __bf16 bf16x2_t __attribute__((ext_vector_type(2)));

constexpr int SEQ = 16384, CTX = 256, DM = 1024, TL = 32768, TC = 512, TA = 33280, NP = 3328, DFF = 4096, UA = 16640;
constexpr int NCHUNK = 260;
constexpr float EPS = 1e-6f, LOG2E = 1.4426950408889634f;
constexpr int SMEM_BYTES = 73728;
constexpr int LDS_STRIDE = 144;

#define MFMA32(a, b, c) __builtin_amdgcn_mfma_f32_32x32x16_bf16((a), (b), (c), 0, 0, 0)

DI unsigned pk2(float a, float b) { f32x2 v = {a, b}; return __builtin_bit_cast(unsigned, __builtin_convertvector(v, bf16x2_t)); }
DI float bf_lo(unsigned u) { return __uint_as_float(u << 16); }
DI float bf_hi(unsigned u) { return __uint_as_float(u & 0xffff0000u); }
DI bf16_t tobf(float a) { return (bf16_t)(pk2(a, 0.f) & 0xffffu); }
DI float fexp2(float x) { return __builtin_amdgcn_exp2f(x); }
DI void sum16_nopk(float& acc, const float (&pe)[16]) {
  asm volatile("s_nop 0\n\tv_add_f32 %0, %1, %0\n\tv_add_f32 %0, %2, %0\n\tv_add_f32 %0, %3, %0\n\tv_add_f32 %0, %4, %0\n\t"
               "v_add_f32 %0, %5, %0\n\tv_add_f32 %0, %6, %0\n\tv_add_f32 %0, %7, %0\n\tv_add_f32 %0, %8, %0\n\t"
               "v_add_f32 %0, %9, %0\n\tv_add_f32 %0, %10, %0\n\tv_add_f32 %0, %11, %0\n\tv_add_f32 %0, %12, %0\n\t"
               "v_add_f32 %0, %13, %0\n\tv_add_f32 %0, %14, %0\n\tv_add_f32 %0, %15, %0\n\tv_add_f32 %0, %16, %0"
               : "+v"(acc)
               : "v"(pe[0]), "v"(pe[1]), "v"(pe[2]), "v"(pe[3]), "v"(pe[4]), "v"(pe[5]), "v"(pe[6]), "v"(pe[7]),
                 "v"(pe[8]), "v"(pe[9]), "v"(pe[10]), "v"(pe[11]), "v"(pe[12]), "v"(pe[13]), "v"(pe[14]), "v"(pe[15]));
}
DI float wave_sum(float v) {
#pragma unroll
  for (int o = 32; o > 0; o >>= 1) v += __shfl_xor(v, o);
  return v;
}
DI float wave_max(float v) {
#pragma unroll
  for (int o = 32; o > 0; o >>= 1) v = fmaxf(v, __shfl_xor(v, o));
  return v;
}
DI int ltid() { int t = threadIdx.x & 255; asm volatile("" : "+v"(t)); return t; }
DI int ltid512() { int t = threadIdx.x; asm volatile("" : "+v"(t)); return t; }
DI unsigned xcc_id() { return (unsigned)__builtin_amdgcn_s_getreg((3 << 11) | 20) & 0xFu; }
DI int rowOfU(int b, int u) { return u < CTX ? TL + b * CTX + u : b * SEQ + (u - CTX); }

struct Params {
  const float *x, *c, *ctx, *c_ctx, *w_mod, *b_mod, *norm1_g, *norm2_g, *w_in, *w_out;
  const float *da_q_gain, *da_k_gain, *da_lambda, *da_sub_gain, *hg_lb_logits, *hg_out_gain;
  const float *na_q_gain, *na_k_gain, *na_rpb, *sw_q_gain, *sw_k_gain, *sw_sink, *w_ff1, *w_ff2;
  float* out;
  float* Xc;
  float* mod;
  float* Hdec;
  float* lbtab;
  bf16_t* WinT;
  bf16_t* WoutT;
  bf16_t* W1T;
  bf16_t* W2T;
  bf16_t* H;
  float* HL;
  bf16_t* P;
  bf16_t* MO;
  bf16_t* VtA;
  bf16_t* VtC;
  bf16_t* VtD;
  unsigned* xcnt;
};

DI void phase0(const Params& p, unsigned char* smem, int bid, int nb) {
  const int tid = ltid();
  constexpr int n_mod = 2 * 96;
  constexpr int t_in = 16 * 52, t_out = 16 * 16, t_f1 = 16 * 64, t_f2 = 64 * 16;
  constexpr int per_layer = t_in + t_out + t_f1 + t_f2;
  constexpr int total = n_mod + 2 * per_layer;
  float* fs = (float*)smem;
  if (bid == 0) {
    for (int i = tid; i < 512; i += 256) {
      const float l0 = p.hg_lb_logits[i], l1 = p.hg_lb_logits[512 + i];
      p.lbtab[i] = 0.f;
      p.lbtab[512 + i] = 1.f / (1.f + expf(l0 - l1));
    }
  }
  for (int it = bid; it < total; it += nb) {
    if (it < n_mod) {
      const int l = it / 96, col0 = (it % 96) * 64;
      float* sc = fs;
      float* red = fs + 3072;
      for (int i = tid; i < 3072; i += 256) {
        const int cond = i >> 10, k = i & 1023;
        const float v = cond == 0 ? p.c[k] : (cond == 1 ? p.c[1024 + k] : p.c_ctx[k]);
        sc[i] = v / (1.f + expf(-v));
      }
      __syncthreads();
      const int kg = tid >> 6, j = tid & 63;
      float a0 = 0.f, a1 = 0.f, a2 = 0.f;
      const float* wp = p.w_mod + ((size_t)l * 1024 + kg * 256) * 6144 + col0 + j;
#pragma unroll 8
      for (int k = 0; k < 256; ++k) {
        const float w = wp[(size_t)k * 6144];
        a0 += sc[kg * 256 + k] * w; a1 += sc[1024 + kg * 256 + k] * w; a2 += sc[2048 + kg * 256 + k] * w;
      }
      red[(kg * 3 + 0) * 64 + j] = a0; red[(kg * 3 + 1) * 64 + j] = a1; red[(kg * 3 + 2) * 64 + j] = a2;
      __syncthreads();
      if (tid < 192) {
        const int cond = tid >> 6, jj = tid & 63;
        float s = p.b_mod[l * 6144 + col0 + jj];
#pragma unroll
        for (int g = 0; g < 4; ++g) s += red[(g * 3 + cond) * 64 + jj];
        p.mod[(l * 3 + cond) * 6144 + col0 + jj] = s;
      }
    } else {
      int idx = it - n_mod;
      const int l = idx / per_layer; idx -= l * per_layer;
      const float* src; bf16_t* dst; int K, N;
      if (idx < t_in) { src = p.w_in + (size_t)l * 1024 * NP; dst = p.WinT + (size_t)l * NP * 1024; K = 1024; N = NP; }
      else if (idx < t_in + t_out) { idx -= t_in; src = p.w_out + (size_t)l * 1024 * 1024; dst = p.WoutT + (size_t)l * 1024 * 1024; K = 1024; N = 1024; }
      else if (idx < t_in + t_out + t_f1) { idx -= t_in + t_out; src = p.w_ff1 + (size_t)l * 1024 * DFF; dst = p.W1T + (size_t)l * DFF * 1024; K = 1024; N = DFF; }
      else { idx -= t_in + t_out + t_f1; src = p.w_ff2 + (size_t)l * DFF * 1024; dst = p.W2T + (size_t)l * 1024 * DFF; K = DFF; N = 1024; }
      const int ntn = N >> 6, kt = idx / ntn, nt = idx % ntn, k0 = kt * 64, n0 = nt * 64;
#pragma unroll
      for (int i = 0; i < 4; ++i) {
        const int r = (tid >> 4) + 16 * i, c4 = (tid & 15) * 4;
        const f32x4 v = *(const f32x4*)(src + (size_t)(k0 + r) * N + n0 + c4);
        fs[r * 65 + c4] = v[0]; fs[r * 65 + c4 + 1] = v[1]; fs[r * 65 + c4 + 2] = v[2]; fs[r * 65 + c4 + 3] = v[3];
      }
      __syncthreads();
      const int n = tid >> 2, kq = (tid & 3) * 16;
      u32x4 w0, w1;
#pragma unroll
      for (int i = 0; i < 4; ++i) {
        w0[i] = pk2(fs[(kq + 2 * i) * 65 + n], fs[(kq + 2 * i + 1) * 65 + n]);
        w1[i] = pk2(fs[(kq + 8 + 2 * i) * 65 + n], fs[(kq + 8 + 2 * i + 1) * 65 + n]);
      }
      bf16_t* dp = dst + (size_t)(n0 + n) * K + k0 + kq;
      *(u32x4*)dp = w0; *(u32x4*)(dp + 8) = w1;
    }
    __syncthreads();
  }
}

DI void norm_phase(const float* lat, const float* ctxp, int nrows, const float* g, const float* modl, int shift_off, int scale_off,
                   bf16_t* H, int bid, int nb) {
  const int wave = ltid() >> 6, lane = ltid() & 63;
  for (int r8 = bid; r8 < nrows / 8; r8 += nb) {
    f32x4 v[2][4]; float ss[2] = {0.f, 0.f};
#pragma unroll
    for (int h = 0; h < 2; ++h) {
      const int row = r8 * 8 + wave + 4 * h;
      const float* src = row < TL ? lat + (size_t)row * DM : ctxp + (size_t)(row - TL) * DM;
#pragma unroll
      for (int i = 0; i < 4; ++i) v[h][i] = *(const f32x4*)(src + lane * 4 + 256 * i);
    }
#pragma unroll
    for (int h = 0; h < 2; ++h) {
#pragma unroll
      for (int i = 0; i < 4; ++i) ss[h] += v[h][i][0] * v[h][i][0] + v[h][i][1] * v[h][i][1] + v[h][i][2] * v[h][i][2] + v[h][i][3] * v[h][i][3];
      ss[h] = wave_sum(ss[h]);
    }
#pragma unroll
    for (int h = 0; h < 2; ++h) {
      const int row = r8 * 8 + wave + 4 * h;
      const int mi = row < TL ? (row >> 14) : 2;
      const float* sh = modl + mi * 6144 + shift_off;
      const float* sc = modl + mi * 6144 + scale_off;
      const float rs = rsqrtf(ss[h] * (1.f / 1024.f) + EPS);
#pragma unroll
      for (int i = 0; i < 4; ++i) {
        const int col = lane * 4 + 256 * i;
        const f32x4 gg = *(const f32x4*)(g + col), s4 = *(const f32x4*)(sc + col), h4 = *(const f32x4*)(sh + col);
        float y[4];
#pragma unroll
        for (int j = 0; j < 4; ++j) y[j] = (v[h][i][j] * rs * gg[j]) * (1.f + s4[j]) + h4[j];
        u32x2 w; w[0] = pk2(y[0], y[1]); w[1] = pk2(y[2], y[3]);
        *(u32x2*)(H + (size_t)row * DM + col) = w;
      }
    }
  }
}

struct EpiBf16 {
  static constexpr bool kBf16 = true;
  DI static float act(float v) { return v; }
  bf16_t* O; int ldc;
  DI void operator()(int m, int n, f32x4 v) const {
    u32x2 w; w[0] = pk2(v[0], v[1]); w[1] = pk2(v[2], v[3]);
    *(u32x2*)(O + (size_t)m * ldc + n) = w;
  }
};
struct EpiRelu2 {
  static constexpr bool kBf16 = true;
  DI static float act(float v) { const float t = fmaxf(v, 0.f); return t * t; }
  bf16_t* O; int ldc;
  DI void operator()(int m, int n, f32x4 v) const {
    float y[4];
#pragma unroll
    for (int j = 0; j < 4; ++j) { const float t = fmaxf(v[j], 0.f); y[j] = t * t; }
    u32x2 w; w[0] = pk2(y[0], y[1]); w[1] = pk2(y[2], y[3]);
    *(u32x2*)(O + (size_t)m * ldc + n) = w;
  }
};
struct EpiResid {
  static constexpr bool kBf16 = false;
  const float* sl; const float* sc; float* dl; float* dc; const float* gate; int row0;
  DI void operator()(int m, int n, f32x4 v) const {
    const int row = m + row0;
    const float* s = row < TL ? sl + (size_t)row * DM : sc + (size_t)(row - TL) * DM;
    float* d = row < TL ? dl + (size_t)row * DM : dc + (size_t)(row - TL) * DM;
    const int mi = row < TL ? (row >> 14) : 2;
    const f32x4 g = *(const f32x4*)(gate + mi * 6144 + n);
    const f32x4 r = *(const f32x4*)(s + n);
    f32x4 o;
#pragma unroll
    for (int j = 0; j < 4; ++j) o[j] = r[j] + g[j] * v[j];
    *(f32x4*)(d + n) = o;
  }
};

template <class Epi>
DI void gemm_phase(const bf16_t* A, const bf16_t* Bt, int mtiles, int ntiles, int K, const Epi& epi, unsigned char* smem, int bid, int nb) {
  const int tid = ltid(), lane = tid & 63, wave = tid >> 6;
  const int wm = wave & 1, wn = wave >> 1, l31 = lane & 31, hh = lane >> 5;
  unsigned char* As0 = smem;
  unsigned char* Bs0 = smem + 2 * 128 * LDS_STRIDE;
  const int nk = K >> 6;
  const int ldrow = tid >> 3, ldcol = (tid & 7) * 8;
  const int total = mtiles * ntiles;
  const int xper = (nb >> 3) > 0 ? (nb >> 3) : 1;
  const int xcd = nb >= 8 ? (bid & 7) : 0, xj = nb >= 8 ? (bid >> 3) : bid, xstep = nb >= 8 ? 8 : 1;
  if (nb >= 8 && bid >= xper * 8) return;
  for (int ch = xcd; ch * xper + xj < total; ch += xstep) {
    const int it = ch * xper + xj;
    const int band = it / (8 * ntiles), rr = it - band * 8 * ntiles;
    const int rib = (mtiles - 8 * band) < 8 ? (mtiles - 8 * band) : 8;
    const int pn = rr / rib, pm = 8 * band + rr % rib;
    const bf16_t* Ap = A + (size_t)(pm * 128 + ldrow) * K + ldcol;
    const bf16_t* Bp = Bt + (size_t)(pn * 128 + ldrow) * K + ldcol;
    f32x16 acc[2][2];
#pragma unroll
    for (int a = 0; a < 2; ++a)
#pragma unroll
      for (int b = 0; b < 2; ++b)
#pragma unroll
        for (int i = 0; i < 16; ++i) acc[a][b][i] = 0.f;
    u32x4 ra0[4], rb0[4], ra1[4], rb1[4];
#define G_LOAD(RA, RB, KT) do { _Pragma("unroll") for (int i = 0; i < 4; ++i) { RA[i] = *(const u32x4*)(Ap + (size_t)i * 32 * K + (KT) * 64); RB[i] = *(const u32x4*)(Bp + (size_t)i * 32 * K + (KT) * 64); } } while (0)
#define G_STORE(RA, RB, BUF) do { unsigned char* Aw = As0 + (BUF) * 128 * LDS_STRIDE; unsigned char* Bw = Bs0 + (BUF) * 128 * LDS_STRIDE; \
      _Pragma("unroll") for (int i = 0; i < 4; ++i) { *(u32x4*)(Aw + (ldrow + 32 * i) * LDS_STRIDE + ldcol * 2) = RA[i]; *(u32x4*)(Bw + (ldrow + 32 * i) * LDS_STRIDE + ldcol * 2) = RB[i]; } } while (0)
#define G_COMPUTE(BUF) do { const unsigned char* As = As0 + (BUF) * 128 * LDS_STRIDE; const unsigned char* Bs = Bs0 + (BUF) * 128 * LDS_STRIDE; \
      _Pragma("unroll") for (int ks = 0; ks < 4; ++ks) { bf16x8 wf[2], af[2]; \
        _Pragma("unroll") for (int i = 0; i < 2; ++i) { \
          wf[i] = *(const bf16x8*)(Bs + (wn * 64 + i * 32 + l31) * LDS_STRIDE + (ks * 16 + 8 * hh) * 2); \
          af[i] = *(const bf16x8*)(As + (wm * 64 + i * 32 + l31) * LDS_STRIDE + (ks * 16 + 8 * hh) * 2); } \
        _Pragma("unroll") for (int ni = 0; ni < 2; ++ni) _Pragma("unroll") for (int mi = 0; mi < 2; ++mi) acc[ni][mi] = MFMA32(wf[ni], af[mi], acc[ni][mi]); } } while (0)
    G_LOAD(ra0, rb0, 0);
    G_LOAD(ra1, rb1, 1);
    G_STORE(ra0, rb0, 0);
    __syncthreads();
#pragma unroll 1
    for (int kt = 0; kt < nk; kt += 2) {
      const int k2 = kt + 2 < nk ? kt + 2 : 0, k3 = kt + 3 < nk ? kt + 3 : 1;
      G_LOAD(ra0, rb0, k2);
      G_COMPUTE(0);
      G_STORE(ra1, rb1, 1);
      __syncthreads();
      G_LOAD(ra1, rb1, k3);
      G_COMPUTE(1);
      G_STORE(ra0, rb0, 0);
      __syncthreads();
    }
#pragma unroll
    for (int ni = 0; ni < 2; ++ni)
#pragma unroll
      for (int mi = 0; mi < 2; ++mi) {
        const int m = pm * 128 + wm * 64 + mi * 32 + l31;
#pragma unroll
        for (int g = 0; g < 4; ++g) {
          const int n = pn * 128 + wn * 64 + ni * 32 + 8 * g + 4 * hh;
          f32x4 v = {acc[ni][mi][4 * g], acc[ni][mi][4 * g + 1], acc[ni][mi][4 * g + 2], acc[ni][mi][4 * g + 3]};
          epi(m, n, v);
        }
      }
  }
}

struct EpiResidAtomic {
  static constexpr bool kBf16 = false;
  float* dl; float* dc; const float* gate; int row0;
  DI void operator()(int m, int n, f32x4 v) const {
    const int row = m + row0;
    float* d = row < TL ? dl + (size_t)row * DM : dc + (size_t)(row - TL) * DM;
    const int mi = row < TL ? (row >> 14) : 2;
    const f32x4 g = *(const f32x4*)(gate + mi * 6144 + n);
#pragma unroll
    for (int j = 0; j < 4; ++j) unsafeAtomicAdd(d + n + j, g[j] * v[j]);
  }
};

template <class Epi>
DI void gemm_phase512(const bf16_t* A, const bf16_t* Bt, int mtiles, int ntiles, int K, int Kper, int ksplit, const Epi& epi,
                      unsigned char* smem, int bid, int nb) {
  const int tid = ltid512(), lane = tid & 63, wave = tid >> 6;
  const int wm = wave & 1, wn = wave >> 1, l31 = lane & 31, hh = lane >> 5;
  constexpr int OPB = 256 * LDS_STRIDE;
  unsigned char* As0 = smem;
  unsigned char* Bs0 = smem + 2 * OPB;
  const int nk = Kper >> 6;
  const int ldrow = tid >> 3, ldcol = (tid & 7) * 8;
  const int ntile = mtiles * ntiles, total = ntile * ksplit;
  for (int it = bid; it < total; it += nb) {
    const int tile = it / ksplit, ks = it - tile * ksplit;
    const int band = tile / (8 * ntiles), rr = tile - band * 8 * ntiles;
    const int rib = (mtiles - 8 * band) < 8 ? (mtiles - 8 * band) : 8;
    const int pn = rr / rib, pm = 8 * band + rr % rib;
    const bf16_t* Ap = A + (size_t)(pm * 256 + ldrow) * K + ks * Kper + ldcol;
    const bf16_t* Bp = Bt + (size_t)(pn * 256 + ldrow) * K + ks * Kper + ldcol;
    f32x16 acc[2][4];
#pragma unroll
    for (int a = 0; a < 2; ++a)
#pragma unroll
      for (int b = 0; b < 4; ++b)
#pragma unroll
        for (int i = 0; i < 16; ++i) acc[a][b][i] = 0.f;
    u32x4 ra[4], rb[4];
#define H_LOAD(KT) do { _Pragma("unroll") for (int i = 0; i < 4; ++i) { ra[i] = *(const u32x4*)(Ap + (size_t)i * 64 * K + (KT) * 64); rb[i] = *(const u32x4*)(Bp + (size_t)i * 64 * K + (KT) * 64); } } while (0)
#define H_STORE(BUF) do { unsigned char* Aw = As0 + (BUF) * OPB; unsigned char* Bw = Bs0 + (BUF) * OPB; \
      _Pragma("unroll") for (int i = 0; i < 4; ++i) { *(u32x4*)(Aw + (ldrow + 64 * i) * LDS_STRIDE + ldcol * 2) = ra[i]; *(u32x4*)(Bw + (ldrow + 64 * i) * LDS_STRIDE + ldcol * 2) = rb[i]; } } while (0)
    H_LOAD(0);
    H_STORE(0);
    H_LOAD(1);
    __syncthreads();
#pragma unroll 1
    for (int kt = 0; kt < nk; ++kt) {
      const int buf = kt & 1;
      const int kn = kt + 2 < nk ? kt + 2 : 0;
      const unsigned char* As = As0 + buf * OPB;
      const unsigned char* Bs = Bs0 + buf * OPB;
      unsigned char* Aw = As0 + (buf ^ 1) * OPB;
      unsigned char* Bw = Bs0 + (buf ^ 1) * OPB;
#pragma unroll
      for (int k16 = 0; k16 < 4; ++k16) {
        bf16x8 wf[2], af[4];
#pragma unroll
        for (int i = 0; i < 2; ++i) wf[i] = *(const bf16x8*)(Bs + (wn * 64 + i * 32 + l31) * LDS_STRIDE + (k16 * 16 + 8 * hh) * 2);
#pragma unroll
        for (int i = 0; i < 4; ++i) af[i] = *(const bf16x8*)(As + (wm * 128 + i * 32 + l31) * LDS_STRIDE + (k16 * 16 + 8 * hh) * 2);
#pragma unroll
        for (int ni = 0; ni < 2; ++ni)
#pragma unroll
          for (int mi = 0; mi < 4; ++mi) acc[ni][mi] = MFMA32(wf[ni], af[mi], acc[ni][mi]);
        *(u32x4*)(Aw + (ldrow + 64 * k16) * LDS_STRIDE + ldcol * 2) = ra[k16];
        *(u32x4*)(Bw + (ldrow + 64 * k16) * LDS_STRIDE + ldcol * 2) = rb[k16];
        ra[k16] = *(const u32x4*)(Ap + (size_t)k16 * 64 * K + kn * 64);
        rb[k16] = *(const u32x4*)(Bp + (size_t)k16 * 64 * K + kn * 64);
        __builtin_amdgcn_sched_barrier(0);
      }
      __syncthreads();
    }
    {
      unsigned char* wl = smem + wave * 18432;
      const int m0 = pm * 256 + wm * 128, n0 = pn * 256 + wn * 64;
      if constexpr (Epi::kBf16) {
#pragma unroll
        for (int ni = 0; ni < 2; ++ni)
#pragma unroll
          for (int mi = 0; mi < 4; ++mi)
#pragma unroll
            for (int g = 0; g < 4; ++g) {
              u32x2 w;
              w[0] = pk2(Epi::act(acc[ni][mi][4 * g]), Epi::act(acc[ni][mi][4 * g + 1]));
              w[1] = pk2(Epi::act(acc[ni][mi][4 * g + 2]), Epi::act(acc[ni][mi][4 * g + 3]));
              *(u32x2*)(wl + (mi * 32 + l31) * LDS_STRIDE + (ni * 32 + 8 * g + 4 * hh) * 2) = w;
            }
        asm volatile("" ::: "memory");
#pragma unroll
        for (int i = 0; i < 16; ++i) {
          const int row = (lane >> 3) + 8 * i, ch = lane & 7;
          const u32x4 w = *(const u32x4*)(wl + row * LDS_STRIDE + ch * 16);
          *(u32x4*)(epi.O + (size_t)(m0 + row) * epi.ldc + n0 + ch * 8) = w;
        }
      } else {
#pragma unroll
        for (int half = 0; half < 2; ++half) {
          if (half) asm volatile("" ::: "memory");
#pragma unroll
          for (int ni = 0; ni < 2; ++ni)
#pragma unroll
            for (int mh = 0; mh < 2; ++mh)
#pragma unroll
              for (int g = 0; g < 4; ++g) {
                const int mi = 2 * half + mh;
                f32x4 v = {acc[ni][mi][4 * g], acc[ni][mi][4 * g + 1], acc[ni][mi][4 * g + 2], acc[ni][mi][4 * g + 3]};
                *(f32x4*)(wl + (mh * 32 + l31) * 272 + (ni * 32 + 8 * g + 4 * hh) * 4) = v;
              }
          asm volatile("" ::: "memory");
#pragma unroll
          for (int i = 0; i < 16; ++i) {
            const int row = (lane >> 4) + 4 * i, ch = lane & 15;
            const f32x4 v = *(const f32x4*)(wl + row * 272 + ch * 16);
            epi(m0 + half * 64 + row, n0 + ch * 4, v);
          }
        }
      }
    }
    __syncthreads();
  }
}

DI float hg_lb(const Params& p, int layer, int d, int j) { return p.lbtab[(layer * 2 + d) * 256 + j]; }

DI void prep32_item(const Params& p, int layer, int it) {
  const int idx = it * 256 + ltid();
  const int row = idx >> 4, j = idx & 15, isk = j >> 3, sub = j & 7;
  bf16_t* ptr = p.P + (size_t)row * NP + isk * 256 + sub * 32;
  const float* gain = (isk ? p.da_k_gain : p.da_q_gain) + layer * 32;
  float v[32];
#pragma unroll
  for (int i = 0; i < 4; ++i) {
    const u32x4 w = *(const u32x4*)(ptr + 8 * i);
#pragma unroll
    for (int q = 0; q < 4; ++q) { v[8 * i + 2 * q] = bf_lo(w[q]); v[8 * i + 2 * q + 1] = bf_hi(w[q]); }
  }
  float ss = 0.f;
#pragma unroll
  for (int i = 0; i < 32; ++i) ss += v[i] * v[i];
  const float r = rsqrtf(ss * (1.f / 32.f) + EPS);
#pragma unroll
  for (int i = 0; i < 32; ++i) v[i] = v[i] * r * gain[i];
  if (row < TL) {
    const int t = row & (SEQ - 1);
    const float gr = (float)(t >> 6), gc = (float)(t & 63);
#pragma unroll
    for (int i = 0; i < 8; ++i) {
      constexpr float FRA[8] = {1.f, 0.31622776601683794f, 0.1f, 0.031622776601683794f, 0.01f, 0.0031622776601683794f, 0.001f, 0.00031622776601683794f};
      const float fr = FRA[i];
      const float ar = gr * fr, ac = gc * fr;
      const float cr = __cosf(ar), sr = __sinf(ar), cc = __cosf(ac), sc = __sinf(ac);
      const float x1 = v[i], x2 = v[8 + i];
      v[i] = x1 * cr - x2 * sr; v[8 + i] = x1 * sr + x2 * cr;
      const float y1 = v[16 + i], y2 = v[24 + i];
      v[16 + i] = y1 * cc - y2 * sc; v[24 + i] = y1 * sc + y2 * cc;
    }
  }
  const float qs = isk ? 1.f : (0.17677669529663687f * LOG2E);
#pragma unroll
  for (int i = 0; i < 4; ++i) {
    u32x4 w;
#pragma unroll
    for (int q = 0; q < 4; ++q) w[q] = pk2(v[8 * i + 2 * q] * qs, v[8 * i + 2 * q + 1] * qs);
    *(u32x4*)(ptr + 8 * i) = w;
  }
}

DI void prep64_item(const Params& p, int layer, int it) {
  const int idx = it * 256 + ltid();
  const int row = idx / 14, j = idx % 14;
  int col; const float* gain; bool rope, isq;
  if (j < 4) { col = 2048 + 64 * j; gain = p.na_q_gain; rope = false; isq = true; }
  else if (j < 8) { col = 2304 + 64 * (j - 4); gain = p.na_k_gain; rope = false; isq = false; }
  else if (j < 12) { col = 2816 + 64 * (j - 8); gain = p.sw_q_gain; rope = true; isq = true; }
  else { col = 3072 + 64 * (j - 12); gain = p.sw_k_gain; rope = true; isq = false; }
  gain += layer * 64;
  bf16_t* ptr = p.P + (size_t)row * NP + col;
  float v[64];
#pragma unroll
  for (int i = 0; i < 8; ++i) {
    const u32x4 w = *(const u32x4*)(ptr + 8 * i);
#pragma unroll
    for (int q = 0; q < 4; ++q) { v[8 * i + 2 * q] = bf_lo(w[q]); v[8 * i + 2 * q + 1] = bf_hi(w[q]); }
  }
  float ss = 0.f;
#pragma unroll
  for (int i = 0; i < 64; ++i) ss += v[i] * v[i];
  const float r = rsqrtf(ss * (1.f / 64.f) + EPS);
#pragma unroll
  for (int i = 0; i < 64; ++i) v[i] = v[i] * r * gain[i];
  if (rope && row < TL) {
    const int t = row & (SEQ - 1);
    const float gr = (float)(t >> 6), gc = (float)(t & 63);
#pragma unroll
    for (int i = 0; i < 16; ++i) {
      constexpr float FRD[16] = {1.f, 0.5623413251903491f, 0.31622776601683794f, 0.1778279410038923f, 0.1f, 0.05623413251903491f, 0.031622776601683794f, 0.01778279410038923f, 0.01f, 0.005623413251903491f, 0.0031622776601683794f, 0.001778279410038923f, 0.001f, 0.0005623413251903491f, 0.00031622776601683794f, 0.0001778279410038923f};
      const float fr = FRD[i];
      const float ar = gr * fr, ac = gc * fr;
      const float cr = __cosf(ar), sr = __sinf(ar), cc = __cosf(ac), sc = __sinf(ac);
      const float x1 = v[i], x2 = v[16 + i];
      v[i] = x1 * cr - x2 * sr; v[16 + i] = x1 * sr + x2 * cr;
      const float y1 = v[32 + i], y2 = v[48 + i];
      v[32 + i] = y1 * cc - y2 * sc; v[48 + i] = y1 * sc + y2 * cc;
    }
  }
  const float qs = isq ? (0.125f * LOG2E) : 1.f;
#pragma unroll
  for (int i = 0; i < 8; ++i) {
    u32x4 w;
#pragma unroll
    for (int q = 0; q < 4; ++q) w[q] = pk2(v[8 * i + 2 * q] * qs, v[8 * i + 2 * q + 1] * qs);
    *(u32x4*)(ptr + 8 * i) = w;
  }
}

DI void vt_item(const Params& p, int it, unsigned char* smem) {
  const int tid = ltid();
  const int hv = it % 10, ug = (it / 10) % NCHUNK, b = it / (10 * NCHUNK);
  int vcol; bf16_t* dst;
  if (hv < 4) { vcol = 512 + 64 * hv; dst = p.VtA + (size_t)(b * 4 + hv) * 64 * UA; }
  else if (hv < 8) { vcol = 2560 + 64 * (hv - 4); dst = p.VtC + (size_t)(b * 4 + hv - 4) * 64 * UA; }
  else { vcol = 3200 + 64 * (hv - 8); dst = p.VtD + (size_t)(b * 2 + hv - 8) * 64 * UA; }
  const int u0 = ug * 64;
  bf16_t* tile = (bf16_t*)smem;
  {
    const int tk = tid >> 2, seg = (tid & 3) * 16;
    const int row = rowOfU(b, u0 + tk);
    const bf16_t* src = p.P + (size_t)row * NP + vcol + seg;
    const u32x4 w0 = *(const u32x4*)src, w1 = *(const u32x4*)(src + 8);
    unsigned* tp = (unsigned*)(tile + tk * 66 + seg);
#pragma unroll
    for (int q = 0; q < 4; ++q) { tp[q] = w0[q]; tp[4 + q] = w1[q]; }
  }
  __syncthreads();
  {
    const int dv = tid >> 2, tq = (tid & 3) * 16;
    u32x4 w0, w1;
#pragma unroll
    for (int q = 0; q < 4; ++q) {
      w0[q] = (unsigned)tile[(tq + 2 * q) * 66 + dv] | ((unsigned)tile[(tq + 2 * q + 1) * 66 + dv] << 16);
      w1[q] = (unsigned)tile[(tq + 8 + 2 * q) * 66 + dv] | ((unsigned)tile[(tq + 8 + 2 * q + 1) * 66 + dv] << 16);
    }
    bf16_t* dp = dst + (size_t)dv * UA + u0 + tq;
    *(u32x4*)dp = w0; *(u32x4*)(dp + 8) = w1;
  }
  __syncthreads();
}

DI int hg_row(int b, int d, int n, int pp) {
  if (n < 4) { const int c = d ? 255 - (64 * n + pp) : 64 * n + pp; return TL + b * CTX + c; }
  const int t = d ? SEQ - 1 - (64 * (n - 4) + pp) : 64 * (n - 4) + pp;
  return b * SEQ + t;
}

#define MFMA16(a, b, c) __builtin_amdgcn_mfma_f32_16x16x32_bf16((a), (b), (c), 0, 0, 0)
DI bf16x8 pack8(const f32x4& a, const f32x4& b) {
  u32x4 w; w[0] = pk2(a[0], a[1]); w[1] = pk2(a[2], a[3]); w[2] = pk2(b[0], b[1]); w[3] = pk2(b[2], b[3]);
  return __builtin_bit_cast(bf16x8, w);
}

DI void prefix64(float* cumT, float* psum, int tid, float (&c)[16]) {
  const int k = tid & 63, qd = tid >> 6;
  float* row = cumT + k * 68 + 16 * qd;
#pragma unroll
  for (int i4 = 0; i4 < 4; ++i4) { const f32x4 t = *(const f32x4*)(row + 4 * i4); c[4 * i4] = t[0]; c[4 * i4 + 1] = t[1]; c[4 * i4 + 2] = t[2]; c[4 * i4 + 3] = t[3]; }
#pragma unroll
  for (int i = 1; i < 16; ++i) c[i] += c[i - 1];
  psum[qd * 64 + k] = c[15];
  __syncthreads();
  float off = 0.f;
#pragma unroll
  for (int q = 0; q < 3; ++q) off += (q < qd) ? psum[q * 64 + k] : 0.f;
#pragma unroll
  for (int i = 0; i < 16; ++i) c[i] += off;
#pragma unroll
  for (int i4 = 0; i4 < 4; ++i4) { f32x4 t = {c[4 * i4], c[4 * i4 + 1], c[4 * i4 + 2], c[4 * i4 + 3]}; *(f32x4*)(row + 4 * i4) = t; }
}

DI void hgsum_item(const Params& p, int layer, int it, unsigned char* smem) {
  const int tid = ltid();
  const int n = it % NCHUNK, chain = it / NCHUNK, d = chain & 1, hh = (chain >> 1) & 3, b = chain >> 3;
  float* cumT = (float*)smem;
  float* wT = cumT + 64 * 68;
  float* vT = wT + 64 * 68;
  float* psum = vT + 64 * 68;
  const int pp = tid >> 2, kq = (tid & 3) * 16;
  {
    const int row = hg_row(b, d, n, pp);
    const bf16_t* pr = p.P + (size_t)row * NP;
    const bf16_t* fp = pr + 1536 + d * 256 + hh * 64 + kq;
    const bf16_t* vp = pr + 1024 + hh * 64 + kq;
    const u32x4 f0 = *(const u32x4*)fp, f1 = *(const u32x4*)(fp + 8), v0 = *(const u32x4*)vp, v1 = *(const u32x4*)(vp + 8);
    float fx[16], vx[16];
#pragma unroll
    for (int q = 0; q < 4; ++q) { fx[2 * q] = bf_lo(f0[q]); fx[2 * q + 1] = bf_hi(f0[q]); fx[8 + 2 * q] = bf_lo(f1[q]); fx[8 + 2 * q + 1] = bf_hi(f1[q]);
                                  vx[2 * q] = bf_lo(v0[q]); vx[2 * q + 1] = bf_hi(v0[q]); vx[8 + 2 * q] = bf_lo(v1[q]); vx[8 + 2 * q + 1] = bf_hi(v1[q]); }
#pragma unroll
    for (int j = 0; j < 16; ++j) {
      const float lb = hg_lb(p, layer, d, hh * 64 + kq + j);
      const float sg = 1.f / (1.f + expf(-fx[j]));
      const float f = lb + (1.f - lb) * sg;
      cumT[(kq + j) * 68 + pp] = logf(f) * LOG2E;
      wT[(kq + j) * 68 + pp] = 1.f - f;
      vT[(kq + j) * 68 + pp] = vx[j];
    }
  }
  __syncthreads();
  { float c[16]; prefix64(cumT, psum, tid, c); }
  __syncthreads();
#pragma unroll
  for (int j = 0; j < 16; ++j) {
    const int k = kq + j;
    wT[k * 68 + pp] *= fexp2(cumT[k * 68 + 63] - cumT[k * 68 + pp]);
  }
  __syncthreads();
  {
    const int wv = tid >> 6, lane = tid & 63, lc = lane & 15, lq = lane >> 4;
    f32x4 acc[4];
#pragma unroll
    for (int vt = 0; vt < 4; ++vt) acc[vt] = (f32x4){0.f, 0.f, 0.f, 0.f};
#pragma unroll
    for (int ks = 0; ks < 2; ++ks) {
      const float* ar = wT + (16 * wv + lc) * 68 + 32 * ks + 8 * lq;
      const bf16x8 af = pack8(*(const f32x4*)ar, *(const f32x4*)(ar + 4));
#pragma unroll
      for (int vt = 0; vt < 4; ++vt) {
        const float* br = vT + (16 * vt + lc) * 68 + 32 * ks + 8 * lq;
        const bf16x8 bf = pack8(*(const f32x4*)br, *(const f32x4*)(br + 4));
        acc[vt] = MFMA16(af, bf, acc[vt]);
      }
    }
    float* L = p.HL + ((size_t)(chain * NCHUNK + n)) * 4096;
#pragma unroll
    for (int vt = 0; vt < 4; ++vt)
#pragma unroll
      for (int i = 0; i < 4; ++i) L[(16 * wv + 4 * lq + i) * 64 + 16 * vt + lc] = acc[vt][i];
    if (tid < 64) p.Hdec[(chain * NCHUNK + n) * 64 + tid] = fexp2(cumT[tid * 68 + 63]);
  }
  __syncthreads();
}

DI void prep_phase(const Params& p, int layer, unsigned char* smem, int bid, int nb) {
  constexpr int n_hg = 16 * NCHUNK;
  constexpr int n_vt = 2 * NCHUNK * 10;
  constexpr int n_p32 = TA * 16 / 256;
  constexpr int n_p64 = TA * 14 / 256;
  constexpr int total = n_hg + n_vt + n_p32 + n_p64;
  for (int it = bid; it < total; it += nb) {
    if (it < n_hg) hgsum_item(p, layer, it, smem);
    else if (it < n_hg + n_vt) vt_item(p, it - n_hg, smem);
    else if (it < n_hg + n_vt + n_p32) prep32_item(p, layer, it - n_hg - n_vt);
    else prep64_item(p, layer, it - n_hg - n_vt - n_p32);
  }
}

DI void scan_item(const Params& p, int it) {
  const int chain = it >> 4, e = (it & 15) * 256 + ltid(), k = e >> 6;
  float* L = p.HL + (size_t)chain * NCHUNK * 4096 + e;
  const float* dc = p.Hdec + chain * NCHUNK * 64 + k;
  float S = 0.f;
  for (int n0 = 0; n0 < NCHUNK; n0 += 26) {
    float l[26], dd[26];
#pragma unroll
    for (int j = 0; j < 26; ++j) { l[j] = L[(size_t)(n0 + j) * 4096]; dd[j] = dc[(n0 + j) * 64]; }
#pragma unroll
    for (int j = 0; j < 26; ++j) { L[(size_t)(n0 + j) * 4096] = S; S = dd[j] * S + l[j]; }
  }
}

DI void attnA_block(const Params& p, int layer, unsigned char* smem, int b, int h, int qrow_blk, int ubeg, int uend) {
  const int tid = ltid512(), wave = tid >> 6;
  const int lane = tid & 63, qi = lane & 31, hh = lane >> 5;
  const int qrow0 = qrow_blk + wave * 32;
  const int pr = (qi & 19) | ((qi & 4) << 1) | ((qi & 8) >> 1);
  const float lam_init = layer == 0 ? 0.2f : 0.35550906759096f;
  float gq = lane < 32 ? fabsf(p.da_q_gain[layer * 32 + lane]) : 0.f, gk = lane < 32 ? fabsf(p.da_k_gain[layer * 32 + lane]) : 0.f;
  gq = wave_max(gq); gk = wave_max(gk);
  const float negM2 = -(0.17677669529663687f * LOG2E * 32.f * 1.02f) * gq * gk;
  float la = 0.f, lb_ = 0.f;
  if (lane < 32) { const float* lv = p.da_lambda + layer * 128; la = lv[lane] * lv[32 + lane]; lb_ = lv[64 + lane] * lv[96 + lane]; }
  la = wave_sum(la); lb_ = wave_sum(lb_);
  const float lam = expf(la) - expf(lb_) + lam_init;

  const bf16_t* qp = p.P + (size_t)(qrow0 + qi) * NP + h * 64 + 8 * hh;
  bf16x8 qf[2][2];
#pragma unroll
  for (int m = 0; m < 2; ++m)
#pragma unroll
    for (int ks = 0; ks < 2; ++ks) qf[m][ks] = *(const bf16x8*)(qp + m * 32 + ks * 16);
  f32x16 o[2][2];
#pragma unroll
  for (int m = 0; m < 2; ++m)
#pragma unroll
    for (int dh = 0; dh < 2; ++dh)
#pragma unroll
      for (int i = 0; i < 16; ++i) o[m][dh][i] = 0.f;
  float ls[2] = {0.f, 0.f};
  constexpr int VSTR = 272, KBYTES = 128 * LDS_STRIDE, STG = KBYTES + 64 * VSTR;
  const int krow = tid >> 3, kch = tid & 7;
  const int vrow = tid >> 4, vch = tid & 15;
  const bf16_t* kg = p.P + 256 + h * 64 + kch * 8;
  const bf16_t* vg = p.VtA + ((size_t)((b * 4 + h) * 64 + vrow)) * UA + vch * 8;
  u32x4 rk0, rk1, rv0, rv1;
  rk0 = *(const u32x4*)(kg + (size_t)rowOfU(b, ubeg + krow) * NP);
  rk1 = *(const u32x4*)(kg + (size_t)rowOfU(b, ubeg + krow + 64) * NP);
  rv0 = *(const u32x4*)(vg + ubeg);
  rv1 = *(const u32x4*)(vg + (size_t)32 * UA + ubeg);
  __syncthreads();
  asm volatile("" :: "v"(qf[0][0]), "v"(qf[0][1]), "v"(qf[1][0]), "v"(qf[1][1]));
  {
    unsigned char* Ks = smem; unsigned char* Vs = smem + KBYTES;
    *(u32x4*)(Ks + krow * LDS_STRIDE + kch * 16) = rk0; *(u32x4*)(Ks + (krow + 64) * LDS_STRIDE + kch * 16) = rk1;
    *(u32x4*)(Vs + vrow * VSTR + vch * 16) = rv0; *(u32x4*)(Vs + (vrow + 32) * VSTR + vch * 16) = rv1;
  }
  __syncthreads();
  int buf = 0;
  for (int u0 = ubeg; u0 < uend; u0 += 128) {
    const int un = u0 + 128 < uend ? u0 + 128 : ubeg;
    rk0 = *(const u32x4*)(kg + (size_t)rowOfU(b, un + krow) * NP);
    rk1 = *(const u32x4*)(kg + (size_t)rowOfU(b, un + krow + 64) * NP);
    rv0 = *(const u32x4*)(vg + un);
    rv1 = *(const u32x4*)(vg + (size_t)32 * UA + un);
    const unsigned char* Ks = smem + buf * STG;
    const unsigned char* Vs = Ks + KBYTES;
    f32x16 sc[2], sn[2];
#define A_QK(SUB, DST) do { _Pragma("unroll") for (int m = 0; m < 2; ++m) { \
      const unsigned char* kr = Ks + (32 * (SUB) + pr) * LDS_STRIDE + (m * 32 + 8 * hh) * 2; \
      const bf16x8 kf0 = *(const bf16x8*)kr, kf1 = *(const bf16x8*)(kr + 32); \
      f32x16 t_; _Pragma("unroll") for (int i = 0; i < 16; ++i) t_[i] = negM2; \
      t_ = MFMA32(kf0, qf[m][0], t_); DST[m] = MFMA32(kf1, qf[m][1], t_); } } while (0)
    A_QK(0, sc);
#pragma unroll
    for (int sub = 0; sub < 4; ++sub) {
      if (sub < 3) A_QK(sub + 1, sn);
      bf16x8 vf[2][2];
#pragma unroll
      for (int dh = 0; dh < 2; ++dh)
#pragma unroll
        for (int s2 = 0; s2 < 2; ++s2) vf[dh][s2] = *(const bf16x8*)(Vs + (32 * dh + qi) * VSTR + (32 * sub + 16 * s2 + 8 * hh) * 2);
#pragma unroll
      for (int m = 0; m < 2; ++m) {
        float pe[16];
#pragma unroll
        for (int i = 0; i < 16; ++i) pe[i] = fexp2(sc[m][i]);
        sum16_nopk(ls[m], pe);
#pragma unroll
        for (int s2 = 0; s2 < 2; ++s2) {
          u32x4 pw;
#pragma unroll
          for (int q = 0; q < 4; ++q) pw[q] = pk2(pe[8 * s2 + 2 * q], pe[8 * s2 + 2 * q + 1]);
          const bf16x8 pf = __builtin_bit_cast(bf16x8, pw);
#pragma unroll
          for (int dh = 0; dh < 2; ++dh) o[m][dh] = MFMA32(vf[dh][s2], pf, o[m][dh]);
        }
      }
      if (sub < 3) { sc[0] = sn[0]; sc[1] = sn[1]; }
    }
    {
      unsigned char* Kw = smem + (buf ^ 1) * STG; unsigned char* Vw = Kw + KBYTES;
      *(u32x4*)(Kw + krow * LDS_STRIDE + kch * 16) = rk0; *(u32x4*)(Kw + (krow + 64) * LDS_STRIDE + kch * 16) = rk1;
      *(u32x4*)(Vw + vrow * VSTR + vch * 16) = rv0; *(u32x4*)(Vw + (vrow + 32) * VSTR + vch * 16) = rv1;
    }
    __syncthreads();
    buf ^= 1;
  }
  const float l0 = ls[0] + __shfl_xor(ls[0], 32), l1 = ls[1] + __shfl_xor(ls[1], 32);
  const float i0 = 1.f / l0, c1 = lam / l1;
  float ss = 0.f;
#pragma unroll
  for (int dh = 0; dh < 2; ++dh)
#pragma unroll
    for (int i = 0; i < 16; ++i) { const float v = o[0][dh][i] * i0 - o[1][dh][i] * c1; o[0][dh][i] = v; ss += v * v; }
  ss += __shfl_xor(ss, 32);
  const float r = rsqrtf(ss * (1.f / 64.f) + EPS) * (1.f - lam_init);
  bf16_t* op = p.MO + (size_t)(qrow0 + qi) * DM + h * 64;
  const float* sg = p.da_sub_gain + layer * 64;
#pragma unroll
  for (int dh = 0; dh < 2; ++dh)
#pragma unroll
    for (int g = 0; g < 4; ++g) {
      const int dv = 32 * dh + 8 * g + 4 * hh;
      const f32x4 g4 = *(const f32x4*)(sg + dv);
      u32x2 w;
      w[0] = pk2(o[0][dh][4 * g] * r * g4[0], o[0][dh][4 * g + 1] * r * g4[1]);
      w[1] = pk2(o[0][dh][4 * g + 2] * r * g4[2], o[0][dh][4 * g + 3] * r * g4[3]);
      *(u32x2*)(op + dv) = w;
    }
}

struct Frag64 { u32x4 k[4]; u32x4 v[4]; };
constexpr int W64_KB = 32 * LDS_STRIDE, W64_VSTR = 80, W64_BYTES = W64_KB + 64 * W64_VSTR;
DI void frag64_load(Frag64& f, const bf16_t* P, const bf16_t* vt, int b, int u, int kcol, int lane) {
#pragma unroll
  for (int i = 0; i < 4; ++i) {
    f.k[i] = *(const u32x4*)(P + (size_t)rowOfU(b, u + (lane >> 3) + 8 * i) * NP + kcol + (lane & 7) * 8);
    f.v[i] = *(const u32x4*)(vt + (size_t)((lane >> 2) + 16 * i) * UA + u + (lane & 3) * 8);
  }
}

template <int MODE>
DI void attn64_wave(const Params& p, int layer, int b, int hq, int qrow0, int t0, const float* rpb_lds, unsigned char* wlds) {
  constexpr bool isC = (MODE == 0 || MODE == 2);
  const int lane = ltid() & 63, qi = lane & 31, hh = lane >> 5;
  const int pr = (qi & 19) | ((qi & 4) << 1) | ((qi & 8) >> 1);
  const float* gqp = (isC ? p.na_q_gain : p.sw_q_gain) + layer * 64;
  const float* gkp = (isC ? p.na_k_gain : p.sw_k_gain) + layer * 64;
  const float gq = wave_max(fabsf(gqp[lane])), gk = wave_max(fabsf(gkp[lane]));
  const float negM2 = -(0.125f * LOG2E * 64.f * 1.02f) * gq * gk;
  const int kvh = isC ? hq : (hq >> 1);
  const int qcol = isC ? 2048 + 64 * hq : 2816 + 64 * hq;
  const int kcol = isC ? 2304 + 64 * hq : 3072 + 64 * kvh;
  const bf16_t* vt = isC ? p.VtC + (size_t)(b * 4 + hq) * 64 * UA : p.VtD + (size_t)(b * 2 + kvh) * 64 * UA;
  const bf16_t* qp = p.P + (size_t)(qrow0 + qi) * NP + qcol + 8 * hh;
  bf16x8 qf[4];
#pragma unroll
  for (int ks = 0; ks < 4; ++ks) qf[ks] = *(const bf16x8*)(qp + ks * 16);
  f32x16 o[2];
#pragma unroll
  for (int dh = 0; dh < 2; ++dh)
#pragma unroll
    for (int i = 0; i < 16; ++i) o[dh][i] = 0.f;
  float ls = 0.f;
  constexpr int NT = MODE == 0 ? 24 : (MODE == 1 ? 18 : 8);
  const int r = t0 >> 6, c = (t0 & 63) + qi;
  const int rs = min(max(r - 4, 0), 248), ws = min(max(c - 8, 0), 48);
  const float* rpb = rpb_lds + hq * 465;
  const int qt = t0 + qi;
  auto tile_u = [&](int t) -> int {
    if (t < 8) return 32 * t;
    if (MODE == 0) return CTX + (rs + ((t - 8) >> 1)) * 64 + ((t - 8) & 1) * 32;
    const int kt0 = t0 - 128 + 32 * (t - 8);
    return CTX + min(max(kt0, 0), SEQ - 32);
  };
  auto load_tile = [&](Frag64& f, int t) { frag64_load(f, p.P, vt, b, tile_u(t), kcol, lane); };
  unsigned char* Kw = wlds; unsigned char* Vw = wlds + W64_KB;
  auto compute_tile = [&](const Frag64& f, int t) {
#pragma unroll
    for (int i = 0; i < 4; ++i) {
      *(u32x4*)(Kw + ((lane >> 3) + 8 * i) * LDS_STRIDE + (lane & 7) * 16) = f.k[i];
      *(u32x4*)(Vw + ((lane >> 2) + 16 * i) * W64_VSTR + (lane & 3) * 16) = f.v[i];
    }
    bf16x8 kf[4], vf[2][2];
#pragma unroll
    for (int ks = 0; ks < 4; ++ks) kf[ks] = __builtin_bit_cast(bf16x8, *(const u32x4*)(Kw + pr * LDS_STRIDE + (16 * ks + 8 * hh) * 2));
#pragma unroll
    for (int dh = 0; dh < 2; ++dh)
#pragma unroll
      for (int s2 = 0; s2 < 2; ++s2) vf[dh][s2] = __builtin_bit_cast(bf16x8, *(const u32x4*)(Vw + (32 * dh + qi) * W64_VSTR + (16 * s2 + 8 * hh) * 2));
    f32x16 s;
#pragma unroll
    for (int i = 0; i < 16; ++i) s[i] = negM2;
#pragma unroll
    for (int ks = 0; ks < 4; ++ks) s = MFMA32(kf[ks], qf[ks], s);
    float pe[16];
    if (t < 8) {
#pragma unroll
      for (int i = 0; i < 16; ++i) pe[i] = fexp2(s[i]);
    } else if (MODE == 0) {
      const int kr = rs + ((t - 8) >> 1), hf = (t - 8) & 1;
      const float* rrow = rpb + (kr - r + 7) * 31 + 15 - c;
#pragma unroll
      for (int i = 0; i < 16; ++i) {
        const int kc = hf * 32 + 16 * (i >> 3) + 8 * hh + (i & 7);
        const bool valid = (kc >= ws) && (kc < ws + 16);
        const int kcc = min(max(kc, ws), ws + 15);
        pe[i] = fexp2(valid ? s[i] + rrow[kcc] : -1e30f);
      }
    } else {
      const int jt = t - 8, kt0 = t0 - 128 + 32 * jt;
      const bool tile_ok = (jt < 9) && (kt0 >= 0) && (kt0 < SEQ);
#pragma unroll
      for (int i = 0; i < 16; ++i) {
        const int dd = kt0 + 16 * (i >> 3) + 8 * hh + (i & 7) - qt;
        pe[i] = fexp2((tile_ok && dd <= 128 && dd >= -128) ? s[i] : -1e30f);
      }
    }
    sum16_nopk(ls, pe);
#pragma unroll
    for (int s2 = 0; s2 < 2; ++s2) {
      u32x4 pw;
#pragma unroll
      for (int q = 0; q < 4; ++q) pw[q] = pk2(pe[8 * s2 + 2 * q], pe[8 * s2 + 2 * q + 1]);
      const bf16x8 pf = __builtin_bit_cast(bf16x8, pw);
#pragma unroll
      for (int dh = 0; dh < 2; ++dh) o[dh] = MFMA32(vf[dh][s2], pf, o[dh]);
    }
  };
  Frag64 fa, fb;
  load_tile(fa, 0);
#pragma unroll 1
  for (int t = 0; t < NT; t += 2) {
    load_tile(fb, t + 1);
    compute_tile(fa, t);
    load_tile(fa, t + 2 < NT ? t + 2 : 0);
    compute_tile(fb, t + 1);
  }
  float l = ls + __shfl_xor(ls, 32);
  if (!isC) l += fexp2(p.sw_sink[layer * 4 + hq] * LOG2E + negM2);
  const float il = 1.f / l;
  bf16_t* op = p.MO + (size_t)(qrow0 + qi) * DM + (isC ? 512 : 768) + hq * 64;
#pragma unroll
  for (int dh = 0; dh < 2; ++dh)
#pragma unroll
    for (int g = 0; g < 4; ++g) {
      const int dv = 32 * dh + 8 * g + 4 * hh;
      u32x2 w;
      w[0] = pk2(o[dh][4 * g] * il, o[dh][4 * g + 1] * il);
      w[1] = pk2(o[dh][4 * g + 2] * il, o[dh][4 * g + 3] * il);
      *(u32x2*)(op + dv) = w;
    }
}

DI void mix_phase(const Params& p, int layer, unsigned char* smem, unsigned char* smem_all, int bid, int nb, int rrank) {
  const int wave = ltid() >> 6;
  const int n_scan = 256, n_lat = 1024, n_ctx = layer == 0 ? 16 : 0;
  const int e0 = n_scan, e1 = e0 + n_lat, e2 = e1 + n_ctx, e3 = e2 + n_lat, e4 = e3 + n_lat, e5 = e4 + n_ctx, e6 = e5 + n_ctx;
  {
    const int rnb_ = nb >> 1, per_r = (rnb_ >> 3) > 0 ? (rnb_ >> 3) : 1;
    const int bh = rrank / per_r, jj = rrank - bh * per_r;
    if (bh < 8)
      for (int qb = jj; qb < 64; qb += per_r) attnA_block(p, layer, smem_all, bh >> 2, bh & 3, (bh >> 2) * SEQ + qb * 256, 0, UA);
    if (layer == 0)
      for (int j = rrank; j < 8; j += rnb_) attnA_block(p, layer, smem_all, j >> 2, j & 3, TL + (j >> 2) * CTX, 0, CTX);
    __syncthreads();
  }
  float* rpb_lds = (float*)smem;
  for (int i = ltid(); i < 4 * 465; i += 256) rpb_lds[i] = p.na_rpb[layer * 4 * 465 + i] * LOG2E;
  __syncthreads();
  for (int it = 2 * rrank + (bid & 1); it < e6; it += nb) {
    if (it < e0) scan_item(p, it);
    else if (it < e1) {
    } else if (it < e2) {
    } else if (it < e3) {
      const int j = it - e2, qb = j & 127, hq = (j >> 7) & 3, b = j >> 9;
      const int t0 = qb * 128 + wave * 32;
      attn64_wave<1>(p, layer, b, hq, b * SEQ + t0, t0, rpb_lds, smem + 8192 + wave * W64_BYTES);
    } else if (it < e4) {
      const int j = it - e3, qb = j & 127, hq = (j >> 7) & 3, b = j >> 9;
      const int t0 = qb * 128 + wave * 32;
      attn64_wave<0>(p, layer, b, hq, b * SEQ + t0, t0, rpb_lds, smem + 8192 + wave * W64_BYTES);
    } else if (it < e5) {
      const int j = it - e4, qb = j & 1, hq = (j >> 1) & 3, b = j >> 3;
      attn64_wave<3>(p, layer, b, hq, TL + b * CTX + qb * 128 + wave * 32, 0, rpb_lds, smem + 8192 + wave * W64_BYTES);
    } else {
      const int j = it - e5, qb = j & 1, hq = (j >> 1) & 3, b = j >> 3;
      attn64_wave<2>(p, layer, b, hq, TL + b * CTX + qb * 128 + wave * 32, 0, rpb_lds, smem + 8192 + wave * W64_BYTES);
    }
  }
}


template <int D>
DI void hgrn_dir(const Params& p, int layer, unsigned char* smem, int b, int hh, int n, f32x4 (&acc)[4]) {
  const int tid = ltid();
  const int chain = (b * 4 + hh) * 2 + D;
  float* cumT = (float*)smem;
  float* qT = cumT + 64 * 68;
  float* kT = qT + 64 * 68;
  float* vT = kT + 64 * 68;
  float* psum = vT + 64 * 68;
  float kreg[16], qreg[16];
  {
    const int pp = tid >> 2, kq = (tid & 3) * 16;
    const int row = hg_row(b, D, n, pp);
    const bf16_t* pr = p.P + (size_t)row * NP;
    const bf16_t* qp = pr + 768 + hh * 64 + kq;
    const bf16_t* fp = pr + 1536 + D * 256 + hh * 64 + kq;
    const bf16_t* vp = pr + 1024 + hh * 64 + kq;
    const u32x4 q0 = *(const u32x4*)qp, q1 = *(const u32x4*)(qp + 8), f0 = *(const u32x4*)fp, f1 = *(const u32x4*)(fp + 8),
                v0 = *(const u32x4*)vp, v1 = *(const u32x4*)(vp + 8);
    const float* Sg = p.HL + ((size_t)(chain * NCHUNK + n)) * 4096 + tid * 16;
    f32x4 s4[4];
#pragma unroll
    for (int i = 0; i < 4; ++i) s4[i] = *(const f32x4*)(Sg + 4 * i);
    float qx[16], fx[16], vx[16];
#pragma unroll
    for (int q = 0; q < 4; ++q) {
      qx[2 * q] = bf_lo(q0[q]); qx[2 * q + 1] = bf_hi(q0[q]); qx[8 + 2 * q] = bf_lo(q1[q]); qx[8 + 2 * q + 1] = bf_hi(q1[q]);
      fx[2 * q] = bf_lo(f0[q]); fx[2 * q + 1] = bf_hi(f0[q]); fx[8 + 2 * q] = bf_lo(f1[q]); fx[8 + 2 * q + 1] = bf_hi(f1[q]);
      vx[2 * q] = bf_lo(v0[q]); vx[2 * q + 1] = bf_hi(v0[q]); vx[8 + 2 * q] = bf_lo(v1[q]); vx[8 + 2 * q + 1] = bf_hi(v1[q]);
    }
#pragma unroll
    for (int j = 0; j < 16; ++j) {
      const float lb = hg_lb(p, layer, D, hh * 64 + kq + j);
      const float sg = 1.f / (1.f + expf(-fx[j]));
      const float f = lb + (1.f - lb) * sg;
      cumT[(kq + j) * 68 + pp] = logf(f) * LOG2E;
      qT[(kq + j) * 68 + pp] = qx[j];
      qreg[j] = qx[j];
      kreg[j] = 1.f - f;
      vT[(kq + j) * 68 + pp] = vx[j];
      kT[(kq + j) * 68 + pp] = s4[j >> 2][j & 3];
    }
  }
  __syncthreads();
  {
    float c[16];
    prefix64(cumT, psum, tid, c);
    float* qrow = qT + (tid & 63) * 68 + 16 * (tid >> 6);
#pragma unroll
    for (int i4 = 0; i4 < 4; ++i4) {
      f32x4 t = *(const f32x4*)(qrow + 4 * i4);
#pragma unroll
      for (int a = 0; a < 4; ++a) t[a] *= fexp2(c[4 * i4 + a]);
      *(f32x4*)(qrow + 4 * i4) = t;
    }
  }
  __syncthreads();
  const int wv = tid >> 6, lane = tid & 63, lc = lane & 15, lq = lane >> 4;
  const int ppos = D ? 16 * (3 - wv) + 15 - lc : 16 * wv + lc;
  {
#pragma unroll
    for (int ks = 0; ks < 2; ++ks) {
      f32x4 b0, b1;
#pragma unroll
      for (int j = 0; j < 4; ++j) { b0[j] = qT[(32 * ks + 8 * lq + j) * 68 + ppos]; b1[j] = qT[(32 * ks + 8 * lq + 4 + j) * 68 + ppos]; }
      const bf16x8 bf = pack8(b0, b1);
#pragma unroll
      for (int vt = 0; vt < 4; ++vt) {
        const float* ar = kT + (16 * vt + lc) * 68 + 32 * ks + 8 * lq;
        const bf16x8 af = pack8(*(const f32x4*)ar, *(const f32x4*)(ar + 4));
        acc[vt] = MFMA16(af, bf, acc[vt]);
      }
    }
  }
  __syncthreads();
  {
    const int pp = tid >> 2, kq = (tid & 3) * 16;
#pragma unroll
    for (int j = 0; j < 16; ++j) { kT[(kq + j) * 68 + pp] = kreg[j]; qT[(kq + j) * 68 + pp] = qreg[j]; }
  }
  __syncthreads();
  {
    const int I = wv;
    bf16x8 af[2];
    float rf[2][8];
#pragma unroll
    for (int ks = 0; ks < 2; ++ks) {
      f32x4 a0, a1;
#pragma unroll
      for (int j = 0; j < 8; ++j) {
        const int k = 32 * ks + 8 * lq + j;
        rf[ks][j] = cumT[k * 68 + 16 * I];
        const float e = qT[k * 68 + 16 * I + lc] * fexp2(cumT[k * 68 + 16 * I + lc] - rf[ks][j]);
        if (j < 4) a0[j] = e; else a1[j - 4] = e;
      }
      af[ks] = pack8(a0, a1);
    }
    f32x4 cacc[4];
#pragma unroll
    for (int J = 0; J < 4; ++J) {
      cacc[J] = (f32x4){0.f, 0.f, 0.f, 0.f};
      if (J <= I) {
#pragma unroll
        for (int ks = 0; ks < 2; ++ks) {
          f32x4 b0, b1;
#pragma unroll
          for (int j = 0; j < 8; ++j) {
            const int k = 32 * ks + 8 * lq + j;
            const float e = kT[k * 68 + 16 * J + lc] * fexp2(fminf(rf[ks][j] - cumT[k * 68 + 16 * J + lc], 126.f));
            if (j < 4) b0[j] = e; else b1[j - 4] = e;
          }
          cacc[J] = MFMA16(af[ks], pack8(b0, b1), cacc[J]);
        }
      }
    }
    __syncthreads();
#pragma unroll
    for (int J = 0; J < 4; ++J)
#pragma unroll
      for (int i = 0; i < 4; ++i) {
        const int t = 16 * I + 4 * lq + i, s_ = 16 * J + lc;
        kT[t * 68 + s_] = (s_ <= t) ? cacc[J][i] : 0.f;
      }
  }
  __syncthreads();
  {
#pragma unroll
    for (int ks = 0; ks < 2; ++ks) {
      const float* br = kT + ppos * 68 + 32 * ks + 8 * lq;
      const bf16x8 bf = pack8(*(const f32x4*)br, *(const f32x4*)(br + 4));
#pragma unroll
      for (int vt = 0; vt < 4; ++vt) {
        const float* ar = vT + (16 * vt + lc) * 68 + 32 * ks + 8 * lq;
        const bf16x8 af = pack8(*(const f32x4*)ar, *(const f32x4*)(ar + 4));
        acc[vt] = MFMA16(af, bf, acc[vt]);
      }
    }
  }
  __syncthreads();
}

DI void hgout_phase(const Params& p, int layer, unsigned char* smem, int bid, int nb) {
  const int tid = ltid();
  const int n_lat = 2 * 4 * 256, n_ctx = layer == 0 ? 2 * 4 * 4 : 0;
  for (int it = bid; it < n_lat + n_ctx; it += nb) {
    int b, hh, n0, n1, rowbase;
    if (it < n_lat) { const int m = it & 255; hh = (it >> 8) & 3; b = it >> 10; n0 = 4 + m; n1 = 4 + 255 - m; rowbase = b * SEQ + 64 * m; }
    else { const int j = it - n_lat, mc = j & 3; hh = (j >> 2) & 3; b = j >> 4; n0 = mc; n1 = 3 - mc; rowbase = TL + b * CTX + 64 * mc; }
    f32x4 acc[4];
#pragma unroll
    for (int vt = 0; vt < 4; ++vt) acc[vt] = (f32x4){0.f, 0.f, 0.f, 0.f};
    hgrn_dir<0>(p, layer, smem, b, hh, n0, acc);
    hgrn_dir<1>(p, layer, smem, b, hh, n1, acc);
    const int wv = tid >> 6, lane = tid & 63, lc = lane & 15, lq = lane >> 4;
    const int row = rowbase + 16 * wv + lc;
    float ss = 0.f;
#pragma unroll
    for (int vt = 0; vt < 4; ++vt)
#pragma unroll
      for (int i = 0; i < 4; ++i) ss += acc[vt][i] * acc[vt][i];
    ss += __shfl_xor(ss, 16); ss += __shfl_xor(ss, 32);
    const float r = rsqrtf(ss * (1.f / 64.f) + EPS);
#pragma unroll
    for (int vt = 0; vt < 4; ++vt) {
      const int v0 = 16 * vt + 4 * lq;
      const f32x4 og = *(const f32x4*)(p.hg_out_gain + layer * 64 + v0);
      const u32x2 gw = *(const u32x2*)(p.P + (size_t)row * NP + 1280 + hh * 64 + v0);
      const float gx[4] = {bf_lo(gw[0]), bf_hi(gw[0]), bf_lo(gw[1]), bf_hi(gw[1])};
      float y[4];
#pragma unroll
      for (int i = 0; i < 4; ++i) y[i] = acc[vt][i] * r * og[i] * (gx[i] / (1.f + expf(-gx[i])));
      u32x2 w; w[0] = pk2(y[0], y[1]); w[1] = pk2(y[2], y[3]);
      *(u32x2*)(p.MO + (size_t)row * DM + 256 + hh * 64 + v0) = w;
    }
  }
}

#if MULTI_LAUNCH
#define SYNC_OR_RETURN(ph) do { if (phase_sel == (ph)) return; } while (0)
#define RUN(ph) (phase_sel == (ph))
#else
#define RUN(ph) (true)
#endif

__global__ void __launch_bounds__(512) fwd_kernel(Params p, int phase_sel) {
  __shared__ __attribute__((aligned(16))) unsigned char smem_all[2 * SMEM_BYTES];
  const int rbid = blockIdx.x, rnb = gridDim.x;
  const int vb = __builtin_amdgcn_readfirstlane((int)(threadIdx.x >> 8));
  const int bid = rbid * 2 + vb, nb = rnb * 2;
  unsigned char* smem = smem_all + vb * SMEM_BYTES;
#if !MULTI_LAUNCH
  cg::grid_group grid = cg::this_grid();
#define GSYNC() grid.sync()
#else
#define GSYNC() do {} while (0)
#endif
  __shared__ int s_rank[2];
  if (threadIdx.x == 0) { const unsigned x = xcc_id(); s_rank[0] = (int)x; s_rank[1] = (int)atomicAdd(&p.xcnt[x], 1u); }
  int ph = 0;
  if (RUN(ph)) phase0(p, smem, bid, nb);
  GSYNC(); ++ph;
  if (threadIdx.x == 0) {
    int r = s_rank[1];
    for (int y = 0; y < s_rank[0]; ++y) r += (int)__hip_atomic_load(&p.xcnt[y], __ATOMIC_RELAXED, __HIP_MEMORY_SCOPE_AGENT);
    s_rank[0] = r;
  }
  __syncthreads();
  const int rrank = __builtin_amdgcn_readfirstlane(s_rank[0]);
  for (int layer = 0; layer < 2; ++layer) {
    const float* modl = p.mod + layer * 3 * 6144;
    const float* rl = layer == 0 ? p.x : p.out;
    const float* rc = layer == 0 ? p.ctx : p.Xc;
    if (RUN(ph)) norm_phase(rl, rc, TA, p.norm1_g + layer * DM, modl, 0, 1024, p.H, bid, nb);
    GSYNC(); ++ph;
    if (RUN(ph)) { EpiBf16 e{p.P, NP}; gemm_phase512(p.H, p.WinT + (size_t)layer * NP * 1024, TA / 256, NP / 256, 1024, 1024, 1, e, smem_all, rrank, rnb); }
    GSYNC(); ++ph;
    if (RUN(ph)) prep_phase(p, layer, smem, bid, nb);
    GSYNC(); ++ph;
    if (RUN(ph)) mix_phase(p, layer, smem, smem_all, bid, nb, rrank);
    GSYNC(); ++ph;
    if (RUN(ph)) hgout_phase(p, layer, smem, bid, nb);
    GSYNC(); ++ph;
    const int mrows = layer == 0 ? TA : TL;
    if (RUN(ph)) { EpiResid e{rl, rc, p.out, p.Xc, modl + 2048, 0}; gemm_phase512(p.MO, p.WoutT + (size_t)layer * 1024 * 1024, mrows / 256, 4, 1024, 1024, 1, e, smem_all, rrank, rnb); }
    GSYNC(); ++ph;
    if (RUN(ph)) norm_phase(p.out, p.Xc, mrows, p.norm2_g + layer * DM, modl, 3072, 4096, p.H, bid, nb);
    GSYNC(); ++ph;
    const int nchunks = layer == 0 ? 3 : 2;
    for (int ch = 0; ch < nchunks; ++ch) {
      const int row0 = ch * 16384, rows = ch < 2 ? 16384 : TC;
      if (RUN(ph)) { EpiRelu2 e{p.P, DFF}; gemm_phase512(p.H + (size_t)row0 * DM, p.W1T + (size_t)layer * DFF * 1024, rows / 256, DFF / 256, 1024, 1024, 1, e, smem_all, rrank, rnb); }
      GSYNC(); ++ph;
      if (RUN(ph)) {
        if (ch < 2) { EpiResid e{p.out, p.Xc, p.out, p.Xc, modl + 5 * 1024, row0}; gemm_phase512(p.P, p.W2T + (size_t)layer * 1024 * DFF, rows / 256, 4, DFF, DFF, 1, e, smem_all, rrank, rnb); }
        else { EpiResidAtomic e{p.out, p.Xc, modl + 5 * 1024, row0}; gemm_phase512(p.P, p.W2T + (size_t)layer * 1024 * DFF, rows / 256, 4, DFF, 256, 16, e, smem_all, rrank, rnb); }
      }
      GSYNC(); ++ph;
    }
  }
}

static size_t align_up(size_t v) { return (v + 255) & ~(size_t)255; }

extern "C" void kernel_launch(void* const* d_in, const int* in_sizes, int n_in, void* d_out, int out_size, void* d_ws, size_t ws_size,
                              hipStream_t stream) {
  Params p{};
  const float** f = (const float**)&p;
  for (int i = 0; i < 24; ++i) f[i] = (const float*)d_in[i];
  p.out = (float*)d_out;
  unsigned char* w = (unsigned char*)d_ws; size_t off = 0;
  auto take = [&](size_t bytes) { void* r = w + off; off = align_up(off + bytes); return r; };
  p.Xc = (float*)take((size_t)TC * DM * 4);
  p.mod = (float*)take((size_t)2 * 3 * 6144 * 4);
  p.Hdec = (float*)take((size_t)16 * NCHUNK * 64 * 4);
  p.lbtab = (float*)take((size_t)2 * 2 * 256 * 4);
  p.WinT = (bf16_t*)take((size_t)2 * NP * 1024 * 2);
  p.WoutT = (bf16_t*)take((size_t)2 * 1024 * 1024 * 2);
  p.W1T = (bf16_t*)take((size_t)2 * DFF * 1024 * 2);
  p.W2T = (bf16_t*)take((size_t)2 * DFF * 1024 * 2);
  p.H = (bf16_t*)take((size_t)TA * DM * 2);
  p.HL = (float*)p.H;
  p.P = (bf16_t*)take((size_t)TA * NP * 2);
  p.MO = (bf16_t*)take((size_t)TA * DM * 2);
  p.VtA = (bf16_t*)take((size_t)2 * 4 * 64 * UA * 2);
  p.VtC = (bf16_t*)take((size_t)2 * 4 * 64 * UA * 2);
  p.VtD = (bf16_t*)take((size_t)2 * 2 * 64 * UA * 2);
  p.xcnt = (unsigned*)take(256);
  if (off > ws_size) { fprintf(stderr, "workspace too small: need %zu have %zu\n", off, ws_size); return; }
#if MULTI_LAUNCH
  const int nphase = 1 + 7 + 6 + 7 + 4;
  for (int ph = 0; ph < nphase; ++ph) hipLaunchKernelGGL(fwd_kernel, dim3(256), dim3(512), 0, stream, p, ph);
#else
  static int grid_blocks = 0;
  int phase_sel = -1;
  void* args[] = {&p, &phase_sel};
  if (!grid_blocks) {
    int dev = 0, cus = 0, per_cu = 0;
    (void)hipGetDevice(&dev);
    (void)hipDeviceGetAttribute(&cus, hipDeviceAttributeMultiprocessorCount, dev);
    (void)hipOccupancyMaxActiveBlocksPerMultiprocessor(&per_cu, fwd_kernel, 512, 0);
    if (per_cu < 1) per_cu = 1;
    grid_blocks = cus;
  }
  (void)hipMemsetAsync(p.xcnt, 0, 256, stream);
  hipError_t e = hipLaunchCooperativeKernel((void*)fwd_kernel, dim3(grid_blocks), dim3(512), args, 0, stream);
  if (e != hipSuccess) fprintf(stderr, "cooperative launch failed: %s (grid %d)\n", hipGetErrorString(e), grid_blocks);
#endif
}
```

```cpp
#include <hip/hip_runtime.h>
#include <hip/hip_cooperative_groups.h>
#include <cstdio>
#include <cstdint>
namespace cg = cooperative_groups;

#ifndef MULTI_LAUNCH
#define MULTI_LAUNCH 0
#endif

#define DI __device__ __forceinline__
typedef unsigned short bf16_t;
typedef short bf16x8 __attribute__((ext_vector_type(8)));
typedef float f32x16 __attribute__((ext_vector_type(16)));
typedef float f32x4 __attribute__((ext_vector_type(4)));
typedef float f32x2 __attribute__((ext_vector_type(2)));
typedef unsigned u32x4 __attribute__((ext_vector_type(4)));
typedef unsigned u32x2 __attribute__((ext_vector_type(2)));
typedef __bf16 bf16x2_t __attribute__((ext_vector_type(2)));

constexpr int SEQ = 16384, CTX = 256, DM = 1024, TL = 32768, TC = 512, TA = 33280, NP = 3328, DFF = 4096, UA = 16640;
constexpr int NCHUNK = 260;
constexpr float EPS = 1e-6f, LOG2E = 1.4426950408889634f;
constexpr int SMEM_BYTES = 73728;
constexpr int LDS_STRIDE = 144;

#define MFMA32(a, b, c) __builtin_amdgcn_mfma_f32_32x32x16_bf16((a), (b), (c), 0, 0, 0)

DI unsigned pk2(float a, float b) { f32x2 v = {a, b}; return __builtin_bit_cast(unsigned, __builtin_convertvector(v, bf16x2_t)); }
DI float bf_lo(unsigned u) { return __uint_as_float(u << 16); }
DI float bf_hi(unsigned u) { return __uint_as_float(u & 0xffff0000u); }
DI bf16_t tobf(float a) { return (bf16_t)(pk2(a, 0.f) & 0xffffu); }
DI float fexp2(float x) { return __builtin_amdgcn_exp2f(x); }
DI void sum16_nopk(float& acc, const float (&pe)[16]) {
  asm volatile("s_nop 0\n\tv_add_f32 %0, %1, %0\n\tv_add_f32 %0, %2, %0\n\tv_add_f32 %0, %3, %0\n\tv_add_f32 %0, %4, %0\n\t"
               "v_add_f32 %0, %5, %0\n\tv_add_f32 %0, %6, %0\n\tv_add_f32 %0, %7, %0\n\tv_add_f32 %0, %8, %0\n\t"
               "v_add_f32 %0, %9, %0\n\tv_add_f32 %0, %10, %0\n\tv_add_f32 %0, %11, %0\n\tv_add_f32 %0, %12, %0\n\t"
               "v_add_f32 %0, %13, %0\n\tv_add_f32 %0, %14, %0\n\tv_add_f32 %0, %15, %0\n\tv_add_f32 %0, %16, %0"
               : "+v"(acc)
               : "v"(pe[0]), "v"(pe[1]), "v"(pe[2]), "v"(pe[3]), "v"(pe[4]), "v"(pe[5]), "v"(pe[6]), "v"(pe[7]),
                 "v"(pe[8]), "v"(pe[9]), "v"(pe[10]), "v"(pe[11]), "v"(pe[12]), "v"(pe[13]), "v"(pe[14]), "v"(pe[15]));
}
DI float wave_sum(float v) {
#pragma unroll
  for (int o = 32; o > 0; o >>= 1) v += __shfl_xor(v, o);
  return v;
}
DI float wave_max(float v) {
#pragma unroll
  for (int o = 32; o > 0; o >>= 1) v = fmaxf(v, __shfl_xor(v, o));
  return v;
}
DI int ltid() { int t = threadIdx.x & 255; asm volatile("" : "+v"(t)); return t; }
DI int ltid512() { int t = threadIdx.x; asm volatile("" : "+v"(t)); return t; }
DI unsigned xcc_id() { return (unsigned)__builtin_amdgcn_s_getreg((3 << 11) | 20) & 0xFu; }
DI int rowOfU(int b, int u) { return u < CTX ? TL + b * CTX + u : b * SEQ + (u - CTX); }

struct Params {
  const float *x, *c, *ctx, *c_ctx, *w_mod, *b_mod, *norm1_g, *norm2_g, *w_in, *w_out;
  const float *da_q_gain, *da_k_gain, *da_lambda, *da_sub_gain, *hg_lb_logits, *hg_out_gain;
  const float *na_q_gain, *na_k_gain, *na_rpb, *sw_q_gain, *sw_k_gain, *sw_sink, *w_ff1, *w_ff2;
  float* out;
  float* Xc;
  float* mod;
  float* Hdec;
  float* lbtab;
  bf16_t* WinT;
  bf16_t* WoutT;
  bf16_t* W1T;
  bf16_t* W2T;
  bf16_t* H;
  float* HL;
  bf16_t* P;
  bf16_t* MO;
  bf16_t* VtA;
  bf16_t* VtC;
  bf16_t* VtD;
  unsigned* xcnt;
  unsigned* xbar;
};

DI void phase0(const Params& p, unsigned char* smem, int bid, int nb) {
  const int tid = ltid();
  constexpr int n_mod = 2 * 96;
  constexpr int t_in = 16 * 52, t_out = 16 * 16, t_f1 = 16 * 64, t_f2 = 64 * 16;
  constexpr int per_layer = t_in + t_out + t_f1 + t_f2;
  constexpr int total = n_mod + 2 * per_layer;
  float* fs = (float*)smem;
  if (bid == 0) {
    for (int i = tid; i < 512; i += 256) {
      const float l0 = p.hg_lb_logits[i], l1 = p.hg_lb_logits[512 + i];
      p.lbtab[i] = 0.f;
      p.lbtab[512 + i] = 1.f / (1.f + expf(l0 - l1));
    }
  }
  for (int it = bid; it < total; it += nb) {
    if (it < n_mod) {
      const int l = it / 96, col0 = (it % 96) * 64;
      float* sc = fs;
      float* red = fs + 3072;
      for (int i = tid; i < 3072; i += 256) {
        const int cond = i >> 10, k = i & 1023;
        const float v = cond == 0 ? p.c[k] : (cond == 1 ? p.c[1024 + k] : p.c_ctx[k]);
        sc[i] = v / (1.f + expf(-v));
      }
      __syncthreads();
      const int kg = tid >> 6, j = tid & 63;
      float a0 = 0.f, a1 = 0.f, a2 = 0.f;
      const float* wp = p.w_mod + ((size_t)l * 1024 + kg * 256) * 6144 + col0 + j;
#pragma unroll 8
      for (int k = 0; k < 256; ++k) {
        const float w = wp[(size_t)k * 6144];
        a0 += sc[kg * 256 + k] * w; a1 += sc[1024 + kg * 256 + k] * w; a2 += sc[2048 + kg * 256 + k] * w;
      }
      red[(kg * 3 + 0) * 64 + j] = a0; red[(kg * 3 + 1) * 64 + j] = a1; red[(kg * 3 + 2) * 64 + j] = a2;
      __syncthreads();
      if (tid < 192) {
        const int cond = tid >> 6, jj = tid & 63;
        float s = p.b_mod[l * 6144 + col0 + jj];
#pragma unroll
        for (int g = 0; g < 4; ++g) s += red[(g * 3 + cond) * 64 + jj];
        p.mod[(l * 3 + cond) * 6144 + col0 + jj] = s;
      }
    } else {
      int idx = it - n_mod;
      const int l = idx / per_layer; idx -= l * per_layer;
      const float* src; bf16_t* dst; int K, N;
      if (idx < t_in) { src = p.w_in + (size_t)l * 1024 * NP; dst = p.WinT + (size_t)l * NP * 1024; K = 1024; N = NP; }
      else if (idx < t_in + t_out) { idx -= t_in; src = p.w_out + (size_t)l * 1024 * 1024; dst = p.WoutT + (size_t)l * 1024 * 1024; K = 1024; N = 1024; }
      else if (idx < t_in + t_out + t_f1) { idx -= t_in + t_out; src = p.w_ff1 + (size_t)l * 1024 * DFF; dst = p.W1T + (size_t)l * DFF * 1024; K = 1024; N = DFF; }
      else { idx -= t_in + t_out + t_f1; src = p.w_ff2 + (size_t)l * DFF * 1024; dst = p.W2T + (size_t)l * 1024 * DFF; K = DFF; N = 1024; }
      const int ntn = N >> 6, kt = idx / ntn, nt = idx % ntn, k0 = kt * 64, n0 = nt * 64;
#pragma unroll
      for (int i = 0; i < 4; ++i) {
        const int r = (tid >> 4) + 16 * i, c4 = (tid & 15) * 4;
        const f32x4 v = *(const f32x4*)(src + (size_t)(k0 + r) * N + n0 + c4);
        fs[r * 65 + c4] = v[0]; fs[r * 65 + c4 + 1] = v[1]; fs[r * 65 + c4 + 2] = v[2]; fs[r * 65 + c4 + 3] = v[3];
      }
      __syncthreads();
      const int n = tid >> 2, kq = (tid & 3) * 16;
      u32x4 w0, w1;
#pragma unroll
      for (int i = 0; i < 4; ++i) {
        w0[i] = pk2(fs[(kq + 2 * i) * 65 + n], fs[(kq + 2 * i + 1) * 65 + n]);
        w1[i] = pk2(fs[(kq + 8 + 2 * i) * 65 + n], fs[(kq + 8 + 2 * i + 1) * 65 + n]);
      }
      bf16_t* dp = dst + (size_t)(n0 + n) * K + k0 + kq;
      *(u32x4*)dp = w0; *(u32x4*)(dp + 8) = w1;
    }
    __syncthreads();
  }
}

DI void norm_phase(const float* lat, const float* ctxp, int nrows, const float* g, const float* modl, int shift_off, int scale_off,
                   bf16_t* H, int bid, int nb) {
  const int wave = ltid() >> 6, lane = ltid() & 63;
  for (int r8 = bid; r8 < nrows / 8; r8 += nb) {
    f32x4 v[2][4]; float ss[2] = {0.f, 0.f};
#pragma unroll
    for (int h = 0; h < 2; ++h) {
      const int row = r8 * 8 + wave + 4 * h;
      const float* src = row < TL ? lat + (size_t)row * DM : ctxp + (size_t)(row - TL) * DM;
#pragma unroll
      for (int i = 0; i < 4; ++i) v[h][i] = *(const f32x4*)(src + lane * 4 + 256 * i);
    }
#pragma unroll
    for (int h = 0; h < 2; ++h) {
#pragma unroll
      for (int i = 0; i < 4; ++i) ss[h] += v[h][i][0] * v[h][i][0] + v[h][i][1] * v[h][i][1] + v[h][i][2] * v[h][i][2] + v[h][i][3] * v[h][i][3];
      ss[h] = wave_sum(ss[h]);
    }
#pragma unroll
    for (int h = 0; h < 2; ++h) {
      const int row = r8 * 8 + wave + 4 * h;
      const int mi = row < TL ? (row >> 14) : 2;
      const float* sh = modl + mi * 6144 + shift_off;
      const float* sc = modl + mi * 6144 + scale_off;
      const float rs = rsqrtf(ss[h] * (1.f / 1024.f) + EPS);
#pragma unroll
      for (int i = 0; i < 4; ++i) {
        const int col = lane * 4 + 256 * i;
        const f32x4 gg = *(const f32x4*)(g + col), s4 = *(const f32x4*)(sc + col), h4 = *(const f32x4*)(sh + col);
        float y[4];
#pragma unroll
        for (int j = 0; j < 4; ++j) y[j] = (v[h][i][j] * rs * gg[j]) * (1.f + s4[j]) + h4[j];
        u32x2 w; w[0] = pk2(y[0], y[1]); w[1] = pk2(y[2], y[3]);
        *(u32x2*)(H + (size_t)row * DM + col) = w;
      }
    }
  }
}

struct EpiBf16 {
  static constexpr bool kBf16 = true;
  DI static float act(float v) { return v; }
  bf16_t* O; int ldc;
  DI void operator()(int m, int n, f32x4 v) const {
    u32x2 w; w[0] = pk2(v[0], v[1]); w[1] = pk2(v[2], v[3]);
    *(u32x2*)(O + (size_t)m * ldc + n) = w;
  }
};
struct EpiRelu2 {
  static constexpr bool kBf16 = true;
  DI static float act(float v) { const float t = fmaxf(v, 0.f); return t * t; }
  bf16_t* O; int ldc;
  DI void operator()(int m, int n, f32x4 v) const {
    float y[4];
#pragma unroll
    for (int j = 0; j < 4; ++j) { const float t = fmaxf(v[j], 0.f); y[j] = t * t; }
    u32x2 w; w[0] = pk2(y[0], y[1]); w[1] = pk2(y[2], y[3]);
    *(u32x2*)(O + (size_t)m * ldc + n) = w;
  }
};
struct EpiResid {
  static constexpr bool kBf16 = false;
  const float* sl; const float* sc; float* dl; float* dc; const float* gate; int row0;
  DI void operator()(int m, int n, f32x4 v) const {
    const int row = m + row0;
    const float* s = row < TL ? sl + (size_t)row * DM : sc + (size_t)(row - TL) * DM;
    float* d = row < TL ? dl + (size_t)row * DM : dc + (size_t)(row - TL) * DM;
    const int mi = row < TL ? (row >> 14) : 2;
    const f32x4 g = *(const f32x4*)(gate + mi * 6144 + n);
    const f32x4 r = *(const f32x4*)(s + n);
    f32x4 o;
#pragma unroll
    for (int j = 0; j < 4; ++j) o[j] = r[j] + g[j] * v[j];
    *(f32x4*)(d + n) = o;
  }
};

template <class Epi>
DI void gemm_phase(const bf16_t* A, const bf16_t* Bt, int mtiles, int ntiles, int K, const Epi& epi, unsigned char* smem, int bid, int nb) {
  const int tid = ltid(), lane = tid & 63, wave = tid >> 6;
  const int wm = wave & 1, wn = wave >> 1, l31 = lane & 31, hh = lane >> 5;
  unsigned char* As0 = smem;
  unsigned char* Bs0 = smem + 2 * 128 * LDS_STRIDE;
  const int nk = K >> 6;
  const int ldrow = tid >> 3, ldcol = (tid & 7) * 8;
  const int total = mtiles * ntiles;
  const int xper = (nb >> 3) > 0 ? (nb >> 3) : 1;
  const int xcd = nb >= 8 ? (bid & 7) : 0, xj = nb >= 8 ? (bid >> 3) : bid, xstep = nb >= 8 ? 8 : 1;
  if (nb >= 8 && bid >= xper * 8) return;
  for (int ch = xcd; ch * xper + xj < total; ch += xstep) {
    const int it = ch * xper + xj;
    const int band = it / (8 * ntiles), rr = it - band * 8 * ntiles;
    const int rib = (mtiles - 8 * band) < 8 ? (mtiles - 8 * band) : 8;
    const int pn = rr / rib, pm = 8 * band + rr % rib;
    const bf16_t* Ap = A + (size_t)(pm * 128 + ldrow) * K + ldcol;
    const bf16_t* Bp = Bt + (size_t)(pn * 128 + ldrow) * K + ldcol;
    f32x16 acc[2][2];
#pragma unroll
    for (int a = 0; a < 2; ++a)
#pragma unroll
      for (int b = 0; b < 2; ++b)
#pragma unroll
        for (int i = 0; i < 16; ++i) acc[a][b][i] = 0.f;
    u32x4 ra0[4], rb0[4], ra1[4], rb1[4];
#define G_LOAD(RA, RB, KT) do { _Pragma("unroll") for (int i = 0; i < 4; ++i) { RA[i] = *(const u32x4*)(Ap + (size_t)i * 32 * K + (KT) * 64); RB[i] = *(const u32x4*)(Bp + (size_t)i * 32 * K + (KT) * 64); } } while (0)
#define G_STORE(RA, RB, BUF) do { unsigned char* Aw = As0 + (BUF) * 128 * LDS_STRIDE; unsigned char* Bw = Bs0 + (BUF) * 128 * LDS_STRIDE; \
      _Pragma("unroll") for (int i = 0; i < 4; ++i) { *(u32x4*)(Aw + (ldrow + 32 * i) * LDS_STRIDE + ldcol * 2) = RA[i]; *(u32x4*)(Bw + (ldrow + 32 * i) * LDS_STRIDE + ldcol * 2) = RB[i]; } } while (0)
#define G_COMPUTE(BUF) do { const unsigned char* As = As0 + (BUF) * 128 * LDS_STRIDE; const unsigned char* Bs = Bs0 + (BUF) * 128 * LDS_STRIDE; \
      _Pragma("unroll") for (int ks = 0; ks < 4; ++ks) { bf16x8 wf[2], af[2]; \
        _Pragma("unroll") for (int i = 0; i < 2; ++i) { \
          wf[i] = *(const bf16x8*)(Bs + (wn * 64 + i * 32 + l31) * LDS_STRIDE + (ks * 16 + 8 * hh) * 2); \
          af[i] = *(const bf16x8*)(As + (wm * 64 + i * 32 + l31) * LDS_STRIDE + (ks * 16 + 8 * hh) * 2); } \
        _Pragma("unroll") for (int ni = 0; ni < 2; ++ni) _Pragma("unroll") for (int mi = 0; mi < 2; ++mi) acc[ni][mi] = MFMA32(wf[ni], af[mi], acc[ni][mi]); } } while (0)
    G_LOAD(ra0, rb0, 0);
    G_LOAD(ra1, rb1, 1);
    G_STORE(ra0, rb0, 0);
    __syncthreads();
#pragma unroll 1
    for (int kt = 0; kt < nk; kt += 2) {
      const int k2 = kt + 2 < nk ? kt + 2 : 0, k3 = kt + 3 < nk ? kt + 3 : 1;
      G_LOAD(ra0, rb0, k2);
      G_COMPUTE(0);
      G_STORE(ra1, rb1, 1);
      __syncthreads();
      G_LOAD(ra1, rb1, k3);
      G_COMPUTE(1);
      G_STORE(ra0, rb0, 0);
      __syncthreads();
    }
#pragma unroll
    for (int ni = 0; ni < 2; ++ni)
#pragma unroll
      for (int mi = 0; mi < 2; ++mi) {
        const int m = pm * 128 + wm * 64 + mi * 32 + l31;
#pragma unroll
        for (int g = 0; g < 4; ++g) {
          const int n = pn * 128 + wn * 64 + ni * 32 + 8 * g + 4 * hh;
          f32x4 v = {acc[ni][mi][4 * g], acc[ni][mi][4 * g + 1], acc[ni][mi][4 * g + 2], acc[ni][mi][4 * g + 3]};
          epi(m, n, v);
        }
      }
  }
}

struct EpiResidAtomic {
  static constexpr bool kBf16 = false;
  float* dl; float* dc; const float* gate; int row0;
  DI void operator()(int m, int n, f32x4 v) const {
    const int row = m + row0;
    float* d = row < TL ? dl + (size_t)row * DM : dc + (size_t)(row - TL) * DM;
    const int mi = row < TL ? (row >> 14) : 2;
    const f32x4 g = *(const f32x4*)(gate + mi * 6144 + n);
#pragma unroll
    for (int j = 0; j < 4; ++j) unsafeAtomicAdd(d + n + j, g[j] * v[j]);
  }
};

template <class Epi>
DI void gemm_phase512(const bf16_t* A, const bf16_t* Bt, int mtiles, int ntiles, int K, int Kper, int ksplit, const Epi& epi,
                      unsigned char* smem, int bid, int nb) {
  const int tid = ltid512(), lane = tid & 63, wave = tid >> 6;
  const int wm = wave & 1, wn = wave >> 1, l31 = lane & 31, hh = lane >> 5;
  constexpr int OPB = 256 * LDS_STRIDE;
  unsigned char* As0 = smem;
  unsigned char* Bs0 = smem + 2 * OPB;
  const int nk = Kper >> 6;
  const int ldrow = tid >> 3, ldcol = (tid & 7) * 8;
  const int ntile = mtiles * ntiles, total = ntile * ksplit;
#define H_TILE(IT, PM, PN, AP, BP) do { const int tile_ = (IT) / ksplit, ks_ = (IT) - tile_ * ksplit; \
    const int band_ = tile_ / (8 * ntiles), rr_ = tile_ - band_ * 8 * ntiles; \
    const int rib_ = (mtiles - 8 * band_) < 8 ? (mtiles - 8 * band_) : 8; \
    PN = rr_ / rib_; PM = 8 * band_ + rr_ % rib_; \
    AP = A + (size_t)(PM * 256 + ldrow) * K + ks_ * Kper + ldcol; BP = Bt + (size_t)(PN * 256 + ldrow) * K + ks_ * Kper + ldcol; } while (0)
#define H_LOAD(KT) do { _Pragma("unroll") for (int i = 0; i < 4; ++i) { ra[i] = *(const u32x4*)(Ap + (size_t)i * 64 * K + (KT) * 64); rb[i] = *(const u32x4*)(Bp + (size_t)i * 64 * K + (KT) * 64); } } while (0)
#define H_STORE(BUF) do { unsigned char* Aw = As0 + (BUF) * OPB; unsigned char* Bw = Bs0 + (BUF) * OPB; \
      _Pragma("unroll") for (int i = 0; i < 4; ++i) { *(u32x4*)(Aw + (ldrow + 64 * i) * LDS_STRIDE + ldcol * 2) = ra[i]; *(u32x4*)(Bw + (ldrow + 64 * i) * LDS_STRIDE + ldcol * 2) = rb[i]; } } while (0)
  int it = bid;
  if (it >= total) return;
  int pm, pn; const bf16_t* Ap; const bf16_t* Bp;
  H_TILE(it, pm, pn, Ap, Bp);
  u32x4 ra[4], rb[4];
  H_LOAD(0);
  for (;;) {
    f32x16 acc[2][4];
#pragma unroll
    for (int a = 0; a < 2; ++a)
#pragma unroll
      for (int b = 0; b < 4; ++b)
#pragma unroll
        for (int i = 0; i < 16; ++i) acc[a][b][i] = 0.f;
    H_STORE(0);
    H_LOAD(1);
    __syncthreads();
#pragma unroll 1
    for (int kt = 0; kt < nk; ++kt) {
      const int buf = kt & 1;
      const int kn = kt + 2 < nk ? kt + 2 : 0;
      const unsigned char* As = As0 + buf * OPB;
      const unsigned char* Bs = Bs0 + buf * OPB;
      unsigned char* Aw = As0 + (buf ^ 1) * OPB;
      unsigned char* Bw = Bs0 + (buf ^ 1) * OPB;
#pragma unroll
      for (int k16 = 0; k16 < 4; ++k16) {
        bf16x8 wf[2], af[4];
#pragma unroll
        for (int i = 0; i < 2; ++i) wf[i] = *(const bf16x8*)(Bs + (wn * 64 + i * 32 + l31) * LDS_STRIDE + (k16 * 16 + 8 * hh) * 2);
#pragma unroll
        for (int i = 0; i < 4; ++i) af[i] = *(const bf16x8*)(As + (wm * 128 + i * 32 + l31) * LDS_STRIDE + (k16 * 16 + 8 * hh) * 2);
#pragma unroll
        for (int ni = 0; ni < 2; ++ni)
#pragma unroll
          for (int mi = 0; mi < 4; ++mi) acc[ni][mi] = MFMA32(wf[ni], af[mi], acc[ni][mi]);
        *(u32x4*)(Aw + (ldrow + 64 * k16) * LDS_STRIDE + ldcol * 2) = ra[k16];
        *(u32x4*)(Bw + (ldrow + 64 * k16) * LDS_STRIDE + ldcol * 2) = rb[k16];
        ra[k16] = *(const u32x4*)(Ap + (size_t)k16 * 64 * K + kn * 64);
        rb[k16] = *(const u32x4*)(Bp + (size_t)k16 * 64 * K + kn * 64);
        __builtin_amdgcn_sched_barrier(0);
      }
      __syncthreads();
    }
    const int itn = it + nb;
    const bool more = itn < total;
    int pmn = pm, pnn = pn; const bf16_t* Apn = Ap; const bf16_t* Bpn = Bp;
    if (more) H_TILE(itn, pmn, pnn, Apn, Bpn);
    const int pm_cur = pm, pn_cur = pn;
    Ap = Apn; Bp = Bpn;
    H_LOAD(0);
    {
      unsigned char* wl = smem + wave * 18432;
      const int m0 = pm_cur * 256 + wm * 128, n0 = pn_cur * 256 + wn * 64;
      if constexpr (Epi::kBf16) {
#pragma unroll
        for (int ni = 0; ni < 2; ++ni)
#pragma unroll
          for (int mi = 0; mi < 4; ++mi)
#pragma unroll
            for (int g = 0; g < 4; ++g) {
              u32x2 w;
              w[0] = pk2(Epi::act(acc[ni][mi][4 * g]), Epi::act(acc[ni][mi][4 * g + 1]));
              w[1] = pk2(Epi::act(acc[ni][mi][4 * g + 2]), Epi::act(acc[ni][mi][4 * g + 3]));
              *(u32x2*)(wl + (mi * 32 + l31) * LDS_STRIDE + (ni * 32 + 8 * g + 4 * hh) * 2) = w;
            }
        asm volatile("" ::: "memory");
#pragma unroll
        for (int i = 0; i < 16; ++i) {
          const int row = (lane >> 3) + 8 * i, ch = lane & 7;
          const u32x4 w = *(const u32x4*)(wl + row * LDS_STRIDE + ch * 16);
          *(u32x4*)(epi.O + (size_t)(m0 + row) * epi.ldc + n0 + ch * 8) = w;
        }
      } else {
#pragma unroll
        for (int half = 0; half < 2; ++half) {
          if (half) asm volatile("" ::: "memory");
#pragma unroll
          for (int ni = 0; ni < 2; ++ni)
#pragma unroll
            for (int mh = 0; mh < 2; ++mh)
#pragma unroll
              for (int g = 0; g < 4; ++g) {
                const int mi = 2 * half + mh;
                f32x4 v = {acc[ni][mi][4 * g], acc[ni][mi][4 * g + 1], acc[ni][mi][4 * g + 2], acc[ni][mi][4 * g + 3]};
                *(f32x4*)(wl + (mh * 32 + l31) * 272 + (ni * 32 + 8 * g + 4 * hh) * 4) = v;
              }
          asm volatile("" ::: "memory");
#pragma unroll
          for (int i = 0; i < 16; ++i) {
            const int row = (lane >> 4) + 4 * i, ch = lane & 15;
            const f32x4 v = *(const f32x4*)(wl + row * 272 + ch * 16);
            epi(m0 + half * 64 + row, n0 + ch * 4, v);
          }
        }
      }
    }
    __syncthreads();
    if (!more) break;
    it = itn; pm = pmn; pn = pnn;
  }
}

DI float hg_lb(const Params& p, int layer, int d, int j) { return p.lbtab[(layer * 2 + d) * 256 + j]; }

DI void prep32_item(const Params& p, int layer, int it) {
  const int idx = it * 256 + ltid();
  const int row = idx >> 4, j = idx & 15, isk = j >> 3, sub = j & 7;
  bf16_t* ptr = p.P + (size_t)row * NP + isk * 256 + sub * 32;
  const float* gain = (isk ? p.da_k_gain : p.da_q_gain) + layer * 32;
  float v[32];
#pragma unroll
  for (int i = 0; i < 4; ++i) {
    const u32x4 w = *(const u32x4*)(ptr + 8 * i);
#pragma unroll
    for (int q = 0; q < 4; ++q) { v[8 * i + 2 * q] = bf_lo(w[q]); v[8 * i + 2 * q + 1] = bf_hi(w[q]); }
  }
  float ss = 0.f;
#pragma unroll
  for (int i = 0; i < 32; ++i) ss += v[i] * v[i];
  const float r = rsqrtf(ss * (1.f / 32.f) + EPS);
#pragma unroll
  for (int i = 0; i < 32; ++i) v[i] = v[i] * r * gain[i];
  if (row < TL) {
    const int t = row & (SEQ - 1);
    const float gr = (float)(t >> 6), gc = (float)(t & 63);
#pragma unroll
    for (int i = 0; i < 8; ++i) {
      constexpr float FRA[8] = {1.f, 0.31622776601683794f, 0.1f, 0.031622776601683794f, 0.01f, 0.0031622776601683794f, 0.001f, 0.00031622776601683794f};
      const float fr = FRA[i];
      const float ar = gr * fr, ac = gc * fr;
      const float cr = __cosf(ar), sr = __sinf(ar), cc = __cosf(ac), sc = __sinf(ac);
      const float x1 = v[i], x2 = v[8 + i];
      v[i] = x1 * cr - x2 * sr; v[8 + i] = x1 * sr + x2 * cr;
      const float y1 = v[16 + i], y2 = v[24 + i];
      v[16 + i] = y1 * cc - y2 * sc; v[24 + i] = y1 * sc + y2 * cc;
    }
  }
  const float qs = isk ? 1.f : (0.17677669529663687f * LOG2E);
#pragma unroll
  for (int i = 0; i < 4; ++i) {
    u32x4 w;
#pragma unroll
    for (int q = 0; q < 4; ++q) w[q] = pk2(v[8 * i + 2 * q] * qs, v[8 * i + 2 * q + 1] * qs);
    *(u32x4*)(ptr + 8 * i) = w;
  }
}

DI void prep64_item(const Params& p, int layer, int it) {
  const int idx = it * 256 + ltid();
  const int row = idx / 14, j = idx % 14;
  int col; const float* gain; bool rope, isq;
  if (j < 4) { col = 2048 + 64 * j; gain = p.na_q_gain; rope = false; isq = true; }
  else if (j < 8) { col = 2304 + 64 * (j - 4); gain = p.na_k_gain; rope = false; isq = false; }
  else if (j < 12) { col = 2816 + 64 * (j - 8); gain = p.sw_q_gain; rope = true; isq = true; }
  else { col = 3072 + 64 * (j - 12); gain = p.sw_k_gain; rope = true; isq = false; }
  gain += layer * 64;
  bf16_t* ptr = p.P + (size_t)row * NP + col;
  float v[64];
#pragma unroll
  for (int i = 0; i < 8; ++i) {
    const u32x4 w = *(const u32x4*)(ptr + 8 * i);
#pragma unroll
    for (int q = 0; q < 4; ++q) { v[8 * i + 2 * q] = bf_lo(w[q]); v[8 * i + 2 * q + 1] = bf_hi(w[q]); }
  }
  float ss = 0.f;
#pragma unroll
  for (int i = 0; i < 64; ++i) ss += v[i] * v[i];
  const float r = rsqrtf(ss * (1.f / 64.f) + EPS);
#pragma unroll
  for (int i = 0; i < 64; ++i) v[i] = v[i] * r * gain[i];
  if (rope && row < TL) {
    const int t = row & (SEQ - 1);
    const float gr = (float)(t >> 6), gc = (float)(t & 63);
#pragma unroll
    for (int i = 0; i < 16; ++i) {
      constexpr float FRD[16] = {1.f, 0.5623413251903491f, 0.31622776601683794f, 0.1778279410038923f, 0.1f, 0.05623413251903491f, 0.031622776601683794f, 0.01778279410038923f, 0.01f, 0.005623413251903491f, 0.0031622776601683794f, 0.001778279410038923f, 0.001f, 0.0005623413251903491f, 0.00031622776601683794f, 0.0001778279410038923f};
      const float fr = FRD[i];
      const float ar = gr * fr, ac = gc * fr;
      const float cr = __cosf(ar), sr = __sinf(ar), cc = __cosf(ac), sc = __sinf(ac);
      const float x1 = v[i], x2 = v[16 + i];
      v[i] = x1 * cr - x2 * sr; v[16 + i] = x1 * sr + x2 * cr;
      const float y1 = v[32 + i], y2 = v[48 + i];
      v[32 + i] = y1 * cc - y2 * sc; v[48 + i] = y1 * sc + y2 * cc;
    }
  }
  const float qs = isq ? (0.125f * LOG2E) : 1.f;
#pragma unroll
  for (int i = 0; i < 8; ++i) {
    u32x4 w;
#pragma unroll
    for (int q = 0; q < 4; ++q) w[q] = pk2(v[8 * i + 2 * q] * qs, v[8 * i + 2 * q + 1] * qs);
    *(u32x4*)(ptr + 8 * i) = w;
  }
}

DI void vt_item(const Params& p, int it, unsigned char* smem) {
  const int tid = ltid();
  const int hv = it % 10, ug = (it / 10) % NCHUNK, b = it / (10 * NCHUNK);
  int vcol; bf16_t* dst;
  if (hv < 4) { vcol = 512 + 64 * hv; dst = p.VtA + (size_t)(b * 4 + hv) * 64 * UA; }
  else if (hv < 8) { vcol = 2560 + 64 * (hv - 4); dst = p.VtC + (size_t)(b * 4 + hv - 4) * 64 * UA; }
  else { vcol = 3200 + 64 * (hv - 8); dst = p.VtD + (size_t)(b * 2 + hv - 8) * 64 * UA; }
  const int u0 = ug * 64;
  bf16_t* tile = (bf16_t*)smem;
  {
    const int tk = tid >> 2, seg = (tid & 3) * 16;
    const int row = rowOfU(b, u0 + tk);
    const bf16_t* src = p.P + (size_t)row * NP + vcol + seg;
    const u32x4 w0 = *(const u32x4*)src, w1 = *(const u32x4*)(src + 8);
    unsigned* tp = (unsigned*)(tile + tk * 66 + seg);
#pragma unroll
    for (int q = 0; q < 4; ++q) { tp[q] = w0[q]; tp[4 + q] = w1[q]; }
  }
  __syncthreads();
  {
    const int dv = tid >> 2, tq = (tid & 3) * 16;
    u32x4 w0, w1;
#pragma unroll
    for (int q = 0; q < 4; ++q) {
      w0[q] = (unsigned)tile[(tq + 2 * q) * 66 + dv] | ((unsigned)tile[(tq + 2 * q + 1) * 66 + dv] << 16);
      w1[q] = (unsigned)tile[(tq + 8 + 2 * q) * 66 + dv] | ((unsigned)tile[(tq + 8 + 2 * q + 1) * 66 + dv] << 16);
    }
    bf16_t* dp = dst + (size_t)dv * UA + u0 + tq;
    *(u32x4*)dp = w0; *(u32x4*)(dp + 8) = w1;
  }
  __syncthreads();
}

DI int hg_row(int b, int d, int n, int pp) {
  if (n < 4) { const int c = d ? 255 - (64 * n + pp) : 64 * n + pp; return TL + b * CTX + c; }
  const int t = d ? SEQ - 1 - (64 * (n - 4) + pp) : 64 * (n - 4) + pp;
  return b * SEQ + t;
}

#define MFMA16(a, b, c) __builtin_amdgcn_mfma_f32_16x16x32_bf16((a), (b), (c), 0, 0, 0)
DI bf16x8 pack8(const f32x4& a, const f32x4& b) {
  u32x4 w; w[0] = pk2(a[0], a[1]); w[1] = pk2(a[2], a[3]); w[2] = pk2(b[0], b[1]); w[3] = pk2(b[2], b[3]);
  return __builtin_bit_cast(bf16x8, w);
}

DI void prefix64(float* cumT, float* psum, int tid, float (&c)[16]) {
  const int k = tid & 63, qd = tid >> 6;
  float* row = cumT + k * 68 + 16 * qd;
#pragma unroll
  for (int i4 = 0; i4 < 4; ++i4) { const f32x4 t = *(const f32x4*)(row + 4 * i4); c[4 * i4] = t[0]; c[4 * i4 + 1] = t[1]; c[4 * i4 + 2] = t[2]; c[4 * i4 + 3] = t[3]; }
#pragma unroll
  for (int i = 1; i < 16; ++i) c[i] += c[i - 1];
  psum[qd * 64 + k] = c[15];
  __syncthreads();
  float off = 0.f;
#pragma unroll
  for (int q = 0; q < 3; ++q) off += (q < qd) ? psum[q * 64 + k] : 0.f;
#pragma unroll
  for (int i = 0; i < 16; ++i) c[i] += off;
#pragma unroll
  for (int i4 = 0; i4 < 4; ++i4) { f32x4 t = {c[4 * i4], c[4 * i4 + 1], c[4 * i4 + 2], c[4 * i4 + 3]}; *(f32x4*)(row + 4 * i4) = t; }
}

DI void hgsum_item(const Params& p, int layer, int it, unsigned char* smem) {
  const int tid = ltid();
  const int n = it % NCHUNK, chain = it / NCHUNK, d = chain & 1, hh = (chain >> 1) & 3, b = chain >> 3;
  float* cumT = (float*)smem;
  float* wT = cumT + 64 * 68;
  float* vT = wT + 64 * 68;
  float* psum = vT + 64 * 68;
  const int pp = tid >> 2, kq = (tid & 3) * 16;
  {
    const int row = hg_row(b, d, n, pp);
    const bf16_t* pr = p.P + (size_t)row * NP;
    const bf16_t* fp = pr + 1536 + d * 256 + hh * 64 + kq;
    const bf16_t* vp = pr + 1024 + hh * 64 + kq;
    const u32x4 f0 = *(const u32x4*)fp, f1 = *(const u32x4*)(fp + 8), v0 = *(const u32x4*)vp, v1 = *(const u32x4*)(vp + 8);
    float fx[16], vx[16];
#pragma unroll
    for (int q = 0; q < 4; ++q) { fx[2 * q] = bf_lo(f0[q]); fx[2 * q + 1] = bf_hi(f0[q]); fx[8 + 2 * q] = bf_lo(f1[q]); fx[8 + 2 * q + 1] = bf_hi(f1[q]);
                                  vx[2 * q] = bf_lo(v0[q]); vx[2 * q + 1] = bf_hi(v0[q]); vx[8 + 2 * q] = bf_lo(v1[q]); vx[8 + 2 * q + 1] = bf_hi(v1[q]); }
#pragma unroll
    for (int j = 0; j < 16; ++j) {
      const float lb = hg_lb(p, layer, d, hh * 64 + kq + j);
      const float sg = __builtin_amdgcn_rcpf(1.f + fexp2(-fx[j] * LOG2E));
      const float f = lb + (1.f - lb) * sg;
      cumT[(kq + j) * 68 + pp] = __builtin_amdgcn_logf(f);
      wT[(kq + j) * 68 + pp] = 1.f - f;
      vT[(kq + j) * 68 + pp] = vx[j];
    }
  }
  __syncthreads();
  { float c[16]; prefix64(cumT, psum, tid, c); }
  __syncthreads();
#pragma unroll
  for (int j = 0; j < 16; ++j) {
    const int k = kq + j;
    wT[k * 68 + pp] *= fexp2(cumT[k * 68 + 63] - cumT[k * 68 + pp]);
  }
  __syncthreads();
  {
    const int wv = tid >> 6, lane = tid & 63, lc = lane & 15, lq = lane >> 4;
    f32x4 acc[4];
#pragma unroll
    for (int vt = 0; vt < 4; ++vt) acc[vt] = (f32x4){0.f, 0.f, 0.f, 0.f};
#pragma unroll
    for (int ks = 0; ks < 2; ++ks) {
      const float* ar = wT + (16 * wv + lc) * 68 + 32 * ks + 8 * lq;
      const bf16x8 af = pack8(*(const f32x4*)ar, *(const f32x4*)(ar + 4));
#pragma unroll
      for (int vt = 0; vt < 4; ++vt) {
        const float* br = vT + (16 * vt + lc) * 68 + 32 * ks + 8 * lq;
        const bf16x8 bf = pack8(*(const f32x4*)br, *(const f32x4*)(br + 4));
        acc[vt] = MFMA16(af, bf, acc[vt]);
      }
    }
    float* L = p.HL + ((size_t)(chain * NCHUNK + n)) * 4096;
#pragma unroll
    for (int vt = 0; vt < 4; ++vt)
#pragma unroll
      for (int i = 0; i < 4; ++i) L[(16 * wv + 4 * lq + i) * 64 + 16 * vt + lc] = acc[vt][i];
    if (tid < 64) p.Hdec[(chain * NCHUNK + n) * 64 + tid] = fexp2(cumT[tid * 68 + 63]);
  }
  __syncthreads();
}

DI void prep_phase(const Params& p, int layer, unsigned char* smem, int bid, int nb) {
  constexpr int n_hg = 16 * NCHUNK;
  constexpr int n_vt = 2 * NCHUNK * 10;
  constexpr int n_p32 = TA * 16 / 256;
  constexpr int n_p64 = TA * 14 / 256;
  constexpr int total = n_hg + n_vt + n_p32 + n_p64;
  for (int it = bid; it < total; it += nb) {
    if (it < n_hg) hgsum_item(p, layer, it, smem);
    else if (it < n_hg + n_vt) vt_item(p, it - n_hg, smem);
    else if (it < n_hg + n_vt + n_p32) prep32_item(p, layer, it - n_hg - n_vt);
    else prep64_item(p, layer, it - n_hg - n_vt - n_p32);
  }
}

DI void scan_item(const Params& p, int it) {
  const int chain = it >> 4, e = (it & 15) * 256 + ltid(), k = e >> 6;
  float* L = p.HL + (size_t)chain * NCHUNK * 4096 + e;
  const float* dc = p.Hdec + chain * NCHUNK * 64 + k;
  float S = 0.f;
  for (int n0 = 0; n0 < NCHUNK; n0 += 26) {
    float l[26], dd[26];
#pragma unroll
    for (int j = 0; j < 26; ++j) { l[j] = L[(size_t)(n0 + j) * 4096]; dd[j] = dc[(n0 + j) * 64]; }
#pragma unroll
    for (int j = 0; j < 26; ++j) { L[(size_t)(n0 + j) * 4096] = S; S = dd[j] * S + l[j]; }
  }
}

DI void attnA_block(const Params& p, int layer, unsigned char* smem, int b, int h, int qrow_blk, int ubeg, int uend) {
  const int tid = ltid512(), wave = tid >> 6;
  const int lane = tid & 63, qi = lane & 31, hh = lane >> 5;
  const int qrow0 = qrow_blk + wave * 32;
  const int pr = (qi & 19) | ((qi & 4) << 1) | ((qi & 8) >> 1);
  const float lam_init = layer == 0 ? 0.2f : 0.35550906759096f;
  float gq = lane < 32 ? fabsf(p.da_q_gain[layer * 32 + lane]) : 0.f, gk = lane < 32 ? fabsf(p.da_k_gain[layer * 32 + lane]) : 0.f;
  gq = wave_max(gq); gk = wave_max(gk);
  const float negM2 = -(0.17677669529663687f * LOG2E * 32.f * 1.02f) * gq * gk;
  float la = 0.f, lb_ = 0.f;
  if (lane < 32) { const float* lv = p.da_lambda + layer * 128; la = lv[lane] * lv[32 + lane]; lb_ = lv[64 + lane] * lv[96 + lane]; }
  la = wave_sum(la); lb_ = wave_sum(lb_);
  const float lam = expf(la) - expf(lb_) + lam_init;

  const bf16_t* qp = p.P + (size_t)(qrow0 + qi) * NP + h * 64 + 8 * hh;
  bf16x8 qf[2][2];
#pragma unroll
  for (int m = 0; m < 2; ++m)
#pragma unroll
    for (int ks = 0; ks < 2; ++ks) qf[m][ks] = *(const bf16x8*)(qp + m * 32 + ks * 16);
  f32x16 o[2][2];
#pragma unroll
  for (int m = 0; m < 2; ++m)
#pragma unroll
    for (int dh = 0; dh < 2; ++dh)
#pragma unroll
      for (int i = 0; i < 16; ++i) o[m][dh][i] = 0.f;
  float ls[2] = {0.f, 0.f};
  constexpr int VSTR = 272, KBYTES = 128 * LDS_STRIDE, STG = KBYTES + 64 * VSTR;
  const int krow = tid >> 3, kch = tid & 7;
  const int vrow = tid >> 4, vch = tid & 15;
  const bf16_t* kg = p.P + 256 + h * 64 + kch * 8;
  const bf16_t* vg = p.VtA + ((size_t)((b * 4 + h) * 64 + vrow)) * UA + vch * 8;
  u32x4 rk0, rk1, rv0, rv1;
  rk0 = *(const u32x4*)(kg + (size_t)rowOfU(b, ubeg + krow) * NP);
  rk1 = *(const u32x4*)(kg + (size_t)rowOfU(b, ubeg + krow + 64) * NP);
  rv0 = *(const u32x4*)(vg + ubeg);
  rv1 = *(const u32x4*)(vg + (size_t)32 * UA + ubeg);
  __syncthreads();
  asm volatile("" :: "v"(qf[0][0]), "v"(qf[0][1]), "v"(qf[1][0]), "v"(qf[1][1]));
  {
    unsigned char* Ks = smem; unsigned char* Vs = smem + KBYTES;
    *(u32x4*)(Ks + krow * LDS_STRIDE + kch * 16) = rk0; *(u32x4*)(Ks + (krow + 64) * LDS_STRIDE + kch * 16) = rk1;
    *(u32x4*)(Vs + vrow * VSTR + vch * 16) = rv0; *(u32x4*)(Vs + (vrow + 32) * VSTR + vch * 16) = rv1;
  }
  __syncthreads();
  int buf = 0;
  for (int u0 = ubeg; u0 < uend; u0 += 128) {
    const int un = u0 + 128 < uend ? u0 + 128 : ubeg;
    rk0 = *(const u32x4*)(kg + (size_t)rowOfU(b, un + krow) * NP);
    rk1 = *(const u32x4*)(kg + (size_t)rowOfU(b, un + krow + 64) * NP);
    rv0 = *(const u32x4*)(vg + un);
    rv1 = *(const u32x4*)(vg + (size_t)32 * UA + un);
    const unsigned char* Ks = smem + buf * STG;
    const unsigned char* Vs = Ks + KBYTES;
    f32x16 sc[2], sn[2];
#define A_QK(SUB, DST) do { _Pragma("unroll") for (int m = 0; m < 2; ++m) { \
      const unsigned char* kr = Ks + (32 * (SUB) + pr) * LDS_STRIDE + (m * 32 + 8 * hh) * 2; \
      const bf16x8 kf0 = *(const bf16x8*)kr, kf1 = *(const bf16x8*)(kr + 32); \
      f32x16 t_; _Pragma("unroll") for (int i = 0; i < 16; ++i) t_[i] = negM2; \
      t_ = MFMA32(kf0, qf[m][0], t_); DST[m] = MFMA32(kf1, qf[m][1], t_); } } while (0)
    A_QK(0, sc);
#pragma unroll
    for (int sub = 0; sub < 4; ++sub) {
      if (sub < 3) A_QK(sub + 1, sn);
      bf16x8 vf[2][2];
#pragma unroll
      for (int dh = 0; dh < 2; ++dh)
#pragma unroll
        for (int s2 = 0; s2 < 2; ++s2) vf[dh][s2] = *(const bf16x8*)(Vs + (32 * dh + qi) * VSTR + (32 * sub + 16 * s2 + 8 * hh) * 2);
#pragma unroll
      for (int m = 0; m < 2; ++m) {
        float pe[16];
#pragma unroll
        for (int i = 0; i < 16; ++i) pe[i] = fexp2(sc[m][i]);
        sum16_nopk(ls[m], pe);
#pragma unroll
        for (int s2 = 0; s2 < 2; ++s2) {
          u32x4 pw;
#pragma unroll
          for (int q = 0; q < 4; ++q) pw[q] = pk2(pe[8 * s2 + 2 * q], pe[8 * s2 + 2 * q + 1]);
          const bf16x8 pf = __builtin_bit_cast(bf16x8, pw);
#pragma unroll
          for (int dh = 0; dh < 2; ++dh) o[m][dh] = MFMA32(vf[dh][s2], pf, o[m][dh]);
        }
      }
      if (sub < 3) { sc[0] = sn[0]; sc[1] = sn[1]; }
    }
    {
      unsigned char* Kw = smem + (buf ^ 1) * STG; unsigned char* Vw = Kw + KBYTES;
      *(u32x4*)(Kw + krow * LDS_STRIDE + kch * 16) = rk0; *(u32x4*)(Kw + (krow + 64) * LDS_STRIDE + kch * 16) = rk1;
      *(u32x4*)(Vw + vrow * VSTR + vch * 16) = rv0; *(u32x4*)(Vw + (vrow + 32) * VSTR + vch * 16) = rv1;
    }
    __syncthreads();
    buf ^= 1;
  }
  const float l0 = ls[0] + __shfl_xor(ls[0], 32), l1 = ls[1] + __shfl_xor(ls[1], 32);
  const float i0 = 1.f / l0, c1 = lam / l1;
  float ss = 0.f;
#pragma unroll
  for (int dh = 0; dh < 2; ++dh)
#pragma unroll
    for (int i = 0; i < 16; ++i) { const float v = o[0][dh][i] * i0 - o[1][dh][i] * c1; o[0][dh][i] = v; ss += v * v; }
  ss += __shfl_xor(ss, 32);
  const float r = rsqrtf(ss * (1.f / 64.f) + EPS) * (1.f - lam_init);
  bf16_t* op = p.MO + (size_t)(qrow0 + qi) * DM + h * 64;
  const float* sg = p.da_sub_gain + layer * 64;
#pragma unroll
  for (int dh = 0; dh < 2; ++dh)
#pragma unroll
    for (int g = 0; g < 4; ++g) {
      const int dv = 32 * dh + 8 * g + 4 * hh;
      const f32x4 g4 = *(const f32x4*)(sg + dv);
      u32x2 w;
      w[0] = pk2(o[0][dh][4 * g] * r * g4[0], o[0][dh][4 * g + 1] * r * g4[1]);
      w[1] = pk2(o[0][dh][4 * g + 2] * r * g4[2], o[0][dh][4 * g + 3] * r * g4[3]);
      *(u32x2*)(op + dv) = w;
    }
}

struct Frag64 { u32x4 k[4]; u32x4 v[4]; };
constexpr int W64_KB = 32 * LDS_STRIDE, W64_VSTR = 80, W64_BYTES = W64_KB + 64 * W64_VSTR;
DI void frag64_load(Frag64& f, const bf16_t* P, const bf16_t* vt, int b, int u, int kcol, int lane) {
#pragma unroll
  for (int i = 0; i < 4; ++i) {
    f.k[i] = *(const u32x4*)(P + (size_t)rowOfU(b, u + (lane >> 3) + 8 * i) * NP + kcol + (lane & 7) * 8);
    f.v[i] = *(const u32x4*)(vt + (size_t)((lane >> 2) + 16 * i) * UA + u + (lane & 3) * 8);
  }
}

template <int MODE>
DI void attn64_wave(const Params& p, int layer, int b, int hq, int qrow0, int t0, const float* rpb_lds, unsigned char* wlds) {
  constexpr bool isC = (MODE == 0 || MODE == 2);
  const int lane = ltid() & 63, qi = lane & 31, hh = lane >> 5;
  const int pr = (qi & 19) | ((qi & 4) << 1) | ((qi & 8) >> 1);
  const float* gqp = (isC ? p.na_q_gain : p.sw_q_gain) + layer * 64;
  const float* gkp = (isC ? p.na_k_gain : p.sw_k_gain) + layer * 64;
  const float gq = wave_max(fabsf(gqp[lane])), gk = wave_max(fabsf(gkp[lane]));
  const float negM2 = -(0.125f * LOG2E * 64.f * 1.02f) * gq * gk;
  const int kvh = isC ? hq : (hq >> 1);
  const int qcol = isC ? 2048 + 64 * hq : 2816 + 64 * hq;
  const int kcol = isC ? 2304 + 64 * hq : 3072 + 64 * kvh;
  const bf16_t* vt = isC ? p.VtC + (size_t)(b * 4 + hq) * 64 * UA : p.VtD + (size_t)(b * 2 + kvh) * 64 * UA;
  const bf16_t* qp = p.P + (size_t)(qrow0 + qi) * NP + qcol + 8 * hh;
  bf16x8 qf[4];
#pragma unroll
  for (int ks = 0; ks < 4; ++ks) qf[ks] = *(const bf16x8*)(qp + ks * 16);
  f32x16 o[2];
#pragma unroll
  for (int dh = 0; dh < 2; ++dh)
#pragma unroll
    for (int i = 0; i < 16; ++i) o[dh][i] = 0.f;
  float ls = 0.f;
  constexpr int NT = MODE == 0 ? 24 : (MODE == 1 ? 18 : 8);
  const int r = t0 >> 6, c = (t0 & 63) + qi;
  const int rs = min(max(r - 4, 0), 248), ws = min(max(c - 8, 0), 48);
  const float* rpb = rpb_lds + hq * 465;
  const int qt = t0 + qi;
  auto tile_u = [&](int t) -> int {
    if (t < 8) return 32 * t;
    if (MODE == 0) return CTX + (rs + ((t - 8) >> 1)) * 64 + ((t - 8) & 1) * 32;
    const int kt0 = t0 - 128 + 32 * (t - 8);
    return CTX + min(max(kt0, 0), SEQ - 32);
  };
  auto load_tile = [&](Frag64& f, int t) { frag64_load(f, p.P, vt, b, tile_u(t), kcol, lane); };
  unsigned char* Kw = wlds; unsigned char* Vw = wlds + W64_KB;
  auto compute_tile = [&](const Frag64& f, int t) {
#pragma unroll
    for (int i = 0; i < 4; ++i) {
      *(u32x4*)(Kw + ((lane >> 3) + 8 * i) * LDS_STRIDE + (lane & 7) * 16) = f.k[i];
      *(u32x4*)(Vw + ((lane >> 2) + 16 * i) * W64_VSTR + (lane & 3) * 16) = f.v[i];
    }
    bf16x8 kf[4], vf[2][2];
#pragma unroll
    for (int ks = 0; ks < 4; ++ks) kf[ks] = __builtin_bit_cast(bf16x8, *(const u32x4*)(Kw + pr * LDS_STRIDE + (16 * ks + 8 * hh) * 2));
#pragma unroll
    for (int dh = 0; dh < 2; ++dh)
#pragma unroll
      for (int s2 = 0; s2 < 2; ++s2) vf[dh][s2] = __builtin_bit_cast(bf16x8, *(const u32x4*)(Vw + (32 * dh + qi) * W64_VSTR + (16 * s2 + 8 * hh) * 2));
    f32x16 s;
#pragma unroll
    for (int i = 0; i < 16; ++i) s[i] = negM2;
#pragma unroll
    for (int ks = 0; ks < 4; ++ks) s = MFMA32(kf[ks], qf[ks], s);
    float pe[16];
    if (t < 8) {
#pragma unroll
      for (int i = 0; i < 16; ++i) pe[i] = fexp2(s[i]);
    } else if (MODE == 0) {
      const int kr = rs + ((t - 8) >> 1), hf = (t - 8) & 1;
      const float* rrow = rpb + (kr - r + 7) * 31 + 15 - c;
#pragma unroll
      for (int i = 0; i < 16; ++i) {
        const int kc = hf * 32 + 16 * (i >> 3) + 8 * hh + (i & 7);
        const bool valid = (kc >= ws) && (kc < ws + 16);
        const int kcc = min(max(kc, ws), ws + 15);
        pe[i] = fexp2(valid ? s[i] + rrow[kcc] : -1e30f);
      }
    } else {
      const int jt = t - 8, kt0 = t0 - 128 + 32 * jt;
      const bool tile_ok = (jt < 9) && (kt0 >= 0) && (kt0 < SEQ);
#pragma unroll
      for (int i = 0; i < 16; ++i) {
        const int dd = kt0 + 16 * (i >> 3) + 8 * hh + (i & 7) - qt;
        pe[i] = fexp2((tile_ok && dd <= 128 && dd >= -128) ? s[i] : -1e30f);
      }
    }
    sum16_nopk(ls, pe);
#pragma unroll
    for (int s2 = 0; s2 < 2; ++s2) {
      u32x4 pw;
#pragma unroll
      for (int q = 0; q < 4; ++q) pw[q] = pk2(pe[8 * s2 + 2 * q], pe[8 * s2 + 2 * q + 1]);
      const bf16x8 pf = __builtin_bit_cast(bf16x8, pw);
#pragma unroll
      for (int dh = 0; dh < 2; ++dh) o[dh] = MFMA32(vf[dh][s2], pf, o[dh]);
    }
  };
  Frag64 fa, fb;
  load_tile(fa, 0);
#pragma unroll 1
  for (int t = 0; t < NT; t += 2) {
    load_tile(fb, t + 1);
    compute_tile(fa, t);
    load_tile(fa, t + 2 < NT ? t + 2 : 0);
    compute_tile(fb, t + 1);
  }
  float l = ls + __shfl_xor(ls, 32);
  if (!isC) l += fexp2(p.sw_sink[layer * 4 + hq] * LOG2E + negM2);
  const float il = 1.f / l;
  bf16_t* op = p.MO + (size_t)(qrow0 + qi) * DM + (isC ? 512 : 768) + hq * 64;
#pragma unroll
  for (int dh = 0; dh < 2; ++dh)
#pragma unroll
    for (int g = 0; g < 4; ++g) {
      const int dv = 32 * dh + 8 * g + 4 * hh;
      u32x2 w;
      w[0] = pk2(o[dh][4 * g] * il, o[dh][4 * g + 1] * il);
      w[1] = pk2(o[dh][4 * g + 2] * il, o[dh][4 * g + 3] * il);
      *(u32x2*)(op + dv) = w;
    }
}

DI void mix_phase(const Params& p, int layer, unsigned char* smem, unsigned char* smem_all, int bid, int nb, int rrank) {
  const int wave = ltid() >> 6;
  const int n_scan = 256, n_lat = 1024, n_ctx = layer == 0 ? 16 : 0;
  const int e0 = n_scan, e1 = e0 + n_lat, e2 = e1 + n_ctx, e3 = e2 + n_lat, e4 = e3 + n_lat, e5 = e4 + n_ctx, e6 = e5 + n_ctx;
  {
    const int rnb_ = nb >> 1, per_r = (rnb_ >> 3) > 0 ? (rnb_ >> 3) : 1;
    const int bh = rrank / per_r, jj = rrank - bh * per_r;
    if (bh < 8)
      for (int qb = jj; qb < 64; qb += per_r) attnA_block(p, layer, smem_all, bh >> 2, bh & 3, (bh >> 2) * SEQ + qb * 256, 0, UA);
    if (layer == 0)
      for (int j = rrank; j < 8; j += rnb_) attnA_block(p, layer, smem_all, j >> 2, j & 3, TL + (j >> 2) * CTX, 0, CTX);
    __syncthreads();
  }
  float* rpb_lds = (float*)smem;
  for (int i = ltid(); i < 4 * 465; i += 256) rpb_lds[i] = p.na_rpb[layer * 4 * 465 + i] * LOG2E;
  __syncthreads();
  for (int it = 2 * rrank + (bid & 1); it < e6; it += nb) {
    if (it < e0) scan_item(p, it);
    else if (it < e1) {
    } else if (it < e2) {
    } else if (it < e3) {
      const int j = it - e2, qb = j & 127, hq = (j >> 7) & 3, b = j >> 9;
      const int t0 = qb * 128 + wave * 32;
      attn64_wave<1>(p, layer, b, hq, b * SEQ + t0, t0, rpb_lds, smem + 8192 + wave * W64_BYTES);
    } else if (it < e4) {
      const int j = it - e3, qb = j & 127, hq = (j >> 7) & 3, b = j >> 9;
      const int t0 = qb * 128 + wave * 32;
      attn64_wave<0>(p, layer, b, hq, b * SEQ + t0, t0, rpb_lds, smem + 8192 + wave * W64_BYTES);
    } else if (it < e5) {
      const int j = it - e4, qb = j & 1, hq = (j >> 1) & 3, b = j >> 3;
      attn64_wave<3>(p, layer, b, hq, TL + b * CTX + qb * 128 + wave * 32, 0, rpb_lds, smem + 8192 + wave * W64_BYTES);
    } else {
      const int j = it - e5, qb = j & 1, hq = (j >> 1) & 3, b = j >> 3;
      attn64_wave<2>(p, layer, b, hq, TL + b * CTX + qb * 128 + wave * 32, 0, rpb_lds, smem + 8192 + wave * W64_BYTES);
    }
  }
}


template <int D>
DI void hgrn_dir(const Params& p, int layer, unsigned char* smem, int b, int hh, int n, f32x4 (&acc)[4]) {
  const int tid = ltid();
  const int chain = (b * 4 + hh) * 2 + D;
  float* cumT = (float*)smem;
  float* qT = cumT + 64 * 68;
  float* kT = qT + 64 * 68;
  float* vT = kT + 64 * 68;
  float* psum = vT + 64 * 68;
  float kreg[16], qreg[16];
  f32x4 s4s[4];
  {
    const int pp = tid >> 2, kq = (tid & 3) * 16;
    const int row = hg_row(b, D, n, pp);
    const bf16_t* pr = p.P + (size_t)row * NP;
    const bf16_t* qp = pr + 768 + hh * 64 + kq;
    const bf16_t* fp = pr + 1536 + D * 256 + hh * 64 + kq;
    const bf16_t* vp = pr + 1024 + hh * 64 + kq;
    const u32x4 q0 = *(const u32x4*)qp, q1 = *(const u32x4*)(qp + 8), f0 = *(const u32x4*)fp, f1 = *(const u32x4*)(fp + 8),
                v0 = *(const u32x4*)vp, v1 = *(const u32x4*)(vp + 8);
    const float* Sg = p.HL + ((size_t)(chain * NCHUNK + n)) * 4096;
    f32x4 s4[4];
#pragma unroll
    for (int i = 0; i < 4; ++i) s4[i] = *(const f32x4*)(Sg + (tid + 256 * i) * 4);
#pragma unroll
    for (int i = 0; i < 4; ++i) s4s[i] = s4[i];
    float qx[16], fx[16], vx[16];
#pragma unroll
    for (int q = 0; q < 4; ++q) {
      qx[2 * q] = bf_lo(q0[q]); qx[2 * q + 1] = bf_hi(q0[q]); qx[8 + 2 * q] = bf_lo(q1[q]); qx[8 + 2 * q + 1] = bf_hi(q1[q]);
      fx[2 * q] = bf_lo(f0[q]); fx[2 * q + 1] = bf_hi(f0[q]); fx[8 + 2 * q] = bf_lo(f1[q]); fx[8 + 2 * q + 1] = bf_hi(f1[q]);
      vx[2 * q] = bf_lo(v0[q]); vx[2 * q + 1] = bf_hi(v0[q]); vx[8 + 2 * q] = bf_lo(v1[q]); vx[8 + 2 * q + 1] = bf_hi(v1[q]);
    }
#pragma unroll
    for (int j = 0; j < 16; ++j) {
      const float lb = hg_lb(p, layer, D, hh * 64 + kq + j);
      const float sg = __builtin_amdgcn_rcpf(1.f + fexp2(-fx[j] * LOG2E));
      const float f = lb + (1.f - lb) * sg;
      cumT[(kq + j) * 68 + pp] = __builtin_amdgcn_logf(f);
      qT[(kq + j) * 68 + pp] = qx[j];
      qreg[j] = qx[j];
      kreg[j] = 1.f - f;
      vT[(kq + j) * 68 + pp] = vx[j];
    }
  }
#pragma unroll
  for (int i = 0; i < 4; ++i) {
    const int k = (tid + 256 * i) >> 4, v = (tid & 15) * 4;
#pragma unroll
    for (int c = 0; c < 4; ++c) kT[(v + c) * 68 + k] = s4s[i][c];
  }
  __syncthreads();
  {
    float c[16];
    prefix64(cumT, psum, tid, c);
    float* qrow = qT + (tid & 63) * 68 + 16 * (tid >> 6);
#pragma unroll
    for (int i4 = 0; i4 < 4; ++i4) {
      f32x4 t = *(const f32x4*)(qrow + 4 * i4);
#pragma unroll
      for (int a = 0; a < 4; ++a) t[a] *= fexp2(c[4 * i4 + a]);
      *(f32x4*)(qrow + 4 * i4) = t;
    }
  }
  __syncthreads();
  const int wv = tid >> 6, lane = tid & 63, lc = lane & 15, lq = lane >> 4;
  const int ppos = D ? 16 * (3 - wv) + 15 - lc : 16 * wv + lc;
  {
#pragma unroll
    for (int ks = 0; ks < 2; ++ks) {
      f32x4 b0, b1;
#pragma unroll
      for (int j = 0; j < 4; ++j) { b0[j] = qT[(32 * ks + 8 * lq + j) * 68 + ppos]; b1[j] = qT[(32 * ks + 8 * lq + 4 + j) * 68 + ppos]; }
      const bf16x8 bf = pack8(b0, b1);
#pragma unroll
      for (int vt = 0; vt < 4; ++vt) {
        const float* ar = kT + (16 * vt + lc) * 68 + 32 * ks + 8 * lq;
        const bf16x8 af = pack8(*(const f32x4*)ar, *(const f32x4*)(ar + 4));
        acc[vt] = MFMA16(af, bf, acc[vt]);
      }
    }
  }
  __syncthreads();
  {
    const int pp = tid >> 2, kq = (tid & 3) * 16;
#pragma unroll
    for (int j = 0; j < 16; ++j) { kT[(kq + j) * 68 + pp] = kreg[j]; qT[(kq + j) * 68 + pp] = qreg[j]; }
  }
  __syncthreads();
  {
    const int I = wv;
    bf16x8 af[2];
    float rf[2][8];
#pragma unroll
    for (int ks = 0; ks < 2; ++ks) {
      f32x4 a0, a1;
#pragma unroll
      for (int j = 0; j < 8; ++j) {
        const int k = 32 * ks + 8 * lq + j;
        rf[ks][j] = cumT[k * 68 + 16 * I];
        const float e = qT[k * 68 + 16 * I + lc] * fexp2(cumT[k * 68 + 16 * I + lc] - rf[ks][j]);
        if (j < 4) a0[j] = e; else a1[j - 4] = e;
      }
      af[ks] = pack8(a0, a1);
    }
    f32x4 cacc[4];
#pragma unroll
    for (int J = 0; J < 4; ++J) {
      cacc[J] = (f32x4){0.f, 0.f, 0.f, 0.f};
      if (J <= I) {
#pragma unroll
        for (int ks = 0; ks < 2; ++ks) {
          f32x4 b0, b1;
#pragma unroll
          for (int j = 0; j < 8; ++j) {
            const int k = 32 * ks + 8 * lq + j;
            const float e = kT[k * 68 + 16 * J + lc] * fexp2(fminf(rf[ks][j] - cumT[k * 68 + 16 * J + lc], 126.f));
            if (j < 4) b0[j] = e; else b1[j - 4] = e;
          }
          cacc[J] = MFMA16(af[ks], pack8(b0, b1), cacc[J]);
        }
      }
    }
    __syncthreads();
#pragma unroll
    for (int J = 0; J < 4; ++J)
#pragma unroll
      for (int i = 0; i < 4; ++i) {
        const int t = 16 * I + 4 * lq + i, s_ = 16 * J + lc;
        kT[t * 68 + s_] = (s_ <= t) ? cacc[J][i] : 0.f;
      }
  }
  __syncthreads();
  {
#pragma unroll
    for (int ks = 0; ks < 2; ++ks) {
      const float* br = kT + ppos * 68 + 32 * ks + 8 * lq;
      const bf16x8 bf = pack8(*(const f32x4*)br, *(const f32x4*)(br + 4));
#pragma unroll
      for (int vt = 0; vt < 4; ++vt) {
        const float* ar = vT + (16 * vt + lc) * 68 + 32 * ks + 8 * lq;
        const bf16x8 af = pack8(*(const f32x4*)ar, *(const f32x4*)(ar + 4));
        acc[vt] = MFMA16(af, bf, acc[vt]);
      }
    }
  }
  __syncthreads();
}

DI void hgout_phase(const Params& p, int layer, unsigned char* smem, int bid, int nb) {
  const int tid = ltid();
  const int n_lat = 2 * 4 * 256, n_ctx = layer == 0 ? 2 * 4 * 4 : 0;
  for (int it = bid; it < n_lat + n_ctx; it += nb) {
    int b, hh, n0, n1, rowbase;
    if (it < n_lat) { const int m = it & 255; hh = (it >> 8) & 3; b = it >> 10; n0 = 4 + m; n1 = 4 + 255 - m; rowbase = b * SEQ + 64 * m; }
    else { const int j = it - n_lat, mc = j & 3; hh = (j >> 2) & 3; b = j >> 4; n0 = mc; n1 = 3 - mc; rowbase = TL + b * CTX + 64 * mc; }
    f32x4 acc[4];
#pragma unroll
    for (int vt = 0; vt < 4; ++vt) acc[vt] = (f32x4){0.f, 0.f, 0.f, 0.f};
    hgrn_dir<0>(p, layer, smem, b, hh, n0, acc);
    hgrn_dir<1>(p, layer, smem, b, hh, n1, acc);
    const int wv = tid >> 6, lane = tid & 63, lc = lane & 15, lq = lane >> 4;
    const int row = rowbase + 16 * wv + lc;
    float ss = 0.f;
#pragma unroll
    for (int vt = 0; vt < 4; ++vt)
#pragma unroll
      for (int i = 0; i < 4; ++i) ss += acc[vt][i] * acc[vt][i];
    ss += __shfl_xor(ss, 16); ss += __shfl_xor(ss, 32);
    const float r = rsqrtf(ss * (1.f / 64.f) + EPS);
#pragma unroll
    for (int vt = 0; vt < 4; ++vt) {
      const int v0 = 16 * vt + 4 * lq;
      const f32x4 og = *(const f32x4*)(p.hg_out_gain + layer * 64 + v0);
      const u32x2 gw = *(const u32x2*)(p.P + (size_t)row * NP + 1280 + hh * 64 + v0);
      const float gx[4] = {bf_lo(gw[0]), bf_hi(gw[0]), bf_lo(gw[1]), bf_hi(gw[1])};
      float y[4];
#pragma unroll
      for (int i = 0; i < 4; ++i) y[i] = acc[vt][i] * r * og[i] * (gx[i] / (1.f + expf(-gx[i])));
      u32x2 w; w[0] = pk2(y[0], y[1]); w[1] = pk2(y[2], y[3]);
      *(u32x2*)(p.MO + (size_t)row * DM + 256 + hh * 64 + v0) = w;
    }
  }
}

#define XB_TMO      128
#define XB_XCNT(j)  (256  + 64 * (j))
#define XB_XSUB(j)  (1280 + 64 * (j))
#define XB_XGEN(j)  (2304 + 64 * (j))
#define XB_TOP      3328
#define XB_TOPGEN   3392
#define XCD_BAR_WORDS 3456
#define XB_SPIN_CAP (1u << 18)
#define LAS __attribute__((address_space(3)))

__device__ __forceinline__ unsigned xb_ld(unsigned* p)              { return __hip_atomic_load(p, __ATOMIC_RELAXED, __HIP_MEMORY_SCOPE_AGENT); }
__device__ __forceinline__ unsigned xb_add(unsigned* p, unsigned v) { return __hip_atomic_fetch_add(p, v, __ATOMIC_RELAXED, __HIP_MEMORY_SCOPE_AGENT); }
__device__ __forceinline__ unsigned xb_xcc_id() { return (unsigned)__builtin_amdgcn_s_getreg((3 << 11) | 20) & 0xFu; }
#define XB_SPIN(cond, bar) do { unsigned _sp = 0; while (cond) { __builtin_amdgcn_s_sleep(1); \
    if ((++_sp & 255u) == 0u) { if (xb_ld(&(bar)[XB_TMO])) break; if (_sp > XB_SPIN_CAP) { atomicAdd(&(bar)[XB_TMO], 1u); break; } } } } while (0)

struct XcdBarrier {
    unsigned* bar; unsigned x;
    volatile LAS unsigned* st;
};

__device__ __forceinline__ XcdBarrier xcd_barrier_post(unsigned* bar, volatile LAS unsigned* st) {
    XcdBarrier b; b.bar = bar; b.x = xb_xcc_id(); b.st = st;
    if (threadIdx.x == 0) (void)xb_add(&bar[XB_XCNT(b.x)], 1u);
    return b;
}
__device__ __forceinline__ void xcd_barrier_complete(unsigned* bar, unsigned x, unsigned& nloc, unsigned& nx) {
    const unsigned G = gridDim.x * gridDim.y * gridDim.z;
    unsigned sum, cnt, mine, sp = 0u;
    for (;;) {
        sum = 0u; cnt = 0u; mine = 0u;
#pragma unroll
        for (unsigned j = 0; j < 16; ++j) { const unsigned c = xb_ld(&bar[XB_XCNT(j)]); sum += c; cnt += (c > 0u) ? 1u : 0u; mine = (j == x) ? c : mine; }
        if (sum == G) break;
        __builtin_amdgcn_s_sleep(1);
        if ((++sp & 255u) == 0u) { if (xb_ld(&bar[XB_TMO])) break; if (sp > XB_SPIN_CAP) { atomicAdd(&bar[XB_TMO], 1u); break; } }
    }
    nloc = mine > 0u ? mine : 1u; nx = cnt > 0u ? cnt : 1u;
}

__device__ __forceinline__ void xcd_barrier(const XcdBarrier& b) {
    asm volatile("s_waitcnt vmcnt(0)" ::: "memory");
    __syncthreads();
    if (threadIdx.x == 0) {
        unsigned* bar = b.bar;
        __builtin_amdgcn_s_waitcnt(0);
        unsigned nloc = b.st[0], nx = b.st[1];
        if (nloc == 0u) { xcd_barrier_complete(bar, b.x, nloc, nx); b.st[0] = nloc; b.st[1] = nx; }
        const unsigned old = xb_add(&bar[XB_XSUB(b.x)], 1u);
        const unsigned gen = old / nloc;
        if (old + 1u == (gen + 1u) * nloc) {
            __builtin_amdgcn_fence(__ATOMIC_RELEASE, "agent");
            asm volatile("s_waitcnt vmcnt(0)" ::: "memory");
            const unsigned og = xb_add(&bar[XB_TOP], 1u);
            const unsigned tg = og / nx;
            if (og + 1u == (tg + 1u) * nx) xb_add(&bar[XB_TOPGEN], 1u);
            else XB_SPIN(xb_ld(&bar[XB_TOPGEN]) == tg, bar);
            __builtin_amdgcn_fence(__ATOMIC_ACQUIRE, "agent");
            xb_add(&bar[XB_XGEN(b.x)], 1u);
            asm volatile("s_waitcnt vmcnt(0)" ::: "memory");
        } else {
            XB_SPIN(xb_ld(&bar[XB_XGEN(b.x)]) == gen, bar);
            __builtin_amdgcn_fence(__ATOMIC_ACQUIRE, "agent");
            asm volatile("s_waitcnt vmcnt(0)" ::: "memory");
        }
    }
    __syncthreads();
}


#if MULTI_LAUNCH
#define SYNC_OR_RETURN(ph) do { if (phase_sel == (ph)) return; } while (0)
#define RUN(ph) (phase_sel == (ph))
#else
#define RUN(ph) (true)
#endif

__global__ void __launch_bounds__(512) fwd_kernel(Params p, int phase_sel) {
  __shared__ __attribute__((aligned(16))) unsigned char smem_all[2 * SMEM_BYTES];
  const int rbid = blockIdx.x, rnb = gridDim.x;
  const int vb = __builtin_amdgcn_readfirstlane((int)(threadIdx.x >> 8));
  const int bid = rbid * 2 + vb, nb = rnb * 2;
  unsigned char* smem = smem_all + vb * SMEM_BYTES;
  cg::grid_group grid = cg::this_grid();
  __shared__ __attribute__((aligned(16))) unsigned xb_words[4];
  if (threadIdx.x < 4) xb_words[threadIdx.x] = 0u;
  __syncthreads();
  const XcdBarrier xb = xcd_barrier_post(p.xbar, (volatile LAS unsigned*)xb_words);
#define GSYNC() xcd_barrier(xb)
  __shared__ int s_rank[2];
  if (threadIdx.x == 0) { const unsigned x = xcc_id(); s_rank[0] = (int)x; s_rank[1] = (int)atomicAdd(&p.xcnt[x], 1u); }
  int ph = 0;
  if (RUN(ph)) phase0(p, smem, bid, nb);
  grid.sync(); ++ph;
  if (threadIdx.x == 0) {
    int r = s_rank[1];
    for (int y = 0; y < s_rank[0]; ++y) r += (int)__hip_atomic_load(&p.xcnt[y], __ATOMIC_RELAXED, __HIP_MEMORY_SCOPE_AGENT);
    s_rank[0] = r;
  }
  __syncthreads();
  const int rrank = __builtin_amdgcn_readfirstlane(s_rank[0]);
  for (int layer = 0; layer < 2; ++layer) {
    const float* modl = p.mod + layer * 3 * 6144;
    const float* rl = layer == 0 ? p.x : p.out;
    const float* rc = layer == 0 ? p.ctx : p.Xc;
    if (RUN(ph)) norm_phase(rl, rc, TA, p.norm1_g + layer * DM, modl, 0, 1024, p.H, bid, nb);
    GSYNC(); ++ph;
    if (RUN(ph)) { EpiBf16 e{p.P, NP}; gemm_phase512(p.H, p.WinT + (size_t)layer * NP * 1024, TA / 256, NP / 256, 1024, 1024, 1, e, smem_all, rrank, rnb); }
    GSYNC(); ++ph;
    if (RUN(ph)) prep_phase(p, layer, smem, bid, nb);
    GSYNC(); ++ph;
    if (RUN(ph)) mix_phase(p, layer, smem, smem_all, bid, nb, rrank);
    GSYNC(); ++ph;
    if (RUN(ph)) hgout_phase(p, layer, smem, bid, nb);
    GSYNC(); ++ph;
    const int mrows = layer == 0 ? TA : TL;
    if (RUN(ph)) { EpiResid e{rl, rc, p.out, p.Xc, modl + 2048, 0}; gemm_phase512(p.MO, p.WoutT + (size_t)layer * 1024 * 1024, mrows / 256, 4, 1024, 1024, 1, e, smem_all, rrank, rnb); }
    GSYNC(); ++ph;
    if (RUN(ph)) norm_phase(p.out, p.Xc, mrows, p.norm2_g + layer * DM, modl, 3072, 4096, p.H, bid, nb);
    GSYNC(); ++ph;
    const int nchunks = layer == 0 ? 3 : 2;
    for (int ch = 0; ch < nchunks; ++ch) {
      const int row0 = ch * 16384, rows = ch < 2 ? 16384 : TC;
      if (RUN(ph)) { EpiRelu2 e{p.P, DFF}; gemm_phase512(p.H + (size_t)row0 * DM, p.W1T + (size_t)layer * DFF * 1024, rows / 256, DFF / 256, 1024, 1024, 1, e, smem_all, rrank, rnb); }
      GSYNC(); ++ph;
      if (RUN(ph)) {
        if (ch < 2) { EpiResid e{p.out, p.Xc, p.out, p.Xc, modl + 5 * 1024, row0}; gemm_phase512(p.P, p.W2T + (size_t)layer * 1024 * DFF, rows / 256, 4, DFF, DFF, 1, e, smem_all, rrank, rnb); }
        else { EpiResidAtomic e{p.out, p.Xc, modl + 5 * 1024, row0}; gemm_phase512(p.P, p.W2T + (size_t)layer * 1024 * DFF, rows / 256, 4, DFF, 256, 16, e, smem_all, rrank, rnb); }
      }
      GSYNC(); ++ph;
    }
  }
}

static size_t align_up(size_t v) { return (v + 255) & ~(size_t)255; }

extern "C" void kernel_launch(void* const* d_in, const int* in_sizes, int n_in, void* d_out, int out_size, void* d_ws, size_t ws_size,
                              hipStream_t stream) {
  Params p{};
  const float** f = (const float**)&p;
  for (int i = 0; i < 24; ++i) f[i] = (const float*)d_in[i];
  p.out = (float*)d_out;
  unsigned char* w = (unsigned char*)d_ws; size_t off = 0;
  auto take = [&](size_t bytes) { void* r = w + off; off = align_up(off + bytes); return r; };
  p.Xc = (float*)take((size_t)TC * DM * 4);
  p.mod = (float*)take((size_t)2 * 3 * 6144 * 4);
  p.Hdec = (float*)take((size_t)16 * NCHUNK * 64 * 4);
  p.lbtab = (float*)take((size_t)2 * 2 * 256 * 4);
  p.WinT = (bf16_t*)take((size_t)2 * NP * 1024 * 2);
  p.WoutT = (bf16_t*)take((size_t)2 * 1024 * 1024 * 2);
  p.W1T = (bf16_t*)take((size_t)2 * DFF * 1024 * 2);
  p.W2T = (bf16_t*)take((size_t)2 * DFF * 1024 * 2);
  p.H = (bf16_t*)take((size_t)TA * DM * 2);
  p.HL = (float*)p.H;
  p.P = (bf16_t*)take((size_t)TA * NP * 2);
  p.MO = (bf16_t*)take((size_t)TA * DM * 2);
  p.VtA = (bf16_t*)take((size_t)2 * 4 * 64 * UA * 2);
  p.VtC = (bf16_t*)take((size_t)2 * 4 * 64 * UA * 2);
  p.VtD = (bf16_t*)take((size_t)2 * 2 * 64 * UA * 2);
  p.xcnt = (unsigned*)take(256);
  p.xbar = (unsigned*)take((size_t)XCD_BAR_WORDS * 4);
  if (off > ws_size) { fprintf(stderr, "workspace too small: need %zu have %zu\n", off, ws_size); return; }
#if MULTI_LAUNCH
  const int nphase = 1 + 7 + 6 + 7 + 4;
  for (int ph = 0; ph < nphase; ++ph) hipLaunchKernelGGL(fwd_kernel, dim3(256), dim3(512), 0, stream, p, ph);
#else
  static int grid_blocks = 0;
  int phase_sel = -1;
  void* args[] = {&p, &phase_sel};
  if (!grid_blocks) {
    int dev = 0, cus = 0, per_cu = 0;
    (void)hipGetDevice(&dev);
    (void)hipDeviceGetAttribute(&cus, hipDeviceAttributeMultiprocessorCount, dev);
    (void)hipOccupancyMaxActiveBlocksPerMultiprocessor(&per_cu, fwd_kernel, 512, 0);
    if (per_cu < 1) per_cu = 1;
    grid_blocks = cus;
  }
  (void)hipMemsetAsync(p.xcnt, 0, 256 + (size_t)XCD_BAR_WORDS * 4, stream);
  hipError_t e = hipLaunchCooperativeKernel((void*)fwd_kernel, dim3(grid_blocks), dim3(512), args, 0, stream);
  if (e != hipSuccess) fprintf(stderr, "cooperative launch failed: %s (grid %d)\n", hipGetErrorString(e), grid_blocks);
#endif
}
```
